# Optimizing an MI355X kernel written in HIP

```python
import jax, jax.numpy as jnp
from jax import lax
import numpy as np

D_MODEL = 1024
BATCH = 2
SEQ = 8192
DEPTH = 1

DN_HEADS = 4
DN_HEAD_DIM = 128
DN_WIDTH = DN_HEADS * DN_HEAD_DIM
DN_CONV = 5
DN_CHUNK = 64
N_DIR = 2
SWA_Q_HEADS = 8
SWA_KV_HEADS = 2
SWA_HEAD_DIM = 64
SWA_WIDTH = SWA_Q_HEADS * SWA_HEAD_DIM
SWA_KV_WIDTH = SWA_KV_HEADS * SWA_HEAD_DIM
WINDOW = 128
BLOCK = 128
ROPE_THETA = 10000.0
EPS = 1e-6
MIX_WIDTH = DN_WIDTH + SWA_WIDTH
SPLITS = (DN_WIDTH, DN_WIDTH, DN_WIDTH, DN_WIDTH, N_DIR * DN_HEADS, N_DIR * DN_HEADS,
          SWA_WIDTH, SWA_KV_WIDTH, SWA_KV_WIDTH, SWA_WIDTH)
IN_WIDTH = 4 * DN_WIDTH + 2 * N_DIR * DN_HEADS + 2 * SWA_WIDTH + 2 * SWA_KV_WIDTH

kernel_name = 'hybrid_gdn_swa_parallel_heads'


def rms_norm(x, w):
    xf = x.astype(jnp.float32)
    y = xf * lax.rsqrt(jnp.mean(xf * xf, axis=-1, keepdims=True) + EPS)
    return (y * w.astype(jnp.float32)).astype(x.dtype)


def l2_norm(x):
    return x * lax.rsqrt(jnp.sum(x * x, axis=-1, keepdims=True) + EPS)


def rope_tables(seq, dim):
    inv_freq = ROPE_THETA ** (-jnp.arange(0, dim, 2, dtype=jnp.float32) / dim)
    ang = jnp.arange(seq, dtype=jnp.float32)[:, None] * inv_freq[None, :]
    ang = jnp.concatenate([ang, ang], axis=-1)
    return jnp.cos(ang), jnp.sin(ang)


def rotary(x, cos, sin):
    half = x.shape[-1] // 2
    rot = jnp.concatenate([-x[..., half:], x[..., :half]], axis=-1)
    return x * cos[:, None, :] + rot * sin[:, None, :]


def centred_depthwise_conv(x, w):
    pad = (w.shape[0] - 1) // 2
    return lax.conv_general_dilated(
        x, w[:, None, :].astype(x.dtype), window_strides=(1,), padding=[(pad, pad)],
        dimension_numbers=('NWC', 'WIO', 'NWC'), feature_group_count=x.shape[-1])


def gated_delta_rule_chunked(q, k, v, g, beta):
    b, t, h, dk = q.shape
    dv = v.shape[-1]
    c = DN_CHUNK
    n = t // c

    def to_chunks(a):
        return jnp.moveaxis(a.reshape(b, n, c, h, *a.shape[3:]), 3, 1)

    q, k, v, g, beta = (to_chunks(a) for a in (q, k, v, g, beta))
    g = jnp.cumsum(g, axis=-1)
    incl = jnp.tril(jnp.ones((c, c), dtype=bool))
    strict = jnp.tril(jnp.ones((c, c), dtype=bool), -1)
    decay = jnp.exp(jnp.where(incl, g[..., :, None] - g[..., None, :], -jnp.inf))
    k_beta = k * beta[..., None]
    m = jnp.where(strict, jnp.einsum('bhncd,bhnsd->bhncs', k_beta, k) * decay, 0.0)
    eye = jnp.eye(c, dtype=q.dtype)
    t_inv = lax.linalg.triangular_solve(eye + m, jnp.broadcast_to(eye, m.shape),
                                        left_side=True, lower=True, unit_diagonal=True)
    u = jnp.einsum('bhncs,bhnse->bhnce', t_inv, v * beta[..., None])
    w = jnp.einsum('bhncs,bhnsd->bhncd', t_inv, k_beta * jnp.exp(g)[..., None])
    a_intra = jnp.where(incl, jnp.einsum('bhncd,bhnsd->bhncs', q, k) * decay, 0.0)

    def step(state, inp):
        q_i, k_i, u_i, w_i, g_i, a_i = inp
        v_new = u_i - jnp.einsum('bhcd,bhde->bhce', w_i, state)
        o = (jnp.einsum('bhcd,bhde->bhce', q_i * jnp.exp(g_i)[..., None], state)
             + jnp.einsum('bhcs,bhse->bhce', a_i, v_new))
        g_last = g_i[..., -1]
        k_dec = k_i * jnp.exp(g_last[..., None] - g_i)[..., None]
        state = state * jnp.exp(g_last)[..., None, None] + jnp.einsum('bhcd,bhce->bhde', k_dec, v_new)
        return state, o

    xs = tuple(jnp.moveaxis(a, 2, 0) for a in (q, k, u, w, g, a_intra))
    state0 = jnp.zeros((b, h, dk, dv), dtype=q.dtype)
    _, o = lax.scan(step, state0, xs)
    o = jnp.moveaxis(o, 0, 2)
    return jnp.moveaxis(o, 1, 3).reshape(b, t, h, dv)


def gated_deltanet_bidir(q, k, v, beta_logit, decay_logit, conv_w, a_log, dt_bias):
    b, s, _ = q.shape
    qkv = jax.nn.silu(centred_depthwise_conv(jnp.concatenate([q, k, v], axis=-1), conv_w))
    q, k, v = jnp.split(qkv.astype(jnp.float32), 3, axis=-1)
    q = l2_norm(q.reshape(b, s, DN_HEADS, DN_HEAD_DIM)) * (DN_HEAD_DIM ** -0.5)
    k = l2_norm(k.reshape(b, s, DN_HEADS, DN_HEAD_DIM))
    v = v.reshape(b, s, DN_HEADS, DN_HEAD_DIM)
    beta = jax.nn.sigmoid(beta_logit.astype(jnp.float32).reshape(b, s, N_DIR, DN_HEADS))
    dl = decay_logit.astype(jnp.float32).reshape(b, s, N_DIR, DN_HEADS)
    g = -jnp.exp(a_log.astype(jnp.float32)) * jax.nn.softplus(dl + dt_bias.astype(jnp.float32))
    fwd = gated_delta_rule_chunked(q, k, v, g[:, :, 0], beta[:, :, 0])
    flip = lambda a: jnp.flip(a, axis=1)
    bwd = flip(gated_delta_rule_chunked(flip(q), flip(k), flip(v), flip(g[:, :, 1]), flip(beta[:, :, 1])))
    return fwd + bwd


def windowed_gqa_with_sinks(q, k, v, q_norm_w, k_norm_w, sinks):
    b, s, _ = q.shape
    nb = s // BLOCK
    nw = WINDOW // BLOCK
    span = BLOCK + 2 * WINDOW
    grp = SWA_Q_HEADS // SWA_KV_HEADS
    cos, sin = rope_tables(s, SWA_HEAD_DIM)
    q = rotary(rms_norm(q.astype(jnp.float32).reshape(b, s, SWA_Q_HEADS, SWA_HEAD_DIM), q_norm_w), cos, sin)
    k = rotary(rms_norm(k.astype(jnp.float32).reshape(b, s, SWA_KV_HEADS, SWA_HEAD_DIM), k_norm_w), cos, sin)
    v = v.astype(jnp.float32).reshape(b, s, SWA_KV_HEADS, SWA_HEAD_DIM)
    qb = q.reshape(b, nb, BLOCK, SWA_KV_HEADS, grp, SWA_HEAD_DIM)

    def band(a):
        ap = jnp.pad(a, ((0, 0), (WINDOW, WINDOW), (0, 0), (0, 0)))
        ab = ap.reshape(b, nb + 2 * nw, BLOCK, SWA_KV_HEADS, SWA_HEAD_DIM)
        return jnp.concatenate([ab[:, i:i + nb] for i in range(2 * nw + 1)], axis=2)

    kb, vb = band(k), band(v)
    scores = jnp.einsum('bnqhgd,bnkhd->bnhgqk', qb, kb) * (SWA_HEAD_DIM ** -0.5)
    q_pos = jnp.arange(nb)[:, None] * BLOCK + jnp.arange(BLOCK)[None, :]
    k_pos = jnp.arange(nb)[:, None] * BLOCK - WINDOW + jnp.arange(span)[None, :]
    rel = k_pos[:, None, :] - q_pos[:, :, None]
    valid = (jnp.abs(rel) <= WINDOW) & (k_pos[:, None, :] >= 0) & (k_pos[:, None, :] < s)
    scores = jnp.where(valid[None, :, None, None], scores, -jnp.inf)
    sink = sinks.astype(jnp.float32).reshape(SWA_KV_HEADS, grp)[None, None, :, :, None, None]
    mx = jnp.maximum(jnp.max(scores, axis=-1, keepdims=True), sink)
    p = jnp.exp(scores - mx)
    denom = jnp.sum(p, axis=-1, keepdims=True) + jnp.exp(sink - mx)
    out = jnp.einsum('bnhgqk,bnkhd->bnqhgd', p / denom, vb)
    return out.reshape(b, s, SWA_WIDTH)


def setup_inputs(seed: int = 0) -> dict:
    key = jax.random.key(seed)
    ks = jax.random.split(key, 12)
    x = jax.random.normal(ks[0], (BATCH, SEQ, D_MODEL), jnp.float32)
    norm_w = 1.0 + 0.02 * jax.random.normal(ks[1], (DEPTH, D_MODEL), jnp.float32)
    w_in = jax.random.normal(ks[2], (DEPTH, D_MODEL, IN_WIDTH), jnp.float32) * D_MODEL ** -0.5
    dn_conv_w = jax.random.normal(ks[3], (DEPTH, DN_CONV, 3 * DN_WIDTH), jnp.float32) * DN_CONV ** -0.5
    dn_a_log = jnp.log(jax.random.uniform(ks[4], (DEPTH, N_DIR, DN_HEADS), jnp.float32, 1.0, 16.0))
    dt = jnp.exp(jax.random.uniform(ks[5], (DEPTH, N_DIR, DN_HEADS), jnp.float32,
                                    float(np.log(1e-3)), float(np.log(1e-1))))
    dn_dt_bias = dt + jnp.log(-jnp.expm1(-dt))
    dn_out_norm_w = 1.0 + 0.02 * jax.random.normal(ks[6], (DEPTH, DN_HEAD_DIM), jnp.float32)
    swa_q_norm_w = 1.0 + 0.02 * jax.random.normal(ks[7], (DEPTH, SWA_HEAD_DIM), jnp.float32)
    swa_k_norm_w = 1.0 + 0.02 * jax.random.normal(ks[8], (DEPTH, SWA_HEAD_DIM), jnp.float32)
    swa_sinks = jax.random.normal(ks[9], (DEPTH, SWA_Q_HEADS), jnp.float32)
    w_out = jax.random.normal(ks[10], (DEPTH, MIX_WIDTH, D_MODEL), jnp.float32) * MIX_WIDTH ** -0.5
    return {'x': x, 'norm_w': norm_w, 'w_in': w_in, 'dn_conv_w': dn_conv_w, 'dn_a_log': dn_a_log,
            'dn_dt_bias': dn_dt_bias, 'dn_out_norm_w': dn_out_norm_w, 'swa_q_norm_w': swa_q_norm_w,
            'swa_k_norm_w': swa_k_norm_w, 'swa_sinks': swa_sinks, 'w_out': w_out}


def reference(x, norm_w, w_in, dn_conv_w, dn_a_log, dn_dt_bias, dn_out_norm_w,
              swa_q_norm_w, swa_k_norm_w, swa_sinks, w_out):
    b, s, _ = x.shape
    cuts = []
    acc = 0
    for width in SPLITS[:-1]:
        acc += width
        cuts.append(acc)
    for l in range(DEPTH):
        h = rms_norm(x, norm_w[l])
        proj = h @ w_in[l].astype(h.dtype)
        (dn_q, dn_k, dn_v, dn_z, dn_beta, dn_decay,
         sw_q, sw_k, sw_v, sw_z) = jnp.split(proj, cuts, axis=-1)
        dn = gated_deltanet_bidir(dn_q, dn_k, dn_v, dn_beta, dn_decay,
                                  dn_conv_w[l], dn_a_log[l], dn_dt_bias[l])
        dn = rms_norm(dn, dn_out_norm_w[l]).reshape(b, s, DN_WIDTH)
        dn = dn * jax.nn.silu(dn_z.astype(jnp.float32))
        sw = windowed_gqa_with_sinks(sw_q, sw_k, sw_v, swa_q_norm_w[l], swa_k_norm_w[l], swa_sinks[l])
        sw = sw * jax.nn.silu(sw_z.astype(jnp.float32))
        mix = jnp.concatenate([dn, sw], axis=-1).astype(x.dtype)
        x = x + mix @ w_out[l].astype(x.dtype)
    return x
```

```cpp
#include <hip/hip_runtime.h>
#include <hip/hip_bf16.h>
#include <hip/hip_cooperative_groups.h>
#include <cstdio>
namespace cg = cooperative_groups;

#ifndef MEGA
#define MEGA 1
#endif

typedef unsigned short u16;
using bf16x8 = __attribute__((ext_vector_type(8))) short;
using f32x16 = __attribute__((ext_vector_type(16))) float;
using f32x4  = __attribute__((ext_vector_type(4))) float;
#define DI __device__ __forceinline__

constexpr int SEQ = 8192, M = 16384, D = 1024, NIN = 3344, N1 = 3328;
constexpr int C_DNQ = 0, C_DNK = 512, C_DNV = 1024, C_DNZ = 1536, C_SWQ = 2048, C_SWK = 2560, C_SWV = 2688, C_SWZ = 2816;
constexpr float EPS = 1e-6f;

constexpr size_t OFF_XN   = 0;
constexpr size_t OFF_W1   = OFF_XN + (size_t)M * 1024 * 2;
constexpr size_t OFF_W2   = OFF_W1 + (size_t)N1 * 1024 * 2;
constexpr size_t OFF_BETA = OFF_W2 + (size_t)1024 * 1024 * 2;
constexpr size_t OFF_G    = OFF_BETA + (size_t)M * 8 * 4;
constexpr size_t OFF_ROPC = OFF_G + (size_t)M * 8 * 4;
constexpr size_t OFF_ROPS = OFF_ROPC + (size_t)SEQ * 32 * 4;
constexpr size_t OFF_PROJ = OFF_ROPS + (size_t)SEQ * 32 * 4;
constexpr size_t OFF_QN   = OFF_PROJ + (size_t)M * N1 * 2;
constexpr size_t OFF_KN   = OFF_QN + (size_t)M * 512 * 2;
constexpr size_t OFF_VV   = OFF_KN + (size_t)M * 512 * 2;
constexpr size_t OFF_KR   = OFF_VV + (size_t)M * 512 * 2;
constexpr size_t OFF_END  = OFF_KR + (size_t)M * 128 * 4;

struct Params {
  const float *x, *norm_w, *w_in, *conv_w, *a_log, *dt_bias, *out_norm_w, *qnw, *knw, *sinks, *w_out;
  float* out;
  unsigned char* ws;
};

DI u16 f2bf(float x) { unsigned u = __float_as_uint(x); u += 0x7fffu + ((u >> 16) & 1u); return (u16)(u >> 16); }
DI float bf2f(u16 v) { return __uint_as_float(((unsigned)v) << 16); }
DI unsigned pack2(float a, float b) { return (unsigned)f2bf(a) | ((unsigned)f2bf(b) << 16); }
DI float wave_sum(float v) {
#pragma unroll
  for (int o = 32; o >= 1; o >>= 1) v += __shfl_xor(v, o);
  return v;
}
DI float silu(float y) { return y / (1.f + __expf(-y)); }
DI int crow(int i, int h) { return (i & 3) + 8 * (i >> 2) + 4 * h; }

__device__ void phaseA(const Params& p, int bid, int nb, unsigned char* smem_raw) {
  float* smem = (float*)smem_raw;
  const int tid = threadIdx.x, wave = tid >> 6, lane = tid & 63;
  for (int i = tid; i < 16 * 1024; i += 256) { int k = i >> 4, j = i & 15; smem[j * 1024 + k] = p.w_in[(size_t)k * NIN + 2048 + j]; }
  __syncthreads();
  u16* xn = (u16*)(p.ws + OFF_XN);
  float* betaA = (float*)(p.ws + OFF_BETA);
  float* gA = (float*)(p.ws + OFF_G);
  for (int row = bid * 4 + wave; row < M; row += nb * 4) {
    const float4* xr = (const float4*)(p.x + (size_t)row * D);
    float4 v[4]; float ss = 0.f;
#pragma unroll
    for (int i = 0; i < 4; ++i) { v[i] = xr[lane + 64 * i]; ss += v[i].x * v[i].x + v[i].y * v[i].y + v[i].z * v[i].z + v[i].w * v[i].w; }
    ss = wave_sum(ss);
    const float rstd = rsqrtf(ss * (1.f / 1024.f) + EPS);
#pragma unroll
    for (int i = 0; i < 4; ++i) {
      float4 nw = ((const float4*)p.norm_w)[lane + 64 * i];
      v[i].x *= rstd * nw.x; v[i].y *= rstd * nw.y; v[i].z *= rstd * nw.z; v[i].w *= rstd * nw.w;
      uint2 pk; pk.x = pack2(v[i].x, v[i].y); pk.y = pack2(v[i].z, v[i].w);
      *(uint2*)(xn + (size_t)row * 1024 + (lane + 64 * i) * 4) = pk;
    }
    float r = 0.f;
#pragma unroll 2
    for (int j = 0; j < 16; ++j) {
      float a = 0.f;
#pragma unroll
      for (int i = 0; i < 4; ++i) {
        float4 w = *(const float4*)&smem[j * 1024 + (lane + 64 * i) * 4];
        a += v[i].x * w.x + v[i].y * w.y + v[i].z * w.z + v[i].w * w.w;
      }
      a = wave_sum(a);
      r = (lane == j) ? a : r;
    }
    if (lane < 8) betaA[(size_t)row * 8 + lane] = 1.f / (1.f + __expf(-r));
    else if (lane < 16) {
      int idx = lane - 8;
      float xx = r + p.dt_bias[idx];
      float sp = fmaxf(xx, 0.f) + log1pf(__expf(-fabsf(xx)));
      gA[(size_t)row * 8 + idx] = -__expf(p.a_log[idx]) * sp;
    }
  }
  u16* w1 = (u16*)(p.ws + OFF_W1);
  u16* w2 = (u16*)(p.ws + OFF_W2);
  const int gt = bid * 256 + tid, gs = nb * 256;
  for (int idx = gt; idx < N1 * 128; idx += gs) {
    int n = idx % N1, kb = idx / N1;
    int col = n < 2048 ? n : n + 16;
    float f[8];
#pragma unroll
    for (int i = 0; i < 8; ++i) f[i] = p.w_in[(size_t)(kb * 8 + i) * NIN + col];
    uint4 pk; pk.x = pack2(f[0], f[1]); pk.y = pack2(f[2], f[3]); pk.z = pack2(f[4], f[5]); pk.w = pack2(f[6], f[7]);
    *(uint4*)(w1 + (size_t)n * 1024 + kb * 8) = pk;
  }
  for (int idx = gt; idx < 1024 * 128; idx += gs) {
    int n = idx & 1023, kb = idx >> 10;
    float f[8];
#pragma unroll
    for (int i = 0; i < 8; ++i) f[i] = p.w_out[(size_t)(kb * 8 + i) * 1024 + n];
    uint4 pk; pk.x = pack2(f[0], f[1]); pk.y = pack2(f[2], f[3]); pk.z = pack2(f[4], f[5]); pk.w = pack2(f[6], f[7]);
    *(uint4*)(w2 + (size_t)n * 1024 + kb * 8) = pk;
  }
  float* rc = (float*)(p.ws + OFF_ROPC);
  float* rs = (float*)(p.ws + OFF_ROPS);
  for (int idx = gt; idx < SEQ * 32; idx += gs) {
    int pos = idx >> 5, i = idx & 31;
    float inv = exp2f(-(float)i * (13.287712379549449f / 32.f));
    float ang = (float)pos * inv;
    double a = (double)ang * 0.15915494309189535;
    float fr = (float)(a - rint(a));
    rc[idx] = __builtin_amdgcn_cosf(fr); rs[idx] = __builtin_amdgcn_sinf(fr);
  }
}

template <int MODE>
__device__ void gemm_tile(const Params& p, const u16* __restrict__ A, const u16* __restrict__ Bt, int K, int m0, int n0, unsigned char* smem) {
  const int tid = threadIdx.x, wave = tid >> 6, lane = tid & 63;
  const int wm = wave >> 1, wn = wave & 1, r = lane & 31, h = lane >> 5;
  unsigned char* As = smem;
  unsigned char* Bs = smem + 32768;
  f32x16 acc[2][2];
#pragma unroll
  for (int a = 0; a < 2; ++a)
#pragma unroll
    for (int b = 0; b < 2; ++b)
#pragma unroll
      for (int i = 0; i < 16; ++i) acc[a][b][i] = 0.f;
  uint4 ra[4], rb[4];
  const int KT = K / 64;
  auto gload = [&](int kt) {
#pragma unroll
    for (int i = 0; i < 4; ++i) {
      int id = tid + 256 * i, row = id >> 3, c = id & 7;
      ra[i] = *(const uint4*)(A + (size_t)(m0 + row) * K + kt * 64 + c * 8);
      rb[i] = *(const uint4*)(Bt + (size_t)(n0 + row) * K + kt * 64 + c * 8);
    }
  };
  auto lstore = [&](int buf) {
#pragma unroll
    for (int i = 0; i < 4; ++i) {
      int id = tid + 256 * i, row = id >> 3, c = id & 7;
      int off = buf * 16384 + row * 128 + ((c ^ ((row >> 1) & 7)) << 4);
      *(uint4*)(As + off) = ra[i];
      *(uint4*)(Bs + off) = rb[i];
    }
  };
  __syncthreads();
  gload(0); lstore(0);
  __syncthreads();
  for (int kt = 0; kt < KT; ++kt) {
    if (kt + 1 < KT) gload(kt + 1);
    const int buf = kt & 1;
#pragma unroll
    for (int ks = 0; ks < 4; ++ks) {
      const int c = ks * 2 + h;
      bf16x8 af[2], bfr[2];
#pragma unroll
      for (int t = 0; t < 2; ++t) {
        int rowa = wm * 64 + t * 32 + r;
        af[t] = *(const bf16x8*)(As + buf * 16384 + rowa * 128 + ((c ^ ((rowa >> 1) & 7)) << 4));
        int rowb = wn * 64 + t * 32 + r;
        bfr[t] = *(const bf16x8*)(Bs + buf * 16384 + rowb * 128 + ((c ^ ((rowb >> 1) & 7)) << 4));
      }
#pragma unroll
      for (int a = 0; a < 2; ++a)
#pragma unroll
        for (int b = 0; b < 2; ++b) acc[a][b] = __builtin_amdgcn_mfma_f32_32x32x16_bf16(af[a], bfr[b], acc[a][b], 0, 0, 0);
    }
    if (kt + 1 < KT) lstore((kt + 1) & 1);
    __syncthreads();
  }
#pragma unroll
  for (int a = 0; a < 2; ++a)
#pragma unroll
    for (int b = 0; b < 2; ++b)
#pragma unroll
      for (int i = 0; i < 16; ++i) {
        int m = m0 + wm * 64 + a * 32 + crow(i, h);
        int n = n0 + wn * 64 + b * 32 + r;
        if (MODE == 0) ((u16*)(p.ws + OFF_PROJ))[(size_t)m * N1 + n] = f2bf(acc[a][b][i]);
        else p.out[(size_t)m * 1024 + n] = p.x[(size_t)m * 1024 + n] + acc[a][b][i];
      }
}

__device__ void phaseB(const Params& p, int bid, int nb, unsigned char* smem) {
  const u16* xn = (const u16*)(p.ws + OFF_XN);
  const u16* w1 = (const u16*)(p.ws + OFF_W1);
  for (int t = bid; t < 128 * 26; t += nb) {
    int tn = t % 26, tm = t / 26;
    gemm_tile<0>(p, xn, w1, 1024, tm * 128, tn * 128, smem);
  }
}
__device__ void phaseG(const Params& p, int bid, int nb, unsigned char* smem) {
  const u16* mix = (const u16*)(p.ws + OFF_XN);
  const u16* w2 = (const u16*)(p.ws + OFF_W2);
  for (int t = bid; t < 128 * 8; t += nb) {
    int tn = t & 7, tm = t >> 3;
    gemm_tile<1>(p, mix, w2, 1024, tm * 128, tn * 128, smem);
  }
}

__device__ void phaseC(const Params& p, int bid, int nb) {
  const int tid = threadIdx.x, wave = tid >> 6, lane = tid & 63;
  const u16* proj = (const u16*)(p.ws + OFF_PROJ);
  u16* qn = (u16*)(p.ws + OFF_QN);
  u16* kn = (u16*)(p.ws + OFF_KN);
  u16* vv = (u16*)(p.ws + OFF_VV);
  float* kr = (float*)(p.ws + OFF_KR);
  const float* rc = (const float*)(p.ws + OFF_ROPC);
  const float* rs = (const float*)(p.ws + OFF_ROPS);
  for (int item = bid * 4 + wave; item < M * 5; item += nb * 4) {
    const int m = item / 5, hh = item % 5;
    const int t = m & (SEQ - 1);
    if (hh < 4) {
      const int c0 = hh * 128 + 2 * lane;
      float y[3][2] = {{0.f, 0.f}, {0.f, 0.f}, {0.f, 0.f}};
#pragma unroll
      for (int j = 0; j < 5; ++j) {
        int tt = t + j - 2;
        if (tt >= 0 && tt < SEQ) {
          const u16* pr = proj + (size_t)(m + j - 2) * N1;
#pragma unroll
          for (int s = 0; s < 3; ++s) {
            unsigned u = *(const unsigned*)(pr + s * 512 + c0);
            float2 w = *(const float2*)(p.conv_w + j * 1536 + s * 512 + c0);
            y[s][0] += bf2f((u16)(u & 0xffff)) * w.x;
            y[s][1] += bf2f((u16)(u >> 16)) * w.y;
          }
        }
      }
#pragma unroll
      for (int s = 0; s < 3; ++s) { y[s][0] = silu(y[s][0]); y[s][1] = silu(y[s][1]); }
      float sq = wave_sum(y[0][0] * y[0][0] + y[0][1] * y[0][1]);
      float sk = wave_sum(y[1][0] * y[1][0] + y[1][1] * y[1][1]);
      float fq = rsqrtf(sq + EPS) * 0.08838834764831845f;
      float fk = rsqrtf(sk + EPS);
      *(unsigned*)(qn + (size_t)m * 512 + c0) = pack2(y[0][0] * fq, y[0][1] * fq);
      *(unsigned*)(kn + (size_t)m * 512 + c0) = pack2(y[1][0] * fk, y[1][1] * fk);
      *(unsigned*)(vv + (size_t)m * 512 + c0) = pack2(y[2][0], y[2][1]);
    } else {
      const int kvh = lane >> 5, d = lane & 31;
      const u16* pr = proj + (size_t)m * N1 + C_SWK + kvh * 64;
      float x0 = bf2f(pr[d]), x1 = bf2f(pr[d + 32]);
      float ss = x0 * x0 + x1 * x1;
#pragma unroll
      for (int o = 16; o >= 1; o >>= 1) ss += __shfl_xor(ss, o);
      float rstd = rsqrtf(ss * (1.f / 64.f) + EPS);
      float y0 = x0 * rstd * p.knw[d], y1 = x1 * rstd * p.knw[d + 32];
      float c = rc[t * 32 + d], s = rs[t * 32 + d];
      kr[(size_t)m * 128 + kvh * 64 + d] = y0 * c - y1 * s;
      kr[(size_t)m * 128 + kvh * 64 + d + 32] = y1 * c + y0 * s;
    }
  }
}

__device__ void scan_naive(const Params& p, int bid, unsigned char* smem_raw) {
  const int tid = threadIdx.x;
  const int b = bid >> 2, hh = bid & 3, dir = tid >> 7, e = tid & 127;
  float* qs = (float*)smem_raw;
  float* ks = qs + 2 * 16 * 128;
  const u16* qn = (const u16*)(p.ws + OFF_QN);
  const u16* kn = (const u16*)(p.ws + OFF_KN);
  const u16* vv = (const u16*)(p.ws + OFF_VV);
  const float* betaA = (const float*)(p.ws + OFF_BETA);
  const float* gA = (const float*)(p.ws + OFF_G);
  float* o_out = p.out + (size_t)dir * M * 512;
  float St[128];
#pragma unroll
  for (int d = 0; d < 128; ++d) St[d] = 0.f;
#pragma unroll 1
  for (int blk = 0; blk < SEQ / 16; ++blk) {
    __syncthreads();
    for (int idx = tid; idx < 4096; idx += 256) {
      int d = idx & 127, i = (idx >> 7) & 15, dd = idx >> 11;
      int t = dd ? SEQ - 1 - (blk * 16 + i) : blk * 16 + i;
      size_t mrow = (size_t)b * SEQ + t;
      qs[idx] = bf2f(qn[mrow * 512 + hh * 128 + d]);
      ks[idx] = bf2f(kn[mrow * 512 + hh * 128 + d]);
    }
    __syncthreads();
#pragma unroll 1
    for (int i = 0; i < 16; ++i) {
      int t = dir ? SEQ - 1 - (blk * 16 + i) : blk * 16 + i;
      size_t mrow = (size_t)b * SEQ + t;
      float beta = betaA[mrow * 8 + dir * 4 + hh];
      float a = __expf(gA[mrow * 8 + dir * 4 + hh]);
      float v = bf2f(vv[mrow * 512 + hh * 128 + e]);
      const float4* kk = (const float4*)(ks + (dir * 16 + i) * 128);
      const float4* qq = (const float4*)(qs + (dir * 16 + i) * 128);
      float s0 = 0.f, s1 = 0.f, s2 = 0.f, s3 = 0.f;
#pragma unroll
      for (int d4 = 0; d4 < 32; ++d4) {
        float4 k4 = kk[d4];
        s0 += k4.x * St[d4 * 4 + 0]; s1 += k4.y * St[d4 * 4 + 1]; s2 += k4.z * St[d4 * 4 + 2]; s3 += k4.w * St[d4 * 4 + 3];
      }
      float kS = (s0 + s1) + (s2 + s3);
      asm volatile("" : "+v"(kk));
      float vn = beta * (v - a * kS);
      float o0 = 0.f, o1 = 0.f, o2 = 0.f, o3 = 0.f;
#pragma unroll
      for (int d4 = 0; d4 < 32; ++d4) {
        float4 k4 = kk[d4]; float4 q4 = qq[d4];
        St[d4 * 4 + 0] = a * St[d4 * 4 + 0] + k4.x * vn; o0 += q4.x * St[d4 * 4 + 0];
        St[d4 * 4 + 1] = a * St[d4 * 4 + 1] + k4.y * vn; o1 += q4.y * St[d4 * 4 + 1];
        St[d4 * 4 + 2] = a * St[d4 * 4 + 2] + k4.z * vn; o2 += q4.z * St[d4 * 4 + 2];
        St[d4 * 4 + 3] = a * St[d4 * 4 + 3] + k4.w * vn; o3 += q4.w * St[d4 * 4 + 3];
      }
      o_out[mrow * 512 + hh * 128 + e] = (o0 + o1) + (o2 + o3);
    }
  }
}

__device__ void swa_naive(const Params& p, int bid, int nb) {
  const u16* proj = (const u16*)(p.ws + OFF_PROJ);
  const float* kr = (const float*)(p.ws + OFF_KR);
  const float* rc = (const float*)(p.ws + OFF_ROPC);
  const float* rs = (const float*)(p.ws + OFF_ROPS);
  u16* mix = (u16*)(p.ws + OFF_XN);
  for (int idx = bid * 256 + threadIdx.x; idx < M * 8; idx += nb * 256) {
    const int qh = idx >> 14, m = idx & (M - 1);
    const int t = m & (SEQ - 1), b = m >> 13, kvh = qh >> 2;
    float q[64];
    const u16* pq = proj + (size_t)m * N1 + C_SWQ + qh * 64;
    float ss = 0.f;
#pragma unroll
    for (int d = 0; d < 64; ++d) { q[d] = bf2f(pq[d]); ss += q[d] * q[d]; }
    float rstd = rsqrtf(ss * (1.f / 64.f) + EPS) * 0.125f;
#pragma unroll
    for (int d = 0; d < 32; ++d) {
      float y0 = q[d] * rstd * p.qnw[d], y1 = q[d + 32] * rstd * p.qnw[d + 32];
      float c = rc[t * 32 + d], s = rs[t * 32 + d];
      q[d] = y0 * c - y1 * s; q[d + 32] = y1 * c + y0 * s;
    }
    float mx = p.sinks[qh], l = 1.f;
    float acc[64];
#pragma unroll
    for (int d = 0; d < 64; ++d) acc[d] = 0.f;
#pragma unroll 1
    for (int rel = -128; rel <= 128; ++rel) {
      int j = t + rel;
      if (j < 0 || j >= SEQ) continue;
      size_t mj = (size_t)b * SEQ + j;
      const float4* kp = (const float4*)(kr + mj * 128 + kvh * 64);
      float s0 = 0.f, s1 = 0.f;
#pragma unroll
      for (int d4 = 0; d4 < 16; ++d4) {
        float4 k4 = kp[d4];
        s0 += q[d4 * 4] * k4.x + q[d4 * 4 + 1] * k4.y; s1 += q[d4 * 4 + 2] * k4.z + q[d4 * 4 + 3] * k4.w;
      }
      float s = s0 + s1;
      float mnew = fmaxf(mx, s);
      float corr = __expf(mx - mnew), pn = __expf(s - mnew);
      l = l * corr + pn; mx = mnew;
      const uint4* vp = (const uint4*)(proj + mj * N1 + C_SWV + kvh * 64);
#pragma unroll
      for (int d8 = 0; d8 < 8; ++d8) {
        uint4 u = vp[d8];
        unsigned w[4] = {u.x, u.y, u.z, u.w};
#pragma unroll
        for (int z = 0; z < 4; ++z) {
          acc[d8 * 8 + 2 * z]     = acc[d8 * 8 + 2 * z] * corr + pn * __uint_as_float(w[z] << 16);
          acc[d8 * 8 + 2 * z + 1] = acc[d8 * 8 + 2 * z + 1] * corr + pn * __uint_as_float(w[z] & 0xffff0000u);
        }
      }
    }
    const float invl = 1.f / l;
    const u16* pz = proj + (size_t)m * N1 + C_SWZ + qh * 64;
    u16* po = mix + (size_t)m * 1024 + 512 + qh * 64;
#pragma unroll
    for (int d = 0; d < 64; d += 2) {
      float z0 = bf2f(pz[d]), z1 = bf2f(pz[d + 1]);
      *(unsigned*)(po + d) = pack2(acc[d] * invl * silu(z0), acc[d + 1] * invl * silu(z1));
    }
  }
}

__device__ void phaseF(const Params& p, int bid, int nb) {
  const int tid = threadIdx.x, wave = tid >> 6, lane = tid & 63;
  const u16* proj = (const u16*)(p.ws + OFF_PROJ);
  u16* mix = (u16*)(p.ws + OFF_XN);
  const float* of = p.out;
  const float* ob = p.out + (size_t)M * 512;
  for (int item = bid * 4 + wave; item < M * 4; item += nb * 4) {
    const int m = item >> 2, hh = item & 3;
    const size_t o = (size_t)m * 512 + hh * 128 + 2 * lane;
    float2 a = *(const float2*)(of + o), b = *(const float2*)(ob + o);
    float v0 = a.x + b.x, v1 = a.y + b.y;
    float ss = wave_sum(v0 * v0 + v1 * v1);
    float rstd = rsqrtf(ss * (1.f / 128.f) + EPS);
    float2 w = *(const float2*)(p.out_norm_w + 2 * lane);
    unsigned uz = *(const unsigned*)(proj + (size_t)m * N1 + C_DNZ + hh * 128 + 2 * lane);
    float z0 = bf2f((u16)(uz & 0xffff)), z1 = bf2f((u16)(uz >> 16));
    *(unsigned*)(mix + (size_t)m * 1024 + hh * 128 + 2 * lane) = pack2(v0 * rstd * w.x * silu(z0), v1 * rstd * w.y * silu(z1));
  }
}

#if MEGA
__global__ void __launch_bounds__(256, 2) k_mega(Params p) {
  __shared__ __attribute__((aligned(16))) unsigned char smem[65536];
  cg::grid_group grid = cg::this_grid();
  const int bid = blockIdx.x, nb = gridDim.x;
  phaseA(p, bid, nb, smem);
  grid.sync();
  phaseB(p, bid, nb, smem);
  grid.sync();
  phaseC(p, bid, nb);
  grid.sync();
  if (bid < 8) scan_naive(p, bid, smem);
  else swa_naive(p, bid - 8, nb - 8);
  grid.sync();
  phaseF(p, bid, nb);
  grid.sync();
  phaseG(p, bid, nb, smem);
}
#else
template <int PH>
__global__ void __launch_bounds__(256, 2) k_phase(Params p) {
  __shared__ __attribute__((aligned(16))) unsigned char smem[65536];
  const int bid = blockIdx.x, nb = gridDim.x;
  if (PH == 0) phaseA(p, bid, nb, smem);
  if (PH == 1) phaseB(p, bid, nb, smem);
  if (PH == 2) phaseC(p, bid, nb);
  if (PH == 3) scan_naive(p, bid, smem);
  if (PH == 6) swa_naive(p, bid, nb);
  if (PH == 4) phaseF(p, bid, nb);
  if (PH == 5) phaseG(p, bid, nb, smem);
}
#endif

extern "C" void kernel_launch(void* const* d_in, const int* in_sizes, int n_in, void* d_out, int out_size, void* d_ws, size_t ws_size, hipStream_t stream) {
  Params p{};
  p.x = (const float*)d_in[0]; p.norm_w = (const float*)d_in[1]; p.w_in = (const float*)d_in[2]; p.conv_w = (const float*)d_in[3];
  p.a_log = (const float*)d_in[4]; p.dt_bias = (const float*)d_in[5]; p.out_norm_w = (const float*)d_in[6]; p.qnw = (const float*)d_in[7];
  p.knw = (const float*)d_in[8]; p.sinks = (const float*)d_in[9]; p.w_out = (const float*)d_in[10];
  p.out = (float*)d_out; p.ws = (unsigned char*)d_ws;
  if (ws_size < OFF_END) { fprintf(stderr, "workspace too small: %zu < %zu\n", ws_size, (size_t)OFF_END); return; }
#if MEGA
  static int grid_blocks = 0;
  if (!grid_blocks) {
    int dev = 0, cus = 0, per_cu = 0;
    hipGetDevice(&dev);
    hipDeviceGetAttribute(&cus, hipDeviceAttributeMultiprocessorCount, dev);
    hipOccupancyMaxActiveBlocksPerMultiprocessor(&per_cu, k_mega, 256, 0);
    if (per_cu > 2) per_cu = 2;
    grid_blocks = cus * per_cu;
  }
  void* args[] = {&p};
  hipError_t e = hipLaunchCooperativeKernel((void*)k_mega, dim3(grid_blocks), dim3(256), args, 0, stream);
  if (e != hipSuccess) fprintf(stderr, "cooperative launch failed: %s (grid %d)\n", hipGetErrorString(e), grid_blocks);
#else
  k_phase<0><<<512, 256, 0, stream>>>(p);
  k_phase<1><<<512, 256, 0, stream>>>(p);
  k_phase<2><<<512, 256, 0, stream>>>(p);
  k_phase<3><<<8, 256, 0, stream>>>(p);
  k_phase<6><<<512, 256, 0, stream>>>(p);
  k_phase<4><<<512, 256, 0, stream>>>(p);
  k_phase<5><<<512, 256, 0, stream>>>(p);
#endif
}
```

```cpp
#include <hip/hip_runtime.h>
#include <hip/hip_bf16.h>
#include <hip/hip_cooperative_groups.h>
#include <cstdio>
namespace cg = cooperative_groups;

#ifndef MEGA
#define MEGA 1
#endif

typedef unsigned short u16;
using bf16x8 = __attribute__((ext_vector_type(8))) short;
using f32x16 = __attribute__((ext_vector_type(16))) float;
using f32x4  = __attribute__((ext_vector_type(4))) float;
#define DI __device__ __forceinline__

constexpr int SEQ = 8192, M = 16384, D = 1024, NIN = 3344, N1 = 3328;
constexpr int C_DNQ = 0, C_DNK = 512, C_DNV = 1024, C_DNZ = 1536, C_SWQ = 2048, C_SWK = 2560, C_SWV = 2688, C_SWZ = 2816;
constexpr float EPS = 1e-6f;

constexpr int LDA = 1536, LDB = 1792;
constexpr int B_DNZ = 0, B_SWQ = 512, B_SWK = 1024, B_SWV = 1152, B_SWZ = 1280;
constexpr size_t OFF_XN   = 0;
constexpr size_t OFF_W1   = OFF_XN + (size_t)M * 1024 * 2;
constexpr size_t OFF_W2   = OFF_W1 + (size_t)N1 * 1024 * 2;
constexpr size_t OFF_BETA = OFF_W2 + (size_t)1024 * 1024 * 2;
constexpr size_t OFF_G    = OFF_BETA + (size_t)M * 8 * 4;
constexpr size_t OFF_ROPC = OFF_G + (size_t)M * 8 * 4;
constexpr size_t OFF_ROPS = OFF_ROPC + (size_t)SEQ * 32 * 4;
constexpr size_t OFF_PROJB= OFF_ROPS + (size_t)SEQ * 32 * 4;
constexpr size_t OFF_QN   = OFF_PROJB + (size_t)M * LDB * 2;
constexpr size_t OFF_KN   = OFF_QN + (size_t)M * 512 * 2;
constexpr size_t OFF_VV   = OFF_KN + (size_t)M * 512 * 2;
constexpr size_t OFF_PROJA= OFF_VV + (size_t)M * 512 * 2;
constexpr size_t OFF_PW   = OFF_PROJA;
constexpr size_t OFF_PU   = OFF_PW + (size_t)2048 * 8192 * 2;
constexpr size_t OFF_PK   = OFF_PU + (size_t)2048 * 8192 * 2;
constexpr size_t OFF_END  = OFF_PK + (size_t)2048 * 8192 * 2;
constexpr size_t DO_OB = (size_t)M * 512 * 2, DO_KR = (size_t)M * 512 * 4, DO_PA = DO_KR + (size_t)M * 128 * 4, DO_PE = DO_PA + (size_t)2048 * 4096 * 2, DO_PGL = DO_PE + (size_t)2048 * 64 * 4;
static_assert(DO_PGL + 2048 * 4 <= (size_t)M * 1024 * 4, "d_out scratch overflow");
static_assert(OFF_END <= (size_t)256 * 1024 * 1024, "workspace overflow");

struct Params {
  const float *x, *norm_w, *w_in, *conv_w, *a_log, *dt_bias, *out_norm_w, *qnw, *knw, *sinks, *w_out;
  float* out;
  unsigned char* ws;
};

DI u16 f2bf(float x) { unsigned u = __float_as_uint(x); u += 0x7fffu + ((u >> 16) & 1u); return (u16)(u >> 16); }
DI float bf2f(u16 v) { return __uint_as_float(((unsigned)v) << 16); }
DI unsigned pack2(float a, float b) { return (unsigned)f2bf(a) | ((unsigned)f2bf(b) << 16); }
DI float wave_sum(float v) {
#pragma unroll
  for (int o = 32; o >= 1; o >>= 1) v += __shfl_xor(v, o);
  return v;
}
DI float silu(float y) { return y / (1.f + __expf(-y)); }
DI int crow(int i, int h) { return (i & 3) + 8 * (i >> 2) + 4 * h; }

__device__ void phaseA(const Params& p, int bid, int nb, unsigned char* smem_raw) {
  float* smem = (float*)smem_raw;
  const int tid = threadIdx.x, wave = tid >> 6, lane = tid & 63;
  for (int i = tid; i < 16 * 1024; i += 256) { int k = i >> 4, j = i & 15; smem[j * 1024 + k] = p.w_in[(size_t)k * NIN + 2048 + j]; }
  __syncthreads();
  u16* xn = (u16*)(p.ws + OFF_XN);
  float* betaA = (float*)(p.ws + OFF_BETA);
  float* gA = (float*)(p.ws + OFF_G);
  for (int row = bid * 4 + wave; row < M; row += nb * 4) {
    const float4* xr = (const float4*)(p.x + (size_t)row * D);
    float4 v[4]; float ss = 0.f;
#pragma unroll
    for (int i = 0; i < 4; ++i) { v[i] = xr[lane + 64 * i]; ss += v[i].x * v[i].x + v[i].y * v[i].y + v[i].z * v[i].z + v[i].w * v[i].w; }
    ss = wave_sum(ss);
    const float rstd = rsqrtf(ss * (1.f / 1024.f) + EPS);
#pragma unroll
    for (int i = 0; i < 4; ++i) {
      float4 nw = ((const float4*)p.norm_w)[lane + 64 * i];
      v[i].x *= rstd * nw.x; v[i].y *= rstd * nw.y; v[i].z *= rstd * nw.z; v[i].w *= rstd * nw.w;
      uint2 pk; pk.x = pack2(v[i].x, v[i].y); pk.y = pack2(v[i].z, v[i].w);
      *(uint2*)(xn + (size_t)row * 1024 + (lane + 64 * i) * 4) = pk;
    }
    float r = 0.f;
#pragma unroll 2
    for (int j = 0; j < 16; ++j) {
      float a = 0.f;
#pragma unroll
      for (int i = 0; i < 4; ++i) {
        float4 w = *(const float4*)&smem[j * 1024 + (lane + 64 * i) * 4];
        a += v[i].x * w.x + v[i].y * w.y + v[i].z * w.z + v[i].w * w.w;
      }
      a = wave_sum(a);
      r = (lane == j) ? a : r;
    }
    if (lane < 8) betaA[(size_t)row * 8 + lane] = 1.f / (1.f + __expf(-r));
    else if (lane < 16) {
      int idx = lane - 8;
      float xx = r + p.dt_bias[idx];
      float sp = fmaxf(xx, 0.f) + log1pf(__expf(-fabsf(xx)));
      gA[(size_t)row * 8 + idx] = -__expf(p.a_log[idx]) * sp;
    }
  }
  u16* w1 = (u16*)(p.ws + OFF_W1);
  u16* w2 = (u16*)(p.ws + OFF_W2);
  const int gt = bid * 256 + tid, gs = nb * 256;
  for (int idx = gt; idx < N1 * 128; idx += gs) {
    int n = idx % N1, kb = idx / N1;
    int col = n < 2048 ? n : n + 16;
    float f[8];
#pragma unroll
    for (int i = 0; i < 8; ++i) f[i] = p.w_in[(size_t)(kb * 8 + i) * NIN + col];
    uint4 pk; pk.x = pack2(f[0], f[1]); pk.y = pack2(f[2], f[3]); pk.z = pack2(f[4], f[5]); pk.w = pack2(f[6], f[7]);
    *(uint4*)(w1 + (size_t)n * 1024 + kb * 8) = pk;
  }
  for (int idx = gt; idx < 1024 * 128; idx += gs) {
    int n = idx & 1023, kb = idx >> 10;
    float f[8];
#pragma unroll
    for (int i = 0; i < 8; ++i) f[i] = p.w_out[(size_t)(kb * 8 + i) * 1024 + n];
    uint4 pk; pk.x = pack2(f[0], f[1]); pk.y = pack2(f[2], f[3]); pk.z = pack2(f[4], f[5]); pk.w = pack2(f[6], f[7]);
    *(uint4*)(w2 + (size_t)n * 1024 + kb * 8) = pk;
  }
  float* rc = (float*)(p.ws + OFF_ROPC);
  float* rs = (float*)(p.ws + OFF_ROPS);
  for (int idx = gt; idx < SEQ * 32; idx += gs) {
    int pos = idx >> 5, i = idx & 31;
    float inv = exp2f(-(float)i * (13.287712379549449f / 32.f));
    float ang = (float)pos * inv;
    double a = (double)ang * 0.15915494309189535;
    float fr = (float)(a - rint(a));
    rc[idx] = __builtin_amdgcn_cosf(fr); rs[idx] = __builtin_amdgcn_sinf(fr);
  }
}

template <int MODE>
__device__ void gemm_tile(const Params& p, const u16* __restrict__ A, const u16* __restrict__ Bt, int K, int m0, int n0, unsigned char* smem) {
  const int tid = threadIdx.x, wave = tid >> 6, lane = tid & 63;
  const int wm = wave >> 1, wn = wave & 1, r = lane & 31, h = lane >> 5;
  unsigned char* As = smem;
  unsigned char* Bs = smem + 32768;
  f32x16 acc[2][2];
#pragma unroll
  for (int a = 0; a < 2; ++a)
#pragma unroll
    for (int b = 0; b < 2; ++b)
#pragma unroll
      for (int i = 0; i < 16; ++i) acc[a][b][i] = 0.f;
  uint4 ra[4], rb[4];
  const int KT = K / 64;
  auto gload = [&](int kt) {
#pragma unroll
    for (int i = 0; i < 4; ++i) {
      int id = tid + 256 * i, row = id >> 3, c = id & 7;
      ra[i] = *(const uint4*)(A + (size_t)(m0 + row) * K + kt * 64 + c * 8);
      rb[i] = *(const uint4*)(Bt + (size_t)(n0 + row) * K + kt * 64 + c * 8);
    }
  };
  auto lstore = [&](int buf) {
#pragma unroll
    for (int i = 0; i < 4; ++i) {
      int id = tid + 256 * i, row = id >> 3, c = id & 7;
      int off = buf * 16384 + row * 128 + ((c ^ ((row >> 1) & 7)) << 4);
      *(uint4*)(As + off) = ra[i];
      *(uint4*)(Bs + off) = rb[i];
    }
  };
  __syncthreads();
  gload(0); lstore(0);
  __syncthreads();
  for (int kt = 0; kt < KT; ++kt) {
    if (kt + 1 < KT) gload(kt + 1);
    const int buf = kt & 1;
#pragma unroll
    for (int ks = 0; ks < 4; ++ks) {
      const int c = ks * 2 + h;
      bf16x8 af[2], bfr[2];
#pragma unroll
      for (int t = 0; t < 2; ++t) {
        int rowa = wm * 64 + t * 32 + r;
        af[t] = *(const bf16x8*)(As + buf * 16384 + rowa * 128 + ((c ^ ((rowa >> 1) & 7)) << 4));
        int rowb = wn * 64 + t * 32 + r;
        bfr[t] = *(const bf16x8*)(Bs + buf * 16384 + rowb * 128 + ((c ^ ((rowb >> 1) & 7)) << 4));
      }
#pragma unroll
      for (int a = 0; a < 2; ++a)
#pragma unroll
        for (int b = 0; b < 2; ++b) acc[a][b] = __builtin_amdgcn_mfma_f32_32x32x16_bf16(af[a], bfr[b], acc[a][b], 0, 0, 0);
    }
    if (kt + 1 < KT) lstore((kt + 1) & 1);
    __syncthreads();
  }
#pragma unroll
  for (int a = 0; a < 2; ++a)
#pragma unroll
    for (int b = 0; b < 2; ++b)
#pragma unroll
      for (int i = 0; i < 16; ++i) {
        int m = m0 + wm * 64 + a * 32 + crow(i, h);
        int n = n0 + wn * 64 + b * 32 + r;
        if (MODE == 0) {
          if (n0 < 1536) ((u16*)(p.ws + OFF_PROJA))[(size_t)m * LDA + n] = f2bf(acc[a][b][i]);
          else ((u16*)(p.ws + OFF_PROJB))[(size_t)m * LDB + (n - 1536)] = f2bf(acc[a][b][i]);
        }
        else p.out[(size_t)m * 1024 + n] = p.x[(size_t)m * 1024 + n] + acc[a][b][i];
      }
}

__device__ void phaseB(const Params& p, int bid, int nb, unsigned char* smem) {
  const u16* xn = (const u16*)(p.ws + OFF_XN);
  const u16* w1 = (const u16*)(p.ws + OFF_W1);
  for (int t = bid; t < 128 * 26; t += nb) {
    int tn = t % 26, tm = t / 26;
    gemm_tile<0>(p, xn, w1, 1024, tm * 128, tn * 128, smem);
  }
}
__device__ void phaseG(const Params& p, int bid, int nb, unsigned char* smem) {
  const u16* mix = (const u16*)(p.ws + OFF_XN);
  const u16* w2 = (const u16*)(p.ws + OFF_W2);
  for (int t = bid; t < 128 * 8; t += nb) {
    int tn = t & 7, tm = t >> 3;
    gemm_tile<1>(p, mix, w2, 1024, tm * 128, tn * 128, smem);
  }
}

__device__ void phaseC(const Params& p, int bid, int nb) {
  const int tid = threadIdx.x, wave = tid >> 6, lane = tid & 63;
  const u16* projA = (const u16*)(p.ws + OFF_PROJA);
  const u16* projB = (const u16*)(p.ws + OFF_PROJB);
  u16* qn = (u16*)(p.ws + OFF_QN);
  u16* kn = (u16*)(p.ws + OFF_KN);
  u16* vv = (u16*)(p.ws + OFF_VV);
  float* kr = (float*)((unsigned char*)p.out + DO_KR);
  const float* rc = (const float*)(p.ws + OFF_ROPC);
  const float* rs = (const float*)(p.ws + OFF_ROPS);
  for (int item = bid * 4 + wave; item < M * 5; item += nb * 4) {
    const int m = item / 5, hh = item % 5;
    const int t = m & (SEQ - 1);
    if (hh < 4) {
      const int c0 = hh * 128 + 2 * lane;
      float y[3][2] = {{0.f, 0.f}, {0.f, 0.f}, {0.f, 0.f}};
#pragma unroll
      for (int j = 0; j < 5; ++j) {
        int tt = t + j - 2;
        if (tt >= 0 && tt < SEQ) {
          const u16* pr = projA + (size_t)(m + j - 2) * LDA;
#pragma unroll
          for (int s = 0; s < 3; ++s) {
            unsigned u = *(const unsigned*)(pr + s * 512 + c0);
            float2 w = *(const float2*)(p.conv_w + j * 1536 + s * 512 + c0);
            y[s][0] += bf2f((u16)(u & 0xffff)) * w.x;
            y[s][1] += bf2f((u16)(u >> 16)) * w.y;
          }
        }
      }
#pragma unroll
      for (int s = 0; s < 3; ++s) { y[s][0] = silu(y[s][0]); y[s][1] = silu(y[s][1]); }
      float sq = wave_sum(y[0][0] * y[0][0] + y[0][1] * y[0][1]);
      float sk = wave_sum(y[1][0] * y[1][0] + y[1][1] * y[1][1]);
      float fq = rsqrtf(sq + EPS) * 0.08838834764831845f;
      float fk = rsqrtf(sk + EPS);
      *(unsigned*)(qn + (size_t)m * 512 + c0) = pack2(y[0][0] * fq, y[0][1] * fq);
      *(unsigned*)(kn + (size_t)m * 512 + c0) = pack2(y[1][0] * fk, y[1][1] * fk);
      *(unsigned*)(vv + (size_t)m * 512 + c0) = pack2(y[2][0], y[2][1]);
    } else {
      const int kvh = lane >> 5, d = lane & 31;
      const u16* pr = projB + (size_t)m * LDB + B_SWK + kvh * 64;
      float x0 = bf2f(pr[d]), x1 = bf2f(pr[d + 32]);
      float ss = x0 * x0 + x1 * x1;
#pragma unroll
      for (int o = 16; o >= 1; o >>= 1) ss += __shfl_xor(ss, o);
      float rstd = rsqrtf(ss * (1.f / 64.f) + EPS);
      float y0 = x0 * rstd * p.knw[d], y1 = x1 * rstd * p.knw[d + 32];
      float c = rc[t * 32 + d], s = rs[t * 32 + d];
      kr[(size_t)m * 128 + kvh * 64 + d] = y0 * c - y1 * s;
      kr[(size_t)m * 128 + kvh * 64 + d + 32] = y1 * c + y0 * s;
    }
  }
}

#define MFMA16(a, b, c) __builtin_amdgcn_mfma_f32_16x16x32_bf16((a), (b), (c), 0, 0, 0)
__device__ void prep_tile(const Params& p, int tile, unsigned char* smem) {
  const int tid = threadIdx.x, wave = tid >> 6, lane = tid & 63;
  const int dir = tile & 1, n = (tile >> 1) & 127, bh = tile >> 8, b = bh >> 2, hh = bh & 3;
  unsigned char* ksb = smem;
  unsigned char* qsb = smem + 17408;
  float* Ms = (float*)(smem + 34816);
  float* gc = (float*)(smem + 51200);
  float* bt = gc + 64;
  const u16* qn = (const u16*)(p.ws + OFF_QN);
  const u16* kn = (const u16*)(p.ws + OFF_KN);
  const u16* vv = (const u16*)(p.ws + OFF_VV);
  const float* betaA = (const float*)(p.ws + OFF_BETA);
  const float* gA = (const float*)(p.ws + OFF_G);
  u16* pw = (u16*)(p.ws + OFF_PW) + (size_t)tile * 8192;
  u16* pu = (u16*)(p.ws + OFF_PU) + (size_t)tile * 8192;
  u16* pk = (u16*)(p.ws + OFF_PK) + (size_t)tile * 8192;
  u16* pa = (u16*)((unsigned char*)p.out + DO_PA) + (size_t)tile * 4096;
  float* pe = (float*)((unsigned char*)p.out + DO_PE) + (size_t)tile * 64;
  float* pgl = (float*)((unsigned char*)p.out + DO_PGL);
  const size_t row0 = (size_t)b * SEQ + n * 64;
  __syncthreads();
#pragma unroll
  for (int i = 0; i < 4; ++i) {
    int id = tid + 256 * i, c = id >> 4, ch = id & 15;
    int tok = dir ? 63 - c : c;
    *(uint4*)(ksb + c * 272 + ch * 16) = *(const uint4*)(kn + (row0 + tok) * 512 + hh * 128 + ch * 8);
    *(uint4*)(qsb + c * 272 + ch * 16) = *(const uint4*)(qn + (row0 + tok) * 512 + hh * 128 + ch * 8);
  }
  if (wave == 0) {
    int tok = dir ? 63 - lane : lane;
    float g = gA[(row0 + tok) * 8 + dir * 4 + hh];
    float bb = betaA[(row0 + tok) * 8 + dir * 4 + hh];
#pragma unroll
    for (int o = 1; o < 64; o <<= 1) { float t = __shfl_up(g, o); if (lane >= o) g += t; }
    gc[lane] = g; bt[lane] = bb;
    pe[lane] = __expf(g);
    if (lane == 63) pgl[tile] = __expf(g);
  }
  __syncthreads();
  {
    const int row = lane & 15, quad = lane >> 4;
    bf16x8 ak[4], aq[4];
#pragma unroll
    for (int k = 0; k < 4; ++k) {
      ak[k] = *(const bf16x8*)(ksb + (16 * wave + row) * 272 + k * 64 + quad * 16);
      aq[k] = *(const bf16x8*)(qsb + (16 * wave + row) * 272 + k * 64 + quad * 16);
    }
#pragma unroll
    for (int tc = 0; tc < 4; ++tc) {
      f32x4 ckk = {0.f, 0.f, 0.f, 0.f}, cqk = {0.f, 0.f, 0.f, 0.f};
#pragma unroll
      for (int k = 0; k < 4; ++k) {
        bf16x8 bk = *(const bf16x8*)(ksb + (16 * tc + row) * 272 + k * 64 + quad * 16);
        ckk = MFMA16(ak[k], bk, ckk);
        cqk = MFMA16(aq[k], bk, cqk);
      }
      const int s = 16 * tc + row;
      const float gs = gc[s];
#pragma unroll
      for (int j = 0; j < 4; ++j) {
        const int c = 16 * wave + quad * 4 + j;
        float dec = __expf(fminf(gc[c] - gs, 0.f));
        float mval = (s < c) ? bt[c] * ckk[j] * dec : 0.f;
        float aval = (s <= c) ? cqk[j] * dec : 0.f;
        Ms[c * 64 + s] = mval;
        pa[c * 64 + s] = f2bf(aval);
      }
    }
  }
  {
    const int dk = tid & 127, half = tid >> 7;
    const float gl = gc[63];
    unsigned pkd[16];
#pragma unroll
    for (int i = 0; i < 16; ++i) {
      int c0 = half * 32 + 2 * i;
      float k0 = bf2f(*(const u16*)(ksb + c0 * 272 + dk * 2)) * __expf(gl - gc[c0]);
      float k1 = bf2f(*(const u16*)(ksb + (c0 + 1) * 272 + dk * 2)) * __expf(gl - gc[c0 + 1]);
      pkd[i] = pack2(k0, k1);
    }
#pragma unroll
    for (int i = 0; i < 4; ++i) *(uint4*)(pk + dk * 64 + half * 32 + i * 8) = make_uint4(pkd[4 * i], pkd[4 * i + 1], pkd[4 * i + 2], pkd[4 * i + 3]);
  }
  __syncthreads();
  float x[64];
  if (tid < 128) {
#pragma unroll
    for (int c = 0; c < 64; ++c) { int tok = dir ? 63 - c : c; x[c] = bt[c] * bf2f(vv[(row0 + tok) * 512 + hh * 128 + tid]); }
  } else {
#pragma unroll
    for (int c = 0; c < 64; ++c) x[c] = bt[c] * __expf(gc[c]) * bf2f(*(const u16*)(ksb + c * 272 + (tid - 128) * 2));
  }
#pragma unroll
  for (int c = 1; c < 64; ++c) {
    const float4* mr = (const float4*)(Ms + c * 64);
    float a0 = 0.f, a1 = 0.f;
#pragma unroll
    for (int s4 = 0; s4 < (c + 3) / 4; ++s4) {
      float4 m = mr[s4];
      a0 += m.x * x[4 * s4] + m.y * x[4 * s4 + 1];
      a1 += m.z * x[4 * s4 + 2] + m.w * x[4 * s4 + 3];
    }
    x[c] -= a0 + a1;
  }
  if (tid < 128) {
#pragma unroll
    for (int i = 0; i < 8; ++i)
      *(uint4*)(pu + tid * 64 + i * 8) = make_uint4(pack2(x[8 * i], x[8 * i + 1]), pack2(x[8 * i + 2], x[8 * i + 3]), pack2(x[8 * i + 4], x[8 * i + 5]), pack2(x[8 * i + 6], x[8 * i + 7]));
  } else {
#pragma unroll
    for (int c = 0; c < 64; ++c) *(u16*)(qsb + c * 272 + (tid - 128) * 2) = f2bf(-x[c]);
  }
  __syncthreads();
#pragma unroll
  for (int i = 0; i < 4; ++i) {
    int id = tid + 256 * i, c = id >> 4, ch = id & 15;
    *(uint4*)(pw + c * 128 + ch * 8) = *(const uint4*)(qsb + c * 272 + ch * 16);
  }
}

struct ScanFrags { bf16x8 aw[4], aq[4], aa[2], akd[2][2]; uint2 u[2]; float4 eg; float egl; };
__device__ void scan_chunked(const Params& p, int sid, unsigned char* smem) {
  const int tid = threadIdx.x, wave = tid >> 6, lane = tid & 63, row = lane & 15, quad = lane >> 4;
  const int chain = sid >> 2, dv0 = (sid & 3) * 32;
  const int b = chain >> 3, hh = (chain >> 1) & 3, dir = chain & 1;
  unsigned char* Sl = smem;
  unsigned char* Vl = smem + 8704;
  const u16* qn = (const u16*)(p.ws + OFF_QN);
  const u16* pwA = (const u16*)(p.ws + OFF_PW);
  const u16* puA = (const u16*)(p.ws + OFF_PU);
  const u16* pkA = (const u16*)(p.ws + OFF_PK);
  const u16* paA = (const u16*)((unsigned char*)p.out + DO_PA);
  const float* peA = (const float*)((unsigned char*)p.out + DO_PE);
  const float* pglA = (const float*)((unsigned char*)p.out + DO_PGL);
  u16* ob = (u16*)((unsigned char*)p.out + (dir ? DO_OB : 0));
  __syncthreads();
  for (int i = tid; i < 8704 / 4; i += 256) ((unsigned*)Sl)[i] = 0u;
  f32x4 Sacc[2][2];
#pragma unroll
  for (int a = 0; a < 2; ++a)
#pragma unroll
    for (int c = 0; c < 2; ++c) Sacc[a][c] = f32x4{0.f, 0.f, 0.f, 0.f};
  auto gload = [&](ScanFrags& f, int step) {
    const int n = dir ? 127 - step : step;
    const size_t tile = ((size_t)(b * 4 + hh) * 128 + n) * 2 + dir;
    const int c = 16 * wave + row;
    const int tok = dir ? 63 - c : c;
    const size_t qrow = ((size_t)b * SEQ + n * 64 + tok) * 512 + hh * 128;
#pragma unroll
    for (int k = 0; k < 4; ++k) {
      f.aw[k] = *(const bf16x8*)(pwA + tile * 8192 + c * 128 + k * 32 + quad * 8);
      f.aq[k] = *(const bf16x8*)(qn + qrow + k * 32 + quad * 8);
    }
#pragma unroll
    for (int k = 0; k < 2; ++k) {
      f.aa[k] = *(const bf16x8*)(paA + tile * 4096 + c * 64 + k * 32 + quad * 8);
#pragma unroll
      for (int d = 0; d < 2; ++d) f.akd[d][k] = *(const bf16x8*)(pkA + tile * 8192 + (32 * wave + 16 * d + row) * 64 + k * 32 + quad * 8);
    }
#pragma unroll
    for (int nt = 0; nt < 2; ++nt) f.u[nt] = *(const uint2*)(puA + tile * 8192 + (dv0 + nt * 16 + row) * 64 + 16 * wave + quad * 4);
    f.eg = *(const float4*)(peA + tile * 64 + 16 * wave + quad * 4);
    f.egl = pglA[tile];
  };
  auto body = [&](ScanFrags& f, ScanFrags& fn, int step) {
    if (step + 1 < 128) gload(fn, step + 1);
    bf16x8 bS[4][2];
#pragma unroll
    for (int k = 0; k < 4; ++k)
#pragma unroll
      for (int nt = 0; nt < 2; ++nt) bS[k][nt] = *(const bf16x8*)(Sl + (nt * 16 + row) * 272 + k * 64 + quad * 16);
    f32x4 vacc[2], oacc[2];
#pragma unroll
    for (int nt = 0; nt < 2; ++nt) {
      vacc[nt] = f32x4{__uint_as_float(f.u[nt].x << 16), __uint_as_float(f.u[nt].x & 0xffff0000u), __uint_as_float(f.u[nt].y << 16), __uint_as_float(f.u[nt].y & 0xffff0000u)};
      oacc[nt] = f32x4{0.f, 0.f, 0.f, 0.f};
#pragma unroll
      for (int k = 0; k < 4; ++k) vacc[nt] = MFMA16(f.aw[k], bS[k][nt], vacc[nt]);
      *(uint2*)(Vl + (nt * 16 + row) * 144 + (16 * wave + quad * 4) * 2) = make_uint2(pack2(vacc[nt][0], vacc[nt][1]), pack2(vacc[nt][2], vacc[nt][3]));
    }
#pragma unroll
    for (int nt = 0; nt < 2; ++nt) {
#pragma unroll
      for (int k = 0; k < 4; ++k) oacc[nt] = MFMA16(f.aq[k], bS[k][nt], oacc[nt]);
      oacc[nt][0] *= f.eg.x; oacc[nt][1] *= f.eg.y; oacc[nt][2] *= f.eg.z; oacc[nt][3] *= f.eg.w;
    }
    __syncthreads();
    bf16x8 bV[2][2];
#pragma unroll
    for (int k = 0; k < 2; ++k)
#pragma unroll
      for (int nt = 0; nt < 2; ++nt) bV[k][nt] = *(const bf16x8*)(Vl + (nt * 16 + row) * 144 + k * 64 + quad * 16);
#pragma unroll
    for (int d = 0; d < 2; ++d)
#pragma unroll
      for (int nt = 0; nt < 2; ++nt) {
        Sacc[d][nt] *= f.egl;
#pragma unroll
        for (int k = 0; k < 2; ++k) Sacc[d][nt] = MFMA16(f.akd[d][k], bV[k][nt], Sacc[d][nt]);
        *(uint2*)(Sl + (nt * 16 + row) * 272 + (32 * wave + 16 * d + quad * 4) * 2) = make_uint2(pack2(Sacc[d][nt][0], Sacc[d][nt][1]), pack2(Sacc[d][nt][2], Sacc[d][nt][3]));
      }
    const int n = dir ? 127 - step : step;
#pragma unroll
    for (int nt = 0; nt < 2; ++nt) {
#pragma unroll
      for (int k = 0; k < 2; ++k) oacc[nt] = MFMA16(f.aa[k], bV[k][nt], oacc[nt]);
#pragma unroll
      for (int j = 0; j < 4; ++j) {
        const int c = 16 * wave + quad * 4 + j;
        const int tok = dir ? 63 - c : c;
        ob[((size_t)b * SEQ + n * 64 + tok) * 512 + hh * 128 + dv0 + nt * 16 + row] = f2bf(oacc[nt][j]);
      }
    }
    __syncthreads();
  };
  ScanFrags f0, f1;
  gload(f0, 0);
  __syncthreads();
#pragma unroll 1
  for (int step = 0; step < 128; step += 2) {
    body(f0, f1, step);
    body(f1, f0, step + 1);
  }
}

__device__ void swa_naive(const Params& p, int bid, int nb) {
  const u16* proj = (const u16*)(p.ws + OFF_PROJB);
  const float* kr = (const float*)((const unsigned char*)p.out + DO_KR);
  const float* rc = (const float*)(p.ws + OFF_ROPC);
  const float* rs = (const float*)(p.ws + OFF_ROPS);
  u16* mix = (u16*)(p.ws + OFF_XN);
  for (int idx = bid * 256 + threadIdx.x; idx < M * 8; idx += nb * 256) {
    const int qh = idx >> 14, m = idx & (M - 1);
    const int t = m & (SEQ - 1), b = m >> 13, kvh = qh >> 2;
    float q[64];
    const u16* pq = proj + (size_t)m * LDB + B_SWQ + qh * 64;
    float ss = 0.f;
#pragma unroll
    for (int d = 0; d < 64; ++d) { q[d] = bf2f(pq[d]); ss += q[d] * q[d]; }
    float rstd = rsqrtf(ss * (1.f / 64.f) + EPS) * 0.125f;
#pragma unroll
    for (int d = 0; d < 32; ++d) {
      float y0 = q[d] * rstd * p.qnw[d], y1 = q[d + 32] * rstd * p.qnw[d + 32];
      float c = rc[t * 32 + d], s = rs[t * 32 + d];
      q[d] = y0 * c - y1 * s; q[d + 32] = y1 * c + y0 * s;
    }
    float mx = p.sinks[qh], l = 1.f;
    float acc[64];
#pragma unroll
    for (int d = 0; d < 64; ++d) acc[d] = 0.f;
#pragma unroll 1
    for (int rel = -128; rel <= 128; ++rel) {
      int j = t + rel;
      if (j < 0 || j >= SEQ) continue;
      size_t mj = (size_t)b * SEQ + j;
      const float4* kp = (const float4*)(kr + mj * 128 + kvh * 64);
      float s0 = 0.f, s1 = 0.f;
#pragma unroll
      for (int d4 = 0; d4 < 16; ++d4) {
        float4 k4 = kp[d4];
        s0 += q[d4 * 4] * k4.x + q[d4 * 4 + 1] * k4.y; s1 += q[d4 * 4 + 2] * k4.z + q[d4 * 4 + 3] * k4.w;
      }
      float s = s0 + s1;
      float mnew = fmaxf(mx, s);
      float corr = __expf(mx - mnew), pn = __expf(s - mnew);
      l = l * corr + pn; mx = mnew;
      const uint4* vp = (const uint4*)(proj + mj * LDB + B_SWV + kvh * 64);
#pragma unroll
      for (int d8 = 0; d8 < 8; ++d8) {
        uint4 u = vp[d8];
        unsigned w[4] = {u.x, u.y, u.z, u.w};
#pragma unroll
        for (int z = 0; z < 4; ++z) {
          acc[d8 * 8 + 2 * z]     = acc[d8 * 8 + 2 * z] * corr + pn * __uint_as_float(w[z] << 16);
          acc[d8 * 8 + 2 * z + 1] = acc[d8 * 8 + 2 * z + 1] * corr + pn * __uint_as_float(w[z] & 0xffff0000u);
        }
      }
    }
    const float invl = 1.f / l;
    const u16* pz = proj + (size_t)m * LDB + B_SWZ + qh * 64;
    u16* po = mix + (size_t)m * 1024 + 512 + qh * 64;
#pragma unroll
    for (int d = 0; d < 64; d += 2) {
      float z0 = bf2f(pz[d]), z1 = bf2f(pz[d + 1]);
      *(unsigned*)(po + d) = pack2(acc[d] * invl * silu(z0), acc[d + 1] * invl * silu(z1));
    }
  }
}

__device__ void phaseF(const Params& p, int bid, int nb) {
  const int tid = threadIdx.x, wave = tid >> 6, lane = tid & 63;
  const u16* proj = (const u16*)(p.ws + OFF_PROJB);
  u16* mix = (u16*)(p.ws + OFF_XN);
  const u16* of = (const u16*)p.out;
  const u16* ob = (const u16*)((const unsigned char*)p.out + DO_OB);
  for (int item = bid * 4 + wave; item < M * 4; item += nb * 4) {
    const int m = item >> 2, hh = item & 3;
    const size_t o = (size_t)m * 512 + hh * 128 + 2 * lane;
    unsigned ua = *(const unsigned*)(of + o), ub = *(const unsigned*)(ob + o);
    float v0 = bf2f((u16)(ua & 0xffff)) + bf2f((u16)(ub & 0xffff)), v1 = bf2f((u16)(ua >> 16)) + bf2f((u16)(ub >> 16));
    float ss = wave_sum(v0 * v0 + v1 * v1);
    float rstd = rsqrtf(ss * (1.f / 128.f) + EPS);
    float2 w = *(const float2*)(p.out_norm_w + 2 * lane);
    unsigned uz = *(const unsigned*)(proj + (size_t)m * LDB + B_DNZ + hh * 128 + 2 * lane);
    float z0 = bf2f((u16)(uz & 0xffff)), z1 = bf2f((u16)(uz >> 16));
    *(unsigned*)(mix + (size_t)m * 1024 + hh * 128 + 2 * lane) = pack2(v0 * rstd * w.x * silu(z0), v1 * rstd * w.y * silu(z1));
  }
}

#if MEGA
__global__ void __launch_bounds__(256, 2) k_mega(Params p) {
  __shared__ __attribute__((aligned(16))) unsigned char smem[65536];
  cg::grid_group grid = cg::this_grid();
  const int bid = blockIdx.x, nb = gridDim.x;
  phaseA(p, bid, nb, smem);
  grid.sync();
  phaseB(p, bid, nb, smem);
  grid.sync();
  phaseC(p, bid, nb);
  grid.sync();
  for (int t = bid; t < 2048; t += nb) prep_tile(p, t, smem);
  grid.sync();
  if (bid < 64) scan_chunked(p, bid, smem);
  else swa_naive(p, bid - 64, nb - 64);
  grid.sync();
  phaseF(p, bid, nb);
  grid.sync();
  phaseG(p, bid, nb, smem);
}
#else
template <int PH>
__global__ void __launch_bounds__(256, 2) k_phase(Params p) {
  __shared__ __attribute__((aligned(16))) unsigned char smem[65536];
  const int bid = blockIdx.x, nb = gridDim.x;
  if (PH == 0) phaseA(p, bid, nb, smem);
  if (PH == 1) phaseB(p, bid, nb, smem);
  if (PH == 2) phaseC(p, bid, nb);
  if (PH == 3) scan_chunked(p, bid, smem);
  if (PH == 6) swa_naive(p, bid, nb);
  if (PH == 7) for (int t = bid; t < 2048; t += nb) prep_tile(p, t, smem);
  if (PH == 4) phaseF(p, bid, nb);
  if (PH == 5) phaseG(p, bid, nb, smem);
}
#endif

extern "C" void kernel_launch(void* const* d_in, const int* in_sizes, int n_in, void* d_out, int out_size, void* d_ws, size_t ws_size, hipStream_t stream) {
  Params p{};
  p.x = (const float*)d_in[0]; p.norm_w = (const float*)d_in[1]; p.w_in = (const float*)d_in[2]; p.conv_w = (const float*)d_in[3];
  p.a_log = (const float*)d_in[4]; p.dt_bias = (const float*)d_in[5]; p.out_norm_w = (const float*)d_in[6]; p.qnw = (const float*)d_in[7];
  p.knw = (const float*)d_in[8]; p.sinks = (const float*)d_in[9]; p.w_out = (const float*)d_in[10];
  p.out = (float*)d_out; p.ws = (unsigned char*)d_ws;
  if (ws_size < OFF_END) { fprintf(stderr, "workspace too small: %zu < %zu\n", ws_size, (size_t)OFF_END); return; }
#if MEGA
  static int grid_blocks = 0;
  if (!grid_blocks) {
    int dev = 0, cus = 0, per_cu = 0;
    hipGetDevice(&dev);
    hipDeviceGetAttribute(&cus, hipDeviceAttributeMultiprocessorCount, dev);
    hipOccupancyMaxActiveBlocksPerMultiprocessor(&per_cu, k_mega, 256, 0);
    if (per_cu > 2) per_cu = 2;
    grid_blocks = cus * per_cu;
  }
  void* args[] = {&p};
  hipError_t e = hipLaunchCooperativeKernel((void*)k_mega, dim3(grid_blocks), dim3(256), args, 0, stream);
  if (e != hipSuccess) fprintf(stderr, "cooperative launch failed: %s (grid %d)\n", hipGetErrorString(e), grid_blocks);
#else
  k_phase<0><<<512, 256, 0, stream>>>(p);
  k_phase<1><<<512, 256, 0, stream>>>(p);
  k_phase<2><<<512, 256, 0, stream>>>(p);
  k_phase<7><<<512, 256, 0, stream>>>(p);
  k_phase<3><<<64, 256, 0, stream>>>(p);
  k_phase<6><<<512, 256, 0, stream>>>(p);
  k_phase<4><<<512, 256, 0, stream>>>(p);
  k_phase<5><<<512, 256, 0, stream>>>(p);
#endif
}
```

```cpp
#include <hip/hip_runtime.h>
#include <hip/hip_bf16.h>
#include <hip/hip_cooperative_groups.h>
#include <cstdio>
namespace cg = cooperative_groups;

#ifndef MEGA
#define MEGA 1
#endif

typedef unsigned short u16;
using bf16x8 = __attribute__((ext_vector_type(8))) short;
using f32x16 = __attribute__((ext_vector_type(16))) float;
using f32x4  = __attribute__((ext_vector_type(4))) float;
#define DI __device__ __forceinline__
#define MFMA16(a, b, c) __builtin_amdgcn_mfma_f32_16x16x32_bf16((a), (b), (c), 0, 0, 0)

constexpr int SEQ = 8192, M = 16384, D = 1024, NIN = 3344, N1 = 3328;
constexpr int C_DNQ = 0, C_DNK = 512, C_DNV = 1024, C_DNZ = 1536, C_SWQ = 2048, C_SWK = 2560, C_SWV = 2688, C_SWZ = 2816;
constexpr float EPS = 1e-6f;

constexpr int LDA = 1536, LDB = 1792;
constexpr int B_DNZ = 0, B_SWQ = 512, B_SWK = 1024, B_SWV = 1152, B_SWZ = 1280;
constexpr size_t OFF_XN   = 0;
constexpr size_t OFF_W1   = OFF_XN + (size_t)M * 1024 * 2;
constexpr size_t OFF_W2   = OFF_W1 + (size_t)N1 * 1024 * 2;
constexpr size_t OFF_BETA = OFF_W2 + (size_t)1024 * 1024 * 2;
constexpr size_t OFF_G    = OFF_BETA + (size_t)M * 8 * 4;
constexpr size_t OFF_ROPC = OFF_G + (size_t)M * 8 * 4;
constexpr size_t OFF_ROPS = OFF_ROPC + (size_t)SEQ * 32 * 4;
constexpr size_t OFF_PROJB= OFF_ROPS + (size_t)SEQ * 32 * 4;
constexpr size_t OFF_QN   = OFF_PROJB + (size_t)M * LDB * 2;
constexpr size_t OFF_KN   = OFF_QN + (size_t)M * 512 * 2;
constexpr size_t OFF_VV   = OFF_KN + (size_t)M * 512 * 2;
constexpr size_t OFF_PROJA= OFF_VV + (size_t)M * 512 * 2;
constexpr size_t OFF_PW   = OFF_PROJA;
constexpr size_t OFF_PU   = OFF_PW + (size_t)2048 * 8192 * 2;
constexpr size_t OFF_PK   = OFF_PU + (size_t)2048 * 8192 * 2;
constexpr size_t OFF_END  = OFF_PK + (size_t)2048 * 8192 * 2;
constexpr size_t DO_OB = (size_t)M * 512 * 2, DO_KR = (size_t)M * 512 * 4, DO_PA = DO_KR + (size_t)M * 128 * 4, DO_PE = DO_PA + (size_t)2048 * 4096 * 2, DO_PGL = DO_PE + (size_t)2048 * 64 * 4;
constexpr size_t DO_VT = DO_PGL + 8192;
static_assert(DO_VT + (size_t)256 * SEQ * 2 <= (size_t)M * 1024 * 4, "d_out scratch overflow");
static_assert(OFF_END <= (size_t)256 * 1024 * 1024, "workspace overflow");

struct Params {
  const float *x, *norm_w, *w_in, *conv_w, *a_log, *dt_bias, *out_norm_w, *qnw, *knw, *sinks, *w_out;
  float* out;
  unsigned char* ws;
};

DI u16 f2bf(float x) { unsigned u = __float_as_uint(x); u += 0x7fffu + ((u >> 16) & 1u); return (u16)(u >> 16); }
DI float bf2f(u16 v) { return __uint_as_float(((unsigned)v) << 16); }
DI unsigned pack2(float a, float b) { return (unsigned)f2bf(a) | ((unsigned)f2bf(b) << 16); }
DI float wave_sum(float v) {
#pragma unroll
  for (int o = 32; o >= 1; o >>= 1) v += __shfl_xor(v, o);
  return v;
}
DI float silu(float y) { return y / (1.f + __expf(-y)); }
DI int crow(int i, int h) { return (i & 3) + 8 * (i >> 2) + 4 * h; }

__device__ void phaseA(const Params& p, int bid, int nb, unsigned char* smem_raw) {
  float* smem = (float*)smem_raw;
  const int tid = threadIdx.x, wave = tid >> 6, lane = tid & 63;
  for (int i = tid; i < 16 * 1024; i += 256) { int k = i >> 4, j = i & 15; smem[j * 1024 + k] = p.w_in[(size_t)k * NIN + 2048 + j]; }
  __syncthreads();
  u16* xn = (u16*)(p.ws + OFF_XN);
  float* betaA = (float*)(p.ws + OFF_BETA);
  float* gA = (float*)(p.ws + OFF_G);
  for (int row = bid * 4 + wave; row < M; row += nb * 4) {
    const float4* xr = (const float4*)(p.x + (size_t)row * D);
    float4 v[4]; float ss = 0.f;
#pragma unroll
    for (int i = 0; i < 4; ++i) { v[i] = xr[lane + 64 * i]; ss += v[i].x * v[i].x + v[i].y * v[i].y + v[i].z * v[i].z + v[i].w * v[i].w; }
    ss = wave_sum(ss);
    const float rstd = rsqrtf(ss * (1.f / 1024.f) + EPS);
#pragma unroll
    for (int i = 0; i < 4; ++i) {
      float4 nw = ((const float4*)p.norm_w)[lane + 64 * i];
      v[i].x *= rstd * nw.x; v[i].y *= rstd * nw.y; v[i].z *= rstd * nw.z; v[i].w *= rstd * nw.w;
      uint2 pk; pk.x = pack2(v[i].x, v[i].y); pk.y = pack2(v[i].z, v[i].w);
      *(uint2*)(xn + (size_t)row * 1024 + (lane + 64 * i) * 4) = pk;
    }
    float r = 0.f;
#pragma unroll 2
    for (int j = 0; j < 16; ++j) {
      float a = 0.f;
#pragma unroll
      for (int i = 0; i < 4; ++i) {
        float4 w = *(const float4*)&smem[j * 1024 + (lane + 64 * i) * 4];
        a += v[i].x * w.x + v[i].y * w.y + v[i].z * w.z + v[i].w * w.w;
      }
      a = wave_sum(a);
      r = (lane == j) ? a : r;
    }
    if (lane < 8) betaA[(size_t)row * 8 + lane] = 1.f / (1.f + __expf(-r));
    else if (lane < 16) {
      int idx = lane - 8;
      float xx = r + p.dt_bias[idx];
      float sp = fmaxf(xx, 0.f) + log1pf(__expf(-fabsf(xx)));
      gA[(size_t)row * 8 + idx] = -__expf(p.a_log[idx]) * sp;
    }
  }
  u16* w1 = (u16*)(p.ws + OFF_W1);
  u16* w2 = (u16*)(p.ws + OFF_W2);
  const int gt = bid * 256 + tid, gs = nb * 256;
  for (int idx = gt; idx < N1 * 128; idx += gs) {
    int n = idx % N1, kb = idx / N1;
    int col = n < 2048 ? n : n + 16;
    float f[8];
#pragma unroll
    for (int i = 0; i < 8; ++i) f[i] = p.w_in[(size_t)(kb * 8 + i) * NIN + col];
    uint4 pk; pk.x = pack2(f[0], f[1]); pk.y = pack2(f[2], f[3]); pk.z = pack2(f[4], f[5]); pk.w = pack2(f[6], f[7]);
    *(uint4*)(w1 + (size_t)n * 1024 + kb * 8) = pk;
  }
  for (int idx = gt; idx < 1024 * 128; idx += gs) {
    int n = idx & 1023, kb = idx >> 10;
    float f[8];
#pragma unroll
    for (int i = 0; i < 8; ++i) f[i] = p.w_out[(size_t)(kb * 8 + i) * 1024 + n];
    uint4 pk; pk.x = pack2(f[0], f[1]); pk.y = pack2(f[2], f[3]); pk.z = pack2(f[4], f[5]); pk.w = pack2(f[6], f[7]);
    *(uint4*)(w2 + (size_t)n * 1024 + kb * 8) = pk;
  }
  float* rc = (float*)(p.ws + OFF_ROPC);
  float* rs = (float*)(p.ws + OFF_ROPS);
  for (int idx = gt; idx < SEQ * 32; idx += gs) {
    int pos = idx >> 5, i = idx & 31;
    float inv = exp2f(-(float)i * (13.287712379549449f / 32.f));
    float ang = (float)pos * inv;
    double a = (double)ang * 0.15915494309189535;
    float fr = (float)(a - rint(a));
    rc[idx] = __builtin_amdgcn_cosf(fr); rs[idx] = __builtin_amdgcn_sinf(fr);
  }
}

template <int MODE>
__device__ void gemm_tile(const Params& p, const u16* __restrict__ A, const u16* __restrict__ Bt, int K, int m0, int n0, unsigned char* smem) {
  const int tid = threadIdx.x, wave = tid >> 6, lane = tid & 63;
  const int wm = wave >> 1, wn = wave & 1, r = lane & 31, h = lane >> 5;
  unsigned char* As = smem;
  unsigned char* Bs = smem + 32768;
  f32x16 acc[2][2];
#pragma unroll
  for (int a = 0; a < 2; ++a)
#pragma unroll
    for (int b = 0; b < 2; ++b)
#pragma unroll
      for (int i = 0; i < 16; ++i) acc[a][b][i] = 0.f;
  uint4 ra[4], rb[4];
  const int KT = K / 64;
  auto gload = [&](int kt) {
#pragma unroll
    for (int i = 0; i < 4; ++i) {
      int id = tid + 256 * i, row = id >> 3, c = id & 7;
      ra[i] = *(const uint4*)(A + (size_t)(m0 + row) * K + kt * 64 + c * 8);
      rb[i] = *(const uint4*)(Bt + (size_t)(n0 + row) * K + kt * 64 + c * 8);
    }
  };
  auto lstore = [&](int buf) {
#pragma unroll
    for (int i = 0; i < 4; ++i) {
      int id = tid + 256 * i, row = id >> 3, c = id & 7;
      int off = buf * 16384 + row * 128 + ((c ^ ((row >> 1) & 7)) << 4);
      *(uint4*)(As + off) = ra[i];
      *(uint4*)(Bs + off) = rb[i];
    }
  };
  __syncthreads();
  gload(0); lstore(0);
  __syncthreads();
  for (int kt = 0; kt < KT; ++kt) {
    if (kt + 1 < KT) gload(kt + 1);
    const int buf = kt & 1;
#pragma unroll
    for (int ks = 0; ks < 4; ++ks) {
      const int c = ks * 2 + h;
      bf16x8 af[2], bfr[2];
#pragma unroll
      for (int t = 0; t < 2; ++t) {
        int rowa = wm * 64 + t * 32 + r;
        af[t] = *(const bf16x8*)(As + buf * 16384 + rowa * 128 + ((c ^ ((rowa >> 1) & 7)) << 4));
        int rowb = wn * 64 + t * 32 + r;
        bfr[t] = *(const bf16x8*)(Bs + buf * 16384 + rowb * 128 + ((c ^ ((rowb >> 1) & 7)) << 4));
      }
#pragma unroll
      for (int a = 0; a < 2; ++a)
#pragma unroll
        for (int b = 0; b < 2; ++b) acc[a][b] = __builtin_amdgcn_mfma_f32_32x32x16_bf16(af[a], bfr[b], acc[a][b], 0, 0, 0);
    }
    if (kt + 1 < KT) lstore((kt + 1) & 1);
    __syncthreads();
  }
#pragma unroll
  for (int a = 0; a < 2; ++a)
#pragma unroll
    for (int b = 0; b < 2; ++b)
#pragma unroll
      for (int i = 0; i < 16; ++i) {
        int m = m0 + wm * 64 + a * 32 + crow(i, h);
        int n = n0 + wn * 64 + b * 32 + r;
        if (MODE == 0) {
          if (n0 < 1536) ((u16*)(p.ws + OFF_PROJA))[(size_t)m * LDA + n] = f2bf(acc[a][b][i]);
          else ((u16*)(p.ws + OFF_PROJB))[(size_t)m * LDB + (n - 1536)] = f2bf(acc[a][b][i]);
        }
        else p.out[(size_t)m * 1024 + n] = p.x[(size_t)m * 1024 + n] + acc[a][b][i];
      }
}

__device__ void phaseB(const Params& p, int bid, int nb, unsigned char* smem) {
  const u16* xn = (const u16*)(p.ws + OFF_XN);
  const u16* w1 = (const u16*)(p.ws + OFF_W1);
  for (int t = bid; t < 128 * 26; t += nb) {
    int tn = t % 26, tm = t / 26;
    gemm_tile<0>(p, xn, w1, 1024, tm * 128, tn * 128, smem);
  }
}
__device__ void phaseG(const Params& p, int bid, int nb, unsigned char* smem) {
  const u16* mix = (const u16*)(p.ws + OFF_XN);
  const u16* w2 = (const u16*)(p.ws + OFF_W2);
  for (int t = bid; t < 128 * 8; t += nb) {
    int tn = t & 7, tm = t >> 3;
    gemm_tile<1>(p, mix, w2, 1024, tm * 128, tn * 128, smem);
  }
}

__device__ void phaseC(const Params& p, int bid, int nb) {
  const int tid = threadIdx.x, wave = tid >> 6, lane = tid & 63;
  const u16* projA = (const u16*)(p.ws + OFF_PROJA);
  const u16* projB = (const u16*)(p.ws + OFF_PROJB);
  u16* qn = (u16*)(p.ws + OFF_QN);
  u16* kn = (u16*)(p.ws + OFF_KN);
  u16* vv = (u16*)(p.ws + OFF_VV);
  u16* kr = (u16*)((unsigned char*)p.out + DO_KR);
  u16* vT = (u16*)((unsigned char*)p.out + DO_VT);
  u16* qr = (u16*)(p.ws + OFF_XN);
  const float* rc = (const float*)(p.ws + OFF_ROPC);
  const float* rs = (const float*)(p.ws + OFF_ROPS);
  for (int item = bid * 4 + wave; item < M * 9; item += nb * 4) {
    const int m = item / 9, hh = item % 9;
    const int t = m & (SEQ - 1), b = m >> 13;
    if (hh < 4) {
      const int c0 = hh * 128 + 2 * lane;
      float y[3][2] = {{0.f, 0.f}, {0.f, 0.f}, {0.f, 0.f}};
#pragma unroll
      for (int j = 0; j < 5; ++j) {
        int tt = t + j - 2;
        if (tt >= 0 && tt < SEQ) {
          const u16* pr = projA + (size_t)(m + j - 2) * LDA;
#pragma unroll
          for (int s = 0; s < 3; ++s) {
            unsigned u = *(const unsigned*)(pr + s * 512 + c0);
            float2 w = *(const float2*)(p.conv_w + j * 1536 + s * 512 + c0);
            y[s][0] += bf2f((u16)(u & 0xffff)) * w.x;
            y[s][1] += bf2f((u16)(u >> 16)) * w.y;
          }
        }
      }
#pragma unroll
      for (int s = 0; s < 3; ++s) { y[s][0] = silu(y[s][0]); y[s][1] = silu(y[s][1]); }
      float sq = wave_sum(y[0][0] * y[0][0] + y[0][1] * y[0][1]);
      float sk = wave_sum(y[1][0] * y[1][0] + y[1][1] * y[1][1]);
      float fq = rsqrtf(sq + EPS) * 0.08838834764831845f;
      float fk = rsqrtf(sk + EPS);
      *(unsigned*)(qn + (size_t)m * 512 + c0) = pack2(y[0][0] * fq, y[0][1] * fq);
      *(unsigned*)(kn + (size_t)m * 512 + c0) = pack2(y[1][0] * fk, y[1][1] * fk);
      *(unsigned*)(vv + (size_t)m * 512 + c0) = pack2(y[2][0], y[2][1]);
    } else {
      const int sub = lane >> 5, d = lane & 31;
      const bool isk = (hh == 4);
      const int head = isk ? sub : (hh - 5) * 2 + sub;
      const u16* pr = projB + (size_t)m * LDB + (isk ? B_SWK : B_SWQ) + head * 64;
      const float* nw = isk ? p.knw : p.qnw;
      float x0 = bf2f(pr[d]), x1 = bf2f(pr[d + 32]);
      float ss = x0 * x0 + x1 * x1;
#pragma unroll
      for (int o = 16; o >= 1; o >>= 1) ss += __shfl_xor(ss, o);
      float rstd = rsqrtf(ss * (1.f / 64.f) + EPS) * (isk ? 1.f : 0.125f);
      float y0 = x0 * rstd * nw[d], y1 = x1 * rstd * nw[d + 32];
      float c = rc[t * 32 + d], sn = rs[t * 32 + d];
      float o0 = y0 * c - y1 * sn, o1 = y1 * c + y0 * sn;
      if (isk) {
        kr[(size_t)m * 128 + head * 64 + d] = f2bf(o0);
        kr[(size_t)m * 128 + head * 64 + d + 32] = f2bf(o1);
        const u16* pv = projB + (size_t)m * LDB + B_SWV + head * 64;
        vT[((size_t)((b * 2 + head) * 64 + d)) * SEQ + t] = pv[d];
        vT[((size_t)((b * 2 + head) * 64 + d + 32)) * SEQ + t] = pv[d + 32];
      } else {
        qr[(size_t)m * 1024 + head * 64 + d] = f2bf(o0);
        qr[(size_t)m * 1024 + head * 64 + d + 32] = f2bf(o1);
      }
    }
  }
}

__device__ void prep_tile(const Params& p, int tile, unsigned char* smem) {
  const int tid = threadIdx.x, wave = tid >> 6, lane = tid & 63;
  const int dir = tile & 1, n = (tile >> 1) & 127, bh = tile >> 8, b = bh >> 2, hh = bh & 3;
  unsigned char* ksb = smem;
  unsigned char* qsb = smem + 17408;
  float* Ms = (float*)(smem + 34816);
  float* gc = (float*)(smem + 51200);
  float* bt = gc + 64;
  const u16* qn = (const u16*)(p.ws + OFF_QN);
  const u16* kn = (const u16*)(p.ws + OFF_KN);
  const u16* vv = (const u16*)(p.ws + OFF_VV);
  const float* betaA = (const float*)(p.ws + OFF_BETA);
  const float* gA = (const float*)(p.ws + OFF_G);
  u16* pw = (u16*)(p.ws + OFF_PW) + (size_t)tile * 8192;
  u16* pu = (u16*)(p.ws + OFF_PU) + (size_t)tile * 8192;
  u16* pk = (u16*)(p.ws + OFF_PK) + (size_t)tile * 8192;
  u16* pa = (u16*)((unsigned char*)p.out + DO_PA) + (size_t)tile * 4096;
  float* pe = (float*)((unsigned char*)p.out + DO_PE) + (size_t)tile * 64;
  float* pgl = (float*)((unsigned char*)p.out + DO_PGL);
  const size_t row0 = (size_t)b * SEQ + n * 64;
  __syncthreads();
#pragma unroll
  for (int i = 0; i < 4; ++i) {
    int id = tid + 256 * i, c = id >> 4, ch = id & 15;
    int tok = dir ? 63 - c : c;
    *(uint4*)(ksb + c * 272 + ch * 16) = *(const uint4*)(kn + (row0 + tok) * 512 + hh * 128 + ch * 8);
    *(uint4*)(qsb + c * 272 + ch * 16) = *(const uint4*)(qn + (row0 + tok) * 512 + hh * 128 + ch * 8);
  }
  if (wave == 0) {
    int tok = dir ? 63 - lane : lane;
    float g = gA[(row0 + tok) * 8 + dir * 4 + hh];
    float bb = betaA[(row0 + tok) * 8 + dir * 4 + hh];
#pragma unroll
    for (int o = 1; o < 64; o <<= 1) { float t = __shfl_up(g, o); if (lane >= o) g += t; }
    gc[lane] = g; bt[lane] = bb;
    pe[lane] = __expf(g);
    if (lane == 63) pgl[tile] = __expf(g);
  }
  __syncthreads();
  {
    const int row = lane & 15, quad = lane >> 4;
    bf16x8 ak[4], aq[4];
#pragma unroll
    for (int k = 0; k < 4; ++k) {
      ak[k] = *(const bf16x8*)(ksb + (16 * wave + row) * 272 + k * 64 + quad * 16);
      aq[k] = *(const bf16x8*)(qsb + (16 * wave + row) * 272 + k * 64 + quad * 16);
    }
#pragma unroll
    for (int tc = 0; tc < 4; ++tc) {
      f32x4 ckk = {0.f, 0.f, 0.f, 0.f}, cqk = {0.f, 0.f, 0.f, 0.f};
#pragma unroll
      for (int k = 0; k < 4; ++k) {
        bf16x8 bk = *(const bf16x8*)(ksb + (16 * tc + row) * 272 + k * 64 + quad * 16);
        ckk = MFMA16(ak[k], bk, ckk);
        cqk = MFMA16(aq[k], bk, cqk);
      }
      const int s = 16 * tc + row;
      const float gs = gc[s];
#pragma unroll
      for (int j = 0; j < 4; ++j) {
        const int c = 16 * wave + quad * 4 + j;
        float dec = __expf(fminf(gc[c] - gs, 0.f));
        float mval = (s < c) ? bt[c] * ckk[j] * dec : 0.f;
        float aval = (s <= c) ? cqk[j] * dec : 0.f;
        Ms[c * 64 + s] = mval;
        pa[c * 64 + s] = f2bf(aval);
      }
    }
  }
  {
    const int dk = tid & 127, half = tid >> 7;
    const float gl = gc[63];
    unsigned pkd[16];
#pragma unroll
    for (int i = 0; i < 16; ++i) {
      int c0 = half * 32 + 2 * i;
      float k0 = bf2f(*(const u16*)(ksb + c0 * 272 + dk * 2)) * __expf(gl - gc[c0]);
      float k1 = bf2f(*(const u16*)(ksb + (c0 + 1) * 272 + dk * 2)) * __expf(gl - gc[c0 + 1]);
      pkd[i] = pack2(k0, k1);
    }
#pragma unroll
    for (int i = 0; i < 4; ++i) *(uint4*)(pk + dk * 64 + half * 32 + i * 8) = make_uint4(pkd[4 * i], pkd[4 * i + 1], pkd[4 * i + 2], pkd[4 * i + 3]);
  }
  __syncthreads();
  float x[64];
  if (tid < 128) {
#pragma unroll
    for (int c = 0; c < 64; ++c) { int tok = dir ? 63 - c : c; x[c] = bt[c] * bf2f(vv[(row0 + tok) * 512 + hh * 128 + tid]); }
  } else {
#pragma unroll
    for (int c = 0; c < 64; ++c) x[c] = bt[c] * __expf(gc[c]) * bf2f(*(const u16*)(ksb + c * 272 + (tid - 128) * 2));
  }
#pragma unroll
  for (int c = 1; c < 64; ++c) {
    const float4* mr = (const float4*)(Ms + c * 64);
    float a0 = 0.f, a1 = 0.f;
#pragma unroll
    for (int s4 = 0; s4 < (c + 3) / 4; ++s4) {
      float4 m = mr[s4];
      a0 += m.x * x[4 * s4] + m.y * x[4 * s4 + 1];
      a1 += m.z * x[4 * s4 + 2] + m.w * x[4 * s4 + 3];
    }
    x[c] -= a0 + a1;
  }
  if (tid < 128) {
#pragma unroll
    for (int i = 0; i < 8; ++i)
      *(uint4*)(pu + tid * 64 + i * 8) = make_uint4(pack2(x[8 * i], x[8 * i + 1]), pack2(x[8 * i + 2], x[8 * i + 3]), pack2(x[8 * i + 4], x[8 * i + 5]), pack2(x[8 * i + 6], x[8 * i + 7]));
  } else {
#pragma unroll
    for (int c = 0; c < 64; ++c) *(u16*)(qsb + c * 272 + (tid - 128) * 2) = f2bf(-x[c]);
  }
  __syncthreads();
#pragma unroll
  for (int i = 0; i < 4; ++i) {
    int id = tid + 256 * i, c = id >> 4, ch = id & 15;
    *(uint4*)(pw + c * 128 + ch * 8) = *(const uint4*)(qsb + c * 272 + ch * 16);
  }
}

struct ScanFrags { bf16x8 aw[4], aq[4], aa[2], akd[2][2]; uint2 u[2]; float4 eg; float egl; };
__device__ void scan_chunked(const Params& p, int sid, unsigned char* smem) {
  const int tid = threadIdx.x, wave = tid >> 6, lane = tid & 63, row = lane & 15, quad = lane >> 4;
  const int chain = sid >> 2, dv0 = (sid & 3) * 32;
  const int b = chain >> 3, hh = (chain >> 1) & 3, dir = chain & 1;
  unsigned char* Sl = smem;
  unsigned char* Vl = smem + 8704;
  const u16* qn = (const u16*)(p.ws + OFF_QN);
  const u16* pwA = (const u16*)(p.ws + OFF_PW);
  const u16* puA = (const u16*)(p.ws + OFF_PU);
  const u16* pkA = (const u16*)(p.ws + OFF_PK);
  const u16* paA = (const u16*)((unsigned char*)p.out + DO_PA);
  const float* peA = (const float*)((unsigned char*)p.out + DO_PE);
  const float* pglA = (const float*)((unsigned char*)p.out + DO_PGL);
  u16* ob = (u16*)((unsigned char*)p.out + (dir ? DO_OB : 0));
  __syncthreads();
  for (int i = tid; i < 8704 / 4; i += 256) ((unsigned*)Sl)[i] = 0u;
  f32x4 Sacc[2][2];
#pragma unroll
  for (int a = 0; a < 2; ++a)
#pragma unroll
    for (int c = 0; c < 2; ++c) Sacc[a][c] = f32x4{0.f, 0.f, 0.f, 0.f};
  auto gload = [&](ScanFrags& f, int step) {
    const int n = dir ? 127 - step : step;
    const size_t tile = ((size_t)(b * 4 + hh) * 128 + n) * 2 + dir;
    const int c = 16 * wave + row;
    const int tok = dir ? 63 - c : c;
    const size_t qrow = ((size_t)b * SEQ + n * 64 + tok) * 512 + hh * 128;
#pragma unroll
    for (int k = 0; k < 4; ++k) {
      f.aw[k] = *(const bf16x8*)(pwA + tile * 8192 + c * 128 + k * 32 + quad * 8);
      f.aq[k] = *(const bf16x8*)(qn + qrow + k * 32 + quad * 8);
    }
#pragma unroll
    for (int k = 0; k < 2; ++k) {
      f.aa[k] = *(const bf16x8*)(paA + tile * 4096 + c * 64 + k * 32 + quad * 8);
#pragma unroll
      for (int d = 0; d < 2; ++d) f.akd[d][k] = *(const bf16x8*)(pkA + tile * 8192 + (32 * wave + 16 * d + row) * 64 + k * 32 + quad * 8);
    }
#pragma unroll
    for (int nt = 0; nt < 2; ++nt) f.u[nt] = *(const uint2*)(puA + tile * 8192 + (dv0 + nt * 16 + row) * 64 + 16 * wave + quad * 4);
    f.eg = *(const float4*)(peA + tile * 64 + 16 * wave + quad * 4);
    f.egl = pglA[tile];
  };
  auto body = [&](ScanFrags& f, ScanFrags& fn, int step) {
    if (step + 1 < 128) gload(fn, step + 1);
    bf16x8 bS[4][2];
#pragma unroll
    for (int k = 0; k < 4; ++k)
#pragma unroll
      for (int nt = 0; nt < 2; ++nt) bS[k][nt] = *(const bf16x8*)(Sl + (nt * 16 + row) * 272 + k * 64 + quad * 16);
    f32x4 vacc[2], oacc[2];
#pragma unroll
    for (int nt = 0; nt < 2; ++nt) {
      vacc[nt] = f32x4{__uint_as_float(f.u[nt].x << 16), __uint_as_float(f.u[nt].x & 0xffff0000u), __uint_as_float(f.u[nt].y << 16), __uint_as_float(f.u[nt].y & 0xffff0000u)};
      oacc[nt] = f32x4{0.f, 0.f, 0.f, 0.f};
#pragma unroll
      for (int k = 0; k < 4; ++k) vacc[nt] = MFMA16(f.aw[k], bS[k][nt], vacc[nt]);
      *(uint2*)(Vl + (nt * 16 + row) * 144 + (16 * wave + quad * 4) * 2) = make_uint2(pack2(vacc[nt][0], vacc[nt][1]), pack2(vacc[nt][2], vacc[nt][3]));
    }
#pragma unroll
    for (int nt = 0; nt < 2; ++nt) {
#pragma unroll
      for (int k = 0; k < 4; ++k) oacc[nt] = MFMA16(f.aq[k], bS[k][nt], oacc[nt]);
      oacc[nt][0] *= f.eg.x; oacc[nt][1] *= f.eg.y; oacc[nt][2] *= f.eg.z; oacc[nt][3] *= f.eg.w;
    }
    __syncthreads();
    bf16x8 bV[2][2];
#pragma unroll
    for (int k = 0; k < 2; ++k)
#pragma unroll
      for (int nt = 0; nt < 2; ++nt) bV[k][nt] = *(const bf16x8*)(Vl + (nt * 16 + row) * 144 + k * 64 + quad * 16);
#pragma unroll
    for (int d = 0; d < 2; ++d)
#pragma unroll
      for (int nt = 0; nt < 2; ++nt) {
        Sacc[d][nt] *= f.egl;
#pragma unroll
        for (int k = 0; k < 2; ++k) Sacc[d][nt] = MFMA16(f.akd[d][k], bV[k][nt], Sacc[d][nt]);
        *(uint2*)(Sl + (nt * 16 + row) * 272 + (32 * wave + 16 * d + quad * 4) * 2) = make_uint2(pack2(Sacc[d][nt][0], Sacc[d][nt][1]), pack2(Sacc[d][nt][2], Sacc[d][nt][3]));
      }
    const int n = dir ? 127 - step : step;
#pragma unroll
    for (int nt = 0; nt < 2; ++nt) {
#pragma unroll
      for (int k = 0; k < 2; ++k) oacc[nt] = MFMA16(f.aa[k], bV[k][nt], oacc[nt]);
#pragma unroll
      for (int j = 0; j < 4; ++j) {
        const int c = 16 * wave + quad * 4 + j;
        const int tok = dir ? 63 - c : c;
        ob[((size_t)b * SEQ + n * 64 + tok) * 512 + hh * 128 + dv0 + nt * 16 + row] = f2bf(oacc[nt][j]);
      }
    }
    __syncthreads();
  };
  ScanFrags f0, f1;
  gload(f0, 0);
  __syncthreads();
#pragma unroll 1
  for (int step = 0; step < 128; step += 2) {
    body(f0, f1, step);
    body(f1, f0, step + 1);
  }
}

__device__ void swa_mfma(const Params& p, int bid, int nb) {
  const int wave = threadIdx.x >> 6, lane = threadIdx.x & 63, col = lane & 15, quad = lane >> 4;
  const u16* kr = (const u16*)((const unsigned char*)p.out + DO_KR);
  const u16* vT = (const u16*)((const unsigned char*)p.out + DO_VT);
  const u16* qr = (const u16*)(p.ws + OFF_XN);
  const u16* projB = (const u16*)(p.ws + OFF_PROJB);
  u16* mix = (u16*)(p.ws + OFF_XN);
  for (int unit = bid; unit < 2048; unit += nb) {
    const int qblk = unit & 511, kvh = (unit >> 9) & 1, b = unit >> 10;
    const int t0 = qblk * 16, qh = kvh * 4 + wave;
    const size_t mq = (size_t)b * SEQ + t0 + col;
    bf16x8 bq[2];
#pragma unroll
    for (int ks = 0; ks < 2; ++ks) bq[ks] = *(const bf16x8*)(qr + mq * 1024 + qh * 64 + ks * 32 + quad * 8);
    f32x4 sc[18];
#pragma unroll
    for (int kt = 0; kt < 18; ++kt) {
      int key = t0 - 128 + 16 * kt + col;
      key = key < 0 ? 0 : (key > SEQ - 1 ? SEQ - 1 : key);
      const u16* kp = kr + ((size_t)b * SEQ + key) * 128 + kvh * 64 + quad * 8;
      bf16x8 a0 = *(const bf16x8*)kp, a1 = *(const bf16x8*)(kp + 32);
      f32x4 c = {0.f, 0.f, 0.f, 0.f};
      c = MFMA16(a0, bq[0], c);
      c = MFMA16(a1, bq[1], c);
      sc[kt] = c;
    }
    const float sink = p.sinks[qh];
    float mx = sink;
#pragma unroll
    for (int kt = 0; kt < 18; ++kt)
#pragma unroll
      for (int jj = 0; jj < 4; ++jj) {
        const int key = t0 - 128 + 16 * kt + quad * 4 + jj;
        const int rel = key - (t0 + col);
        const bool valid = (rel >= -128) && (rel <= 128) && (key >= 0) && (key < SEQ);
        float v = valid ? sc[kt][jj] : -1e30f;
        sc[kt][jj] = v;
        mx = fmaxf(mx, v);
      }
    mx = fmaxf(mx, __shfl_xor(mx, 16));
    mx = fmaxf(mx, __shfl_xor(mx, 32));
    float l = 0.f;
#pragma unroll
    for (int kt = 0; kt < 18; ++kt)
#pragma unroll
      for (int jj = 0; jj < 4; ++jj) { float e = __expf(sc[kt][jj] - mx); sc[kt][jj] = e; l += e; }
    l += __shfl_xor(l, 16);
    l += __shfl_xor(l, 32);
    l += __expf(sink - mx);
    f32x4 o[4];
#pragma unroll
    for (int dt = 0; dt < 4; ++dt) o[dt] = f32x4{0.f, 0.f, 0.f, 0.f};
#pragma unroll
    for (int kg = 0; kg < 9; ++kg) {
      union { bf16x8 v; unsigned u[4]; } bp;
      bp.u[0] = pack2(sc[2 * kg][0], sc[2 * kg][1]); bp.u[1] = pack2(sc[2 * kg][2], sc[2 * kg][3]);
      bp.u[2] = pack2(sc[2 * kg + 1][0], sc[2 * kg + 1][1]); bp.u[3] = pack2(sc[2 * kg + 1][2], sc[2 * kg + 1][3]);
      const int key0 = t0 - 128 + 32 * kg + quad * 4;
      const bool ok0 = key0 >= 0 && key0 < SEQ, ok1 = key0 + 16 >= 0 && key0 + 16 < SEQ;
#pragma unroll
      for (int dt = 0; dt < 4; ++dt) {
        const u16* vp = vT + ((size_t)((b * 2 + kvh) * 64 + dt * 16 + col)) * SEQ;
        uint2 lo = make_uint2(0u, 0u), hi = make_uint2(0u, 0u);
        if (ok0) lo = *(const uint2*)(vp + key0);
        if (ok1) hi = *(const uint2*)(vp + key0 + 16);
        union { bf16x8 v; unsigned u[4]; } av;
        av.u[0] = lo.x; av.u[1] = lo.y; av.u[2] = hi.x; av.u[3] = hi.y;
        o[dt] = MFMA16(av.v, bp.v, o[dt]);
      }
    }
    const float inv = 1.f / l;
#pragma unroll
    for (int dt = 0; dt < 4; ++dt) {
      const int d0 = dt * 16 + quad * 4;
      uint2 z = *(const uint2*)(projB + mq * LDB + B_SWZ + qh * 64 + d0);
      float z0 = __uint_as_float(z.x << 16), z1 = __uint_as_float(z.x & 0xffff0000u), z2 = __uint_as_float(z.y << 16), z3 = __uint_as_float(z.y & 0xffff0000u);
      *(uint2*)(mix + mq * 1024 + 512 + qh * 64 + d0) = make_uint2(pack2(o[dt][0] * inv * silu(z0), o[dt][1] * inv * silu(z1)), pack2(o[dt][2] * inv * silu(z2), o[dt][3] * inv * silu(z3)));
    }
  }
}

__device__ void phaseF(const Params& p, int bid, int nb) {
  const int tid = threadIdx.x, wave = tid >> 6, lane = tid & 63;
  const u16* proj = (const u16*)(p.ws + OFF_PROJB);
  u16* mix = (u16*)(p.ws + OFF_XN);
  const u16* of = (const u16*)p.out;
  const u16* ob = (const u16*)((const unsigned char*)p.out + DO_OB);
  for (int item = bid * 4 + wave; item < M * 4; item += nb * 4) {
    const int m = item >> 2, hh = item & 3;
    const size_t o = (size_t)m * 512 + hh * 128 + 2 * lane;
    unsigned ua = *(const unsigned*)(of + o), ub = *(const unsigned*)(ob + o);
    float v0 = bf2f((u16)(ua & 0xffff)) + bf2f((u16)(ub & 0xffff)), v1 = bf2f((u16)(ua >> 16)) + bf2f((u16)(ub >> 16));
    float ss = wave_sum(v0 * v0 + v1 * v1);
    float rstd = rsqrtf(ss * (1.f / 128.f) + EPS);
    float2 w = *(const float2*)(p.out_norm_w + 2 * lane);
    unsigned uz = *(const unsigned*)(proj + (size_t)m * LDB + B_DNZ + hh * 128 + 2 * lane);
    float z0 = bf2f((u16)(uz & 0xffff)), z1 = bf2f((u16)(uz >> 16));
    *(unsigned*)(mix + (size_t)m * 1024 + hh * 128 + 2 * lane) = pack2(v0 * rstd * w.x * silu(z0), v1 * rstd * w.y * silu(z1));
  }
}

#if MEGA
__global__ void __launch_bounds__(256, 2) k_mega(Params p) {
  __shared__ __attribute__((aligned(16))) unsigned char smem[65536];
  cg::grid_group grid = cg::this_grid();
  const int bid = blockIdx.x, nb = gridDim.x;
  phaseA(p, bid, nb, smem);
  grid.sync();
  phaseB(p, bid, nb, smem);
  grid.sync();
  phaseC(p, bid, nb);
  grid.sync();
  for (int t = bid; t < 2048; t += nb) prep_tile(p, t, smem);
  grid.sync();
  if (bid < 64) scan_chunked(p, bid, smem);
  else swa_mfma(p, bid - 64, nb - 64);
  grid.sync();
  phaseF(p, bid, nb);
  grid.sync();
  phaseG(p, bid, nb, smem);
}
#else
template <int PH>
__global__ void __launch_bounds__(256, 2) k_phase(Params p) {
  __shared__ __attribute__((aligned(16))) unsigned char smem[65536];
  const int bid = blockIdx.x, nb = gridDim.x;
  if (PH == 0) phaseA(p, bid, nb, smem);
  if (PH == 1) phaseB(p, bid, nb, smem);
  if (PH == 2) phaseC(p, bid, nb);
  if (PH == 3) scan_chunked(p, bid, smem);
  if (PH == 6) swa_mfma(p, bid, nb);
  if (PH == 7) for (int t = bid; t < 2048; t += nb) prep_tile(p, t, smem);
  if (PH == 4) phaseF(p, bid, nb);
  if (PH == 5) phaseG(p, bid, nb, smem);
}
#endif

extern "C" void kernel_launch(void* const* d_in, const int* in_sizes, int n_in, void* d_out, int out_size, void* d_ws, size_t ws_size, hipStream_t stream) {
  Params p{};
  p.x = (const float*)d_in[0]; p.norm_w = (const float*)d_in[1]; p.w_in = (const float*)d_in[2]; p.conv_w = (const float*)d_in[3];
  p.a_log = (const float*)d_in[4]; p.dt_bias = (const float*)d_in[5]; p.out_norm_w = (const float*)d_in[6]; p.qnw = (const float*)d_in[7];
  p.knw = (const float*)d_in[8]; p.sinks = (const float*)d_in[9]; p.w_out = (const float*)d_in[10];
  p.out = (float*)d_out; p.ws = (unsigned char*)d_ws;
  if (ws_size < OFF_END) { fprintf(stderr, "workspace too small: %zu < %zu\n", ws_size, (size_t)OFF_END); return; }
#if MEGA
  static int grid_blocks = 0;
  if (!grid_blocks) {
    int dev = 0, cus = 0, per_cu = 0;
    hipGetDevice(&dev);
    hipDeviceGetAttribute(&cus, hipDeviceAttributeMultiprocessorCount, dev);
    hipOccupancyMaxActiveBlocksPerMultiprocessor(&per_cu, k_mega, 256, 0);
    if (per_cu > 2) per_cu = 2;
    grid_blocks = cus * per_cu;
  }
  void* args[] = {&p};
  hipError_t e = hipLaunchCooperativeKernel((void*)k_mega, dim3(grid_blocks), dim3(256), args, 0, stream);
  if (e != hipSuccess) fprintf(stderr, "cooperative launch failed: %s (grid %d)\n", hipGetErrorString(e), grid_blocks);
#else
  k_phase<0><<<512, 256, 0, stream>>>(p);
  k_phase<1><<<512, 256, 0, stream>>>(p);
  k_phase<2><<<512, 256, 0, stream>>>(p);
  k_phase<7><<<512, 256, 0, stream>>>(p);
  k_phase<3><<<64, 256, 0, stream>>>(p);
  k_phase<6><<<512, 256, 0, stream>>>(p);
  k_phase<4><<<512, 256, 0, stream>>>(p);
  k_phase<5><<<512, 256, 0, stream>>>(p);
#endif
}
```

```cpp
#include <hip/hip_runtime.h>
#include <hip/hip_bf16.h>
#include <hip/hip_cooperative_groups.h>
#include <cstdio>
namespace cg = cooperative_groups;

#ifndef MEGA
#define MEGA 1
#endif
#define REP_A 1
#define REP_B 1
#define REP_C 1
#define REP_P 1
#define REP_S 1
#define REP_W 1
#define REP_F 1
#define REP_G 1

typedef unsigned short u16;
using bf16x8 = __attribute__((ext_vector_type(8))) short;
using f32x16 = __attribute__((ext_vector_type(16))) float;
using f32x4  = __attribute__((ext_vector_type(4))) float;
#define DI __device__ __forceinline__
#define MFMA16(a, b, c) __builtin_amdgcn_mfma_f32_16x16x32_bf16((a), (b), (c), 0, 0, 0)

constexpr int SEQ = 8192, M = 16384, D = 1024, NIN = 3344, N1 = 3328;
constexpr int C_DNQ = 0, C_DNK = 512, C_DNV = 1024, C_DNZ = 1536, C_SWQ = 2048, C_SWK = 2560, C_SWV = 2688, C_SWZ = 2816;
constexpr float EPS = 1e-6f;

constexpr int LDA = 1536, LDB = 1792;
constexpr int B_DNZ = 0, B_SWQ = 512, B_SWK = 1024, B_SWV = 1152, B_SWZ = 1280;
constexpr size_t OFF_XN   = 0;
constexpr size_t OFF_W1   = OFF_XN + (size_t)M * 1024 * 2;
constexpr size_t OFF_W2   = OFF_W1 + (size_t)N1 * 1024 * 2;
constexpr size_t OFF_BETA = OFF_W2 + (size_t)1024 * 1024 * 2;
constexpr size_t OFF_G    = OFF_BETA + (size_t)M * 8 * 4;
constexpr size_t OFF_ROPC = OFF_G + (size_t)M * 8 * 4;
constexpr size_t OFF_ROPS = OFF_ROPC + (size_t)SEQ * 32 * 4;
constexpr size_t OFF_PROJB= OFF_ROPS + (size_t)SEQ * 32 * 4;
constexpr size_t OFF_QN   = OFF_PROJB + (size_t)M * LDB * 2;
constexpr size_t OFF_KN   = OFF_QN + (size_t)M * 512 * 2;
constexpr size_t OFF_VV   = OFF_KN + (size_t)M * 512 * 2;
constexpr size_t OFF_PROJA= OFF_VV + (size_t)M * 512 * 2;
constexpr size_t OFF_PW   = OFF_PROJA;
constexpr size_t OFF_PU   = OFF_PW + (size_t)2048 * 8192 * 2;
constexpr size_t OFF_PK   = OFF_PU + (size_t)2048 * 8192 * 2;
constexpr size_t OFF_END  = OFF_PK + (size_t)2048 * 8192 * 2;
constexpr size_t DO_OB = (size_t)M * 512 * 2, DO_KR = (size_t)M * 512 * 4, DO_PA = DO_KR + (size_t)M * 128 * 4, DO_PE = DO_PA + (size_t)2048 * 4096 * 2, DO_PGL = DO_PE + (size_t)2048 * 64 * 4;
constexpr size_t DO_VT = DO_PGL + 8192;
static_assert(DO_VT + (size_t)256 * SEQ * 2 <= (size_t)M * 1024 * 4, "d_out scratch overflow");
constexpr size_t OFF_BAR  = OFF_END;
constexpr size_t OFF_PROG = OFF_BAR + 16384;
constexpr size_t OFF_CTL_END = OFF_PROG + 16 * 256;
static_assert(OFF_CTL_END <= (size_t)256 * 1024 * 1024, "workspace overflow");

struct Params {
  const float *x, *norm_w, *w_in, *conv_w, *a_log, *dt_bias, *out_norm_w, *qnw, *knw, *sinks, *w_out;
  float* out;
  unsigned char* ws;
};

DI u16 f2bf(float x) { __bf16 r = (__bf16)x; return __builtin_bit_cast(u16, r); }
DI float bf2f(u16 v) { return __uint_as_float(((unsigned)v) << 16); }
typedef float f32x2_t __attribute__((ext_vector_type(2)));
typedef __bf16 bf16x2_t __attribute__((ext_vector_type(2)));
DI unsigned pack2(float a, float b) { f32x2_t v = {a, b}; bf16x2_t r = __builtin_convertvector(v, bf16x2_t); return __builtin_bit_cast(unsigned, r); }
DI float wave_sum(float v) {
#pragma unroll
  for (int o = 32; o >= 1; o >>= 1) v += __shfl_xor(v, o);
  return v;
}
DI float silu(float y) { return y / (1.f + __expf(-y)); }
#define XB_TMO      128
#define XB_XCNT(j)  (256  + 64 * (j))
#define XB_XSUB(j)  (1280 + 64 * (j))
#define XB_XGEN(j)  (2304 + 64 * (j))
#define XB_TOP      3328
#define XB_TOPGEN   3392
#define XCD_BAR_WORDS 3456
#define XB_SPIN_CAP (1u << 20)
DI unsigned xb_ld(unsigned* p) { return __hip_atomic_load(p, __ATOMIC_RELAXED, __HIP_MEMORY_SCOPE_AGENT); }
DI unsigned xb_add(unsigned* p, unsigned v) { return __hip_atomic_fetch_add(p, v, __ATOMIC_RELAXED, __HIP_MEMORY_SCOPE_AGENT); }
DI unsigned xb_xcc_id() { return (unsigned)__builtin_amdgcn_s_getreg((3 << 11) | 20) & 0xFu; }
#define XB_SPIN(cond, bar) do { unsigned _sp = 0; while (cond) { __builtin_amdgcn_s_sleep(1); \
    if ((++_sp & 255u) == 0u) { if (xb_ld(&(bar)[XB_TMO])) break; if (_sp > XB_SPIN_CAP) { atomicAdd(&(bar)[XB_TMO], 1u); break; } } } } while (0)
struct XcdBarrier { unsigned* bar; unsigned x; volatile unsigned* st; };
DI XcdBarrier xcd_barrier_post(unsigned* bar, volatile unsigned* st) {
  XcdBarrier b; b.bar = bar; b.x = xb_xcc_id(); b.st = st;
  if (threadIdx.x == 0) (void)xb_add(&bar[XB_XCNT(b.x)], 1u);
  return b;
}
DI void xcd_barrier_complete(unsigned* bar, unsigned x, unsigned& nloc, unsigned& nx) {
  const unsigned G = gridDim.x;
  unsigned sum, cnt, mine, sp = 0u;
  for (;;) {
    sum = 0u; cnt = 0u; mine = 0u;
#pragma unroll
    for (unsigned j = 0; j < 16; ++j) { const unsigned c = xb_ld(&bar[XB_XCNT(j)]); sum += c; cnt += (c > 0u) ? 1u : 0u; mine = (j == x) ? c : mine; }
    if (sum == G) break;
    __builtin_amdgcn_s_sleep(1);
    if ((++sp & 255u) == 0u) { if (xb_ld(&bar[XB_TMO])) break; if (sp > XB_SPIN_CAP) { atomicAdd(&bar[XB_TMO], 1u); break; } }
  }
  nloc = mine > 0u ? mine : 1u; nx = cnt > 0u ? cnt : 1u;
}
DI void xcd_barrier(const XcdBarrier& b) {
  asm volatile("s_waitcnt vmcnt(0)" ::: "memory");
  __syncthreads();
  if (threadIdx.x == 0) {
    unsigned* bar = b.bar;
    __builtin_amdgcn_s_waitcnt(0);
    unsigned nloc = b.st[0], nx = b.st[1];
    if (nloc == 0u) { xcd_barrier_complete(bar, b.x, nloc, nx); b.st[0] = nloc; b.st[1] = nx; }
    const unsigned old = xb_add(&bar[XB_XSUB(b.x)], 1u);
    const unsigned gen = old / nloc;
    if (old + 1u == (gen + 1u) * nloc) {
      __builtin_amdgcn_fence(__ATOMIC_RELEASE, "agent");
      asm volatile("s_waitcnt vmcnt(0)" ::: "memory");
      const unsigned og = xb_add(&bar[XB_TOP], 1u);
      const unsigned tg = og / nx;
      if (og + 1u == (tg + 1u) * nx) xb_add(&bar[XB_TOPGEN], 1u);
      else XB_SPIN(xb_ld(&bar[XB_TOPGEN]) == tg, bar);
      __builtin_amdgcn_fence(__ATOMIC_ACQUIRE, "agent");
      xb_add(&bar[XB_XGEN(b.x)], 1u);
      asm volatile("s_waitcnt vmcnt(0)" ::: "memory");
    } else {
      XB_SPIN(xb_ld(&bar[XB_XGEN(b.x)]) == gen, bar);
      __builtin_amdgcn_fence(__ATOMIC_ACQUIRE, "agent");
      asm volatile("s_waitcnt vmcnt(0)" ::: "memory");
    }
  }
  __syncthreads();
}
DI int crow(int i, int h) { return (i & 3) + 8 * (i >> 2) + 4 * h; }

__device__ void phaseA(const Params& p, int bid, int nb, unsigned char* smem_raw) {
  float* smem = (float*)smem_raw;
  const int tid = threadIdx.x, wave = tid >> 6, lane = tid & 63;
  for (int i = tid; i < 16 * 1024; i += 256) { int k = i >> 4, j = i & 15; smem[j * 1024 + k] = p.w_in[(size_t)k * NIN + 2048 + j]; }
  __syncthreads();
  u16* xn = (u16*)(p.ws + OFF_XN);
  float* betaA = (float*)(p.ws + OFF_BETA);
  float* gA = (float*)(p.ws + OFF_G);
  for (int row = bid * 4 + wave; row < M; row += nb * 4) {
    const float4* xr = (const float4*)(p.x + (size_t)row * D);
    float4 v[4]; float ss = 0.f;
#pragma unroll
    for (int i = 0; i < 4; ++i) { v[i] = xr[lane + 64 * i]; ss += v[i].x * v[i].x + v[i].y * v[i].y + v[i].z * v[i].z + v[i].w * v[i].w; }
    ss = wave_sum(ss);
    const float rstd = rsqrtf(ss * (1.f / 1024.f) + EPS);
#pragma unroll
    for (int i = 0; i < 4; ++i) {
      float4 nw = ((const float4*)p.norm_w)[lane + 64 * i];
      v[i].x *= rstd * nw.x; v[i].y *= rstd * nw.y; v[i].z *= rstd * nw.z; v[i].w *= rstd * nw.w;
      uint2 pk; pk.x = pack2(v[i].x, v[i].y); pk.y = pack2(v[i].z, v[i].w);
      *(uint2*)(xn + (size_t)row * 1024 + (lane + 64 * i) * 4) = pk;
    }
    float r = 0.f;
#pragma unroll 2
    for (int j = 0; j < 16; ++j) {
      float a = 0.f;
#pragma unroll
      for (int i = 0; i < 4; ++i) {
        float4 w = *(const float4*)&smem[j * 1024 + (lane + 64 * i) * 4];
        a += v[i].x * w.x + v[i].y * w.y + v[i].z * w.z + v[i].w * w.w;
      }
      a = wave_sum(a);
      r = (lane == j) ? a : r;
    }
    if (lane < 8) betaA[(size_t)row * 8 + lane] = 1.f / (1.f + __expf(-r));
    else if (lane < 16) {
      int idx = lane - 8;
      float xx = r + p.dt_bias[idx];
      float sp = fmaxf(xx, 0.f) + log1pf(__expf(-fabsf(xx)));
      gA[(size_t)row * 8 + idx] = -__expf(p.a_log[idx]) * sp;
    }
  }
  u16* w1 = (u16*)(p.ws + OFF_W1);
  u16* w2 = (u16*)(p.ws + OFF_W2);
  const int gt = bid * 256 + tid, gs = nb * 256;
  for (int idx = gt; idx < N1 * 128; idx += gs) {
    int n = idx % N1, kb = idx / N1;
    int col = n < 2048 ? n : n + 16;
    float f[8];
#pragma unroll
    for (int i = 0; i < 8; ++i) f[i] = p.w_in[(size_t)(kb * 8 + i) * NIN + col];
    uint4 pk; pk.x = pack2(f[0], f[1]); pk.y = pack2(f[2], f[3]); pk.z = pack2(f[4], f[5]); pk.w = pack2(f[6], f[7]);
    *(uint4*)(w1 + (size_t)n * 1024 + kb * 8) = pk;
  }
  for (int idx = gt; idx < 1024 * 128; idx += gs) {
    int n = idx & 1023, kb = idx >> 10;
    float f[8];
#pragma unroll
    for (int i = 0; i < 8; ++i) f[i] = p.w_out[(size_t)(kb * 8 + i) * 1024 + n];
    uint4 pk; pk.x = pack2(f[0], f[1]); pk.y = pack2(f[2], f[3]); pk.z = pack2(f[4], f[5]); pk.w = pack2(f[6], f[7]);
    *(uint4*)(w2 + (size_t)n * 1024 + kb * 8) = pk;
  }
  float* rc = (float*)(p.ws + OFF_ROPC);
  float* rs = (float*)(p.ws + OFF_ROPS);
  for (int idx = gt; idx < SEQ * 32; idx += gs) {
    int pos = idx >> 5, i = idx & 31;
    float inv = exp2f(-(float)i * (13.287712379549449f / 32.f));
    float ang = (float)pos * inv;
    double a = (double)ang * 0.15915494309189535;
    float fr = (float)(a - rint(a));
    rc[idx] = __builtin_amdgcn_cosf(fr); rs[idx] = __builtin_amdgcn_sinf(fr);
  }
}

template <int MODE>
__device__ void gemm_tile(const Params& p, const u16* __restrict__ A, const u16* __restrict__ Bt, int K, int m0, int n0, unsigned char* smem) {
  const int tid = threadIdx.x, wave = tid >> 6, lane = tid & 63;
  const int wm = wave >> 1, wn = wave & 1, r = lane & 31, h = lane >> 5;
  unsigned char* As = smem;
  unsigned char* Bs = smem + 32768;
  f32x16 acc[2][2];
#pragma unroll
  for (int a = 0; a < 2; ++a)
#pragma unroll
    for (int b = 0; b < 2; ++b)
#pragma unroll
      for (int i = 0; i < 16; ++i) acc[a][b][i] = 0.f;
  uint4 ra[4], rb[4];
  const int KT = K / 64;
  auto gload = [&](int kt) {
#pragma unroll
    for (int i = 0; i < 4; ++i) {
      int id = tid + 256 * i, row = id >> 3, c = id & 7;
      ra[i] = *(const uint4*)(A + (size_t)(m0 + row) * K + kt * 64 + c * 8);
      rb[i] = *(const uint4*)(Bt + (size_t)(n0 + row) * K + kt * 64 + c * 8);
    }
  };
  auto lstore = [&](int buf) {
#pragma unroll
    for (int i = 0; i < 4; ++i) {
      int id = tid + 256 * i, row = id >> 3, c = id & 7;
      int off = buf * 16384 + row * 128 + ((c ^ ((row >> 1) & 7)) << 4);
      *(uint4*)(As + off) = ra[i];
      *(uint4*)(Bs + off) = rb[i];
    }
  };
  __syncthreads();
  gload(0); lstore(0);
  __syncthreads();
  for (int kt = 0; kt < KT; ++kt) {
    if (kt + 1 < KT) gload(kt + 1);
    const int buf = kt & 1;
#pragma unroll
    for (int ks = 0; ks < 4; ++ks) {
      const int c = ks * 2 + h;
      bf16x8 af[2], bfr[2];
#pragma unroll
      for (int t = 0; t < 2; ++t) {
        int rowa = wm * 64 + t * 32 + r;
        af[t] = *(const bf16x8*)(As + buf * 16384 + rowa * 128 + ((c ^ ((rowa >> 1) & 7)) << 4));
        int rowb = wn * 64 + t * 32 + r;
        bfr[t] = *(const bf16x8*)(Bs + buf * 16384 + rowb * 128 + ((c ^ ((rowb >> 1) & 7)) << 4));
      }
#pragma unroll
      for (int a = 0; a < 2; ++a)
#pragma unroll
        for (int b = 0; b < 2; ++b) acc[a][b] = __builtin_amdgcn_mfma_f32_32x32x16_bf16(af[a], bfr[b], acc[a][b], 0, 0, 0);
    }
    if (kt + 1 < KT) lstore((kt + 1) & 1);
    __syncthreads();
  }
#pragma unroll
  for (int a = 0; a < 2; ++a)
#pragma unroll
    for (int b = 0; b < 2; ++b)
#pragma unroll
      for (int i = 0; i < 16; ++i) {
        int m = m0 + wm * 64 + a * 32 + crow(i, h);
        int n = n0 + wn * 64 + b * 32 + r;
        if (MODE == 0) {
          if (n0 < 1536) ((u16*)(p.ws + OFF_PROJA))[(size_t)m * LDA + n] = f2bf(acc[a][b][i]);
          else ((u16*)(p.ws + OFF_PROJB))[(size_t)m * LDB + (n - 1536)] = f2bf(acc[a][b][i]);
        }
        else p.out[(size_t)m * 1024 + n] = p.x[(size_t)m * 1024 + n] + acc[a][b][i];
      }
}

__device__ void phaseB(const Params& p, int bid, int nb, unsigned char* smem) {
  const u16* xn = (const u16*)(p.ws + OFF_XN);
  const u16* w1 = (const u16*)(p.ws + OFF_W1);
  for (int t = bid; t < 128 * 26; t += nb) {
    int tn = t % 26, tm = t / 26;
    gemm_tile<0>(p, xn, w1, 1024, tm * 128, tn * 128, smem);
  }
}
__device__ void phaseG(const Params& p, int bid, int nb, unsigned char* smem) {
  const u16* mix = (const u16*)(p.ws + OFF_XN);
  const u16* w2 = (const u16*)(p.ws + OFF_W2);
  for (int t = bid; t < 128 * 8; t += nb) {
    int tn = t & 7, tm = t >> 3;
    gemm_tile<1>(p, mix, w2, 1024, tm * 128, tn * 128, smem);
  }
}

__device__ void phaseC(const Params& p, int bid, int nb) {
  const int tid = threadIdx.x, wave = tid >> 6, lane = tid & 63;
  const u16* projA = (const u16*)(p.ws + OFF_PROJA);
  const u16* projB = (const u16*)(p.ws + OFF_PROJB);
  u16* qn = (u16*)(p.ws + OFF_QN);
  u16* kn = (u16*)(p.ws + OFF_KN);
  u16* vv = (u16*)(p.ws + OFF_VV);
  u16* kr = (u16*)((unsigned char*)p.out + DO_KR);
  u16* vT = (u16*)((unsigned char*)p.out + DO_VT);
  u16* qr = (u16*)(p.ws + OFF_XN);
  const float* rc = (const float*)(p.ws + OFF_ROPC);
  const float* rs = (const float*)(p.ws + OFF_ROPS);
  for (int item = bid * 4 + wave; item < M * 9; item += nb * 4) {
    const int m = item / 9, hh = item % 9;
    const int t = m & (SEQ - 1), b = m >> 13;
    if (hh < 4) {
      const int c0 = hh * 128 + 2 * lane;
      float y[3][2] = {{0.f, 0.f}, {0.f, 0.f}, {0.f, 0.f}};
#pragma unroll
      for (int j = 0; j < 5; ++j) {
        int tt = t + j - 2;
        if (tt >= 0 && tt < SEQ) {
          const u16* pr = projA + (size_t)(m + j - 2) * LDA;
#pragma unroll
          for (int s = 0; s < 3; ++s) {
            unsigned u = *(const unsigned*)(pr + s * 512 + c0);
            float2 w = *(const float2*)(p.conv_w + j * 1536 + s * 512 + c0);
            y[s][0] += bf2f((u16)(u & 0xffff)) * w.x;
            y[s][1] += bf2f((u16)(u >> 16)) * w.y;
          }
        }
      }
#pragma unroll
      for (int s = 0; s < 3; ++s) { y[s][0] = silu(y[s][0]); y[s][1] = silu(y[s][1]); }
      float sq = wave_sum(y[0][0] * y[0][0] + y[0][1] * y[0][1]);
      float sk = wave_sum(y[1][0] * y[1][0] + y[1][1] * y[1][1]);
      float fq = rsqrtf(sq + EPS) * 0.08838834764831845f;
      float fk = rsqrtf(sk + EPS);
      *(unsigned*)(qn + (size_t)m * 512 + c0) = pack2(y[0][0] * fq, y[0][1] * fq);
      *(unsigned*)(kn + (size_t)m * 512 + c0) = pack2(y[1][0] * fk, y[1][1] * fk);
      *(unsigned*)(vv + (size_t)m * 512 + c0) = pack2(y[2][0], y[2][1]);
    } else {
      const int sub = lane >> 5, d = lane & 31;
      const bool isk = (hh == 4);
      const int head = isk ? sub : (hh - 5) * 2 + sub;
      const u16* pr = projB + (size_t)m * LDB + (isk ? B_SWK : B_SWQ) + head * 64;
      const float* nw = isk ? p.knw : p.qnw;
      float x0 = bf2f(pr[d]), x1 = bf2f(pr[d + 32]);
      float ss = x0 * x0 + x1 * x1;
#pragma unroll
      for (int o = 16; o >= 1; o >>= 1) ss += __shfl_xor(ss, o);
      float rstd = rsqrtf(ss * (1.f / 64.f) + EPS) * (isk ? 1.f : 0.125f);
      float y0 = x0 * rstd * nw[d], y1 = x1 * rstd * nw[d + 32];
      float c = rc[t * 32 + d], sn = rs[t * 32 + d];
      float o0 = y0 * c - y1 * sn, o1 = y1 * c + y0 * sn;
      if (isk) {
        kr[(size_t)m * 128 + head * 64 + d] = f2bf(o0);
        kr[(size_t)m * 128 + head * 64 + d + 32] = f2bf(o1);
        const u16* pv = projB + (size_t)m * LDB + B_SWV + head * 64;
        vT[((size_t)((b * 2 + head) * 64 + d)) * SEQ + t] = pv[d];
        vT[((size_t)((b * 2 + head) * 64 + d + 32)) * SEQ + t] = pv[d + 32];
      } else {
        qr[(size_t)m * 1024 + head * 64 + d] = f2bf(o0);
        qr[(size_t)m * 1024 + head * 64 + d + 32] = f2bf(o1);
      }
    }
  }
}

__device__ void prep_tile(const Params& p, int tile, unsigned char* smem) {
  const int tid = threadIdx.x, wave = tid >> 6, lane = tid & 63;
  const int dir = tile & 1, n = (tile >> 1) & 127, bh = tile >> 8, b = bh >> 2, hh = bh & 3;
  unsigned char* ksb = smem;
  unsigned char* qsb = smem + 17408;
  float* Ms = (float*)(smem + 34816);
  float* gc = (float*)(smem + 51200);
  float* bt = gc + 64;
  const u16* qn = (const u16*)(p.ws + OFF_QN);
  const u16* kn = (const u16*)(p.ws + OFF_KN);
  const u16* vv = (const u16*)(p.ws + OFF_VV);
  const float* betaA = (const float*)(p.ws + OFF_BETA);
  const float* gA = (const float*)(p.ws + OFF_G);
  u16* pw = (u16*)(p.ws + OFF_PW) + (size_t)tile * 8192;
  u16* pu = (u16*)(p.ws + OFF_PU) + (size_t)tile * 8192;
  u16* pk = (u16*)(p.ws + OFF_PK) + (size_t)tile * 8192;
  u16* pa = (u16*)((unsigned char*)p.out + DO_PA) + (size_t)tile * 4096;
  float* pe = (float*)((unsigned char*)p.out + DO_PE) + (size_t)tile * 64;
  float* pgl = (float*)((unsigned char*)p.out + DO_PGL);
  const size_t row0 = (size_t)b * SEQ + n * 64;
  __syncthreads();
#pragma unroll
  for (int i = 0; i < 4; ++i) {
    int id = tid + 256 * i, c = id >> 4, ch = id & 15;
    int tok = dir ? 63 - c : c;
    *(uint4*)(ksb + c * 272 + ch * 16) = *(const uint4*)(kn + (row0 + tok) * 512 + hh * 128 + ch * 8);
    *(uint4*)(qsb + c * 272 + ch * 16) = *(const uint4*)(qn + (row0 + tok) * 512 + hh * 128 + ch * 8);
  }
  if (wave == 0) {
    int tok = dir ? 63 - lane : lane;
    float g = gA[(row0 + tok) * 8 + dir * 4 + hh];
    float bb = betaA[(row0 + tok) * 8 + dir * 4 + hh];
#pragma unroll
    for (int o = 1; o < 64; o <<= 1) { float t = __shfl_up(g, o); if (lane >= o) g += t; }
    gc[lane] = g; bt[lane] = bb;
    pe[lane] = __expf(g);
    if (lane == 63) pgl[tile] = __expf(g);
  }
  __syncthreads();
  {
    const int row = lane & 15, quad = lane >> 4;
    bf16x8 ak[4], aq[4];
#pragma unroll
    for (int k = 0; k < 4; ++k) {
      ak[k] = *(const bf16x8*)(ksb + (16 * wave + row) * 272 + k * 64 + quad * 16);
      aq[k] = *(const bf16x8*)(qsb + (16 * wave + row) * 272 + k * 64 + quad * 16);
    }
#pragma unroll
    for (int tc = 0; tc < 4; ++tc) {
      f32x4 ckk = {0.f, 0.f, 0.f, 0.f}, cqk = {0.f, 0.f, 0.f, 0.f};
#pragma unroll
      for (int k = 0; k < 4; ++k) {
        bf16x8 bk = *(const bf16x8*)(ksb + (16 * tc + row) * 272 + k * 64 + quad * 16);
        ckk = MFMA16(ak[k], bk, ckk);
        cqk = MFMA16(aq[k], bk, cqk);
      }
      const int s = 16 * tc + row;
      const float gs = gc[s];
#pragma unroll
      for (int j = 0; j < 4; ++j) {
        const int c = 16 * wave + quad * 4 + j;
        float dec = __expf(fminf(gc[c] - gs, 0.f));
        float mval = (s < c) ? bt[c] * ckk[j] * dec : 0.f;
        float aval = (s <= c) ? cqk[j] * dec : 0.f;
        Ms[c * 64 + s] = mval;
        pa[c * 64 + s] = f2bf(aval);
      }
    }
  }
  {
    const int dk = tid & 127, half = tid >> 7;
    const float gl = gc[63];
    unsigned pkd[16];
#pragma unroll
    for (int i = 0; i < 16; ++i) {
      int c0 = half * 32 + 2 * i;
      float k0 = bf2f(*(const u16*)(ksb + c0 * 272 + dk * 2)) * __expf(gl - gc[c0]);
      float k1 = bf2f(*(const u16*)(ksb + (c0 + 1) * 272 + dk * 2)) * __expf(gl - gc[c0 + 1]);
      pkd[i] = pack2(k0, k1);
    }
#pragma unroll
    for (int i = 0; i < 4; ++i) *(uint4*)(pk + dk * 64 + half * 32 + i * 8) = make_uint4(pkd[4 * i], pkd[4 * i + 1], pkd[4 * i + 2], pkd[4 * i + 3]);
  }
  __syncthreads();
  float x[64];
  if (tid < 128) {
#pragma unroll
    for (int c = 0; c < 64; ++c) { int tok = dir ? 63 - c : c; x[c] = bt[c] * bf2f(vv[(row0 + tok) * 512 + hh * 128 + tid]); }
  } else {
#pragma unroll
    for (int c = 0; c < 64; ++c) x[c] = bt[c] * __expf(gc[c]) * bf2f(*(const u16*)(ksb + c * 272 + (tid - 128) * 2));
  }
#pragma unroll
  for (int c = 1; c < 64; ++c) {
    const float4* mr = (const float4*)(Ms + c * 64);
    float a0 = 0.f, a1 = 0.f;
#pragma unroll
    for (int s4 = 0; s4 < (c + 3) / 4; ++s4) {
      float4 m = mr[s4];
      a0 += m.x * x[4 * s4] + m.y * x[4 * s4 + 1];
      a1 += m.z * x[4 * s4 + 2] + m.w * x[4 * s4 + 3];
    }
    x[c] -= a0 + a1;
  }
  if (tid < 128) {
#pragma unroll
    for (int i = 0; i < 8; ++i)
      *(uint4*)(pu + tid * 64 + i * 8) = make_uint4(pack2(x[8 * i], x[8 * i + 1]), pack2(x[8 * i + 2], x[8 * i + 3]), pack2(x[8 * i + 4], x[8 * i + 5]), pack2(x[8 * i + 6], x[8 * i + 7]));
  } else {
#pragma unroll
    for (int c = 0; c < 64; ++c) *(u16*)(qsb + c * 272 + (tid - 128) * 2) = f2bf(-x[c]);
  }
  __syncthreads();
#pragma unroll
  for (int i = 0; i < 4; ++i) {
    int id = tid + 256 * i, c = id >> 4, ch = id & 15;
    *(uint4*)(pw + c * 128 + ch * 8) = *(const uint4*)(qsb + c * 272 + ch * 16);
  }
}

struct ScanFrags { bf16x8 aw[4], aq[4], aa[2], akd[2][2]; uint2 u[2]; float eg; float egl; };
__device__ void scan_chunked(const Params& p, int sid, unsigned char* smem) {
  const int tid = threadIdx.x, wave = tid >> 6, lane = tid & 63, row = lane & 15, quad = lane >> 4;
  const int chain = (sid & 7) * 2 + (sid >> 5), dv0 = ((sid >> 3) & 3) * 32;
  const int b = chain >> 3, hh = (chain >> 1) & 3, dir = chain & 1;
  unsigned* prog = (unsigned*)(p.ws + OFF_PROG) + chain * 64;
  const bool publisher = (dv0 == 0) && (tid == 0);
  unsigned char* Sl = smem;
  unsigned char* Vl = smem + 8704;
  const u16* qn = (const u16*)(p.ws + OFF_QN);
  const u16* pwA = (const u16*)(p.ws + OFF_PW);
  const u16* puA = (const u16*)(p.ws + OFF_PU);
  const u16* pkA = (const u16*)(p.ws + OFF_PK);
  const u16* paA = (const u16*)((unsigned char*)p.out + DO_PA);
  const float* peA = (const float*)((unsigned char*)p.out + DO_PE);
  const float* pglA = (const float*)((unsigned char*)p.out + DO_PGL);
  u16* ob = (u16*)((unsigned char*)p.out + (dir ? DO_OB : 0));
#pragma unroll 1
  for (int rep = 0; rep < REP_S; ++rep) {
  __syncthreads();
  for (int i = tid; i < 8704 / 4; i += 256) ((unsigned*)Sl)[i] = 0u;
  f32x4 Sacc[2][2];
#pragma unroll
  for (int a = 0; a < 2; ++a)
#pragma unroll
    for (int c = 0; c < 2; ++c) Sacc[a][c] = f32x4{0.f, 0.f, 0.f, 0.f};
  auto gload = [&](ScanFrags& f, int step) {
    const int n = dir ? 127 - step : step;
    const size_t tile = ((size_t)(b * 4 + hh) * 128 + n) * 2 + dir;
    const int c = 16 * wave + row;
    const int tok = dir ? 63 - c : c;
    const size_t qrow = ((size_t)b * SEQ + n * 64 + tok) * 512 + hh * 128;
#pragma unroll
    for (int k = 0; k < 4; ++k) {
      f.aw[k] = *(const bf16x8*)(pwA + tile * 8192 + c * 128 + k * 32 + quad * 8);
      f.aq[k] = *(const bf16x8*)(qn + qrow + k * 32 + quad * 8);
    }
#pragma unroll
    for (int k = 0; k < 2; ++k) {
      f.aa[k] = *(const bf16x8*)(paA + tile * 4096 + c * 64 + k * 32 + quad * 8);
#pragma unroll
      for (int d = 0; d < 2; ++d) f.akd[d][k] = *(const bf16x8*)(pkA + tile * 8192 + (32 * wave + 16 * d + row) * 64 + k * 32 + quad * 8);
    }
#pragma unroll
    for (int nt = 0; nt < 2; ++nt) f.u[nt] = *(const uint2*)(puA + tile * 8192 + (dv0 + nt * 16 + row) * 64 + 16 * wave + quad * 4);
    f.eg = peA[tile * 64 + c];
    f.egl = pglA[tile];
  };
  auto body = [&](ScanFrags& f, ScanFrags& fn, int step) {
    if (publisher) __hip_atomic_store(prog, (unsigned)(step + 1), __ATOMIC_RELAXED, __HIP_MEMORY_SCOPE_AGENT);
    if (step + 1 < 128) gload(fn, step + 1);
    bf16x8 bS[4][2];
#pragma unroll
    for (int k = 0; k < 4; ++k)
#pragma unroll
      for (int nt = 0; nt < 2; ++nt) bS[k][nt] = *(const bf16x8*)(Sl + (nt * 16 + row) * 272 + k * 64 + quad * 16);
    f32x4 vacc[2], oacc[2];
#pragma unroll
    for (int nt = 0; nt < 2; ++nt) {
      vacc[nt] = f32x4{__uint_as_float(f.u[nt].x << 16), __uint_as_float(f.u[nt].x & 0xffff0000u), __uint_as_float(f.u[nt].y << 16), __uint_as_float(f.u[nt].y & 0xffff0000u)};
      oacc[nt] = f32x4{0.f, 0.f, 0.f, 0.f};
#pragma unroll
      for (int k = 0; k < 4; ++k) vacc[nt] = MFMA16(f.aw[k], bS[k][nt], vacc[nt]);
      *(uint2*)(Vl + (nt * 16 + row) * 144 + (16 * wave + quad * 4) * 2) = make_uint2(pack2(vacc[nt][0], vacc[nt][1]), pack2(vacc[nt][2], vacc[nt][3]));
    }
#pragma unroll
    for (int nt = 0; nt < 2; ++nt) {
#pragma unroll
      for (int k = 0; k < 4; ++k) oacc[nt] = MFMA16(bS[k][nt], f.aq[k], oacc[nt]);
      oacc[nt] *= f.eg;
    }
    asm volatile("s_waitcnt lgkmcnt(0)\n\ts_barrier" ::: "memory");
    bf16x8 bV[2][2];
#pragma unroll
    for (int k = 0; k < 2; ++k)
#pragma unroll
      for (int nt = 0; nt < 2; ++nt) bV[k][nt] = *(const bf16x8*)(Vl + (nt * 16 + row) * 144 + k * 64 + quad * 16);
#pragma unroll
    for (int d = 0; d < 2; ++d)
#pragma unroll
      for (int nt = 0; nt < 2; ++nt) {
        Sacc[d][nt] *= f.egl;
#pragma unroll
        for (int k = 0; k < 2; ++k) Sacc[d][nt] = MFMA16(f.akd[d][k], bV[k][nt], Sacc[d][nt]);
        *(uint2*)(Sl + (nt * 16 + row) * 272 + (32 * wave + 16 * d + quad * 4) * 2) = make_uint2(pack2(Sacc[d][nt][0], Sacc[d][nt][1]), pack2(Sacc[d][nt][2], Sacc[d][nt][3]));
      }
    const int n = dir ? 127 - step : step;
#pragma unroll
    for (int nt = 0; nt < 2; ++nt) {
#pragma unroll
      for (int k = 0; k < 2; ++k) oacc[nt] = MFMA16(bV[k][nt], f.aa[k], oacc[nt]);
      const int c = 16 * wave + row;
      const int tok = dir ? 63 - c : c;
      *(uint2*)(ob + ((size_t)b * SEQ + n * 64 + tok) * 512 + hh * 128 + dv0 + nt * 16 + quad * 4) = make_uint2(pack2(oacc[nt][0], oacc[nt][1]), pack2(oacc[nt][2], oacc[nt][3]));
    }
    asm volatile("s_waitcnt lgkmcnt(0)\n\ts_barrier" ::: "memory");
  };
  ScanFrags f0, f1;
  gload(f0, 0);
  __syncthreads();
#pragma unroll 1
  for (int step = 0; step < 128; step += 2) {
    body(f0, f1, step);
    body(f1, f0, step + 1);
  }
  }
}

constexpr int PF_DEPTH = 10, PF_BATCH = 4;
__device__ void scan_helper(const Params& p, int hid) {
  const int tid = threadIdx.x;
  const int chain = (hid & 7) * 2 + (hid >> 3);
  const int b = chain >> 3, hh = (chain >> 1) & 3, dir = chain & 1;
  unsigned* prog = (unsigned*)(p.ws + OFF_PROG) + chain * 64;
  const unsigned char* pw = p.ws + OFF_PW;
  const unsigned char* pu = p.ws + OFF_PU;
  const unsigned char* pk = p.ws + OFF_PK;
  const unsigned char* pa = (const unsigned char*)p.out + DO_PA;
  const unsigned char* pe = (const unsigned char*)p.out + DO_PE;
  const unsigned char* qn = p.ws + OFF_QN;
  unsigned acc = 0u;
  int cur = 1;
#pragma unroll 1
  while (cur < 128) {
    const int done = (int)__hip_atomic_load(prog, __ATOMIC_RELAXED, __HIP_MEMORY_SCOPE_AGENT);
    if (done >= 127) break;
    if (cur < done + 1) cur = done + 1;
    const int lim = done + PF_DEPTH < 128 ? done + PF_DEPTH : 128;
    if (cur >= lim) { __builtin_amdgcn_s_sleep(4); continue; }
    unsigned v[PF_BATCH][3];
#pragma unroll
    for (int i = 0; i < PF_BATCH; ++i) {
      const int st = cur + i < lim ? cur + i : lim - 1;
      const int n = dir ? 127 - st : st;
      const size_t tile = ((size_t)(b * 4 + hh) * 128 + n) * 2 + dir;
      const unsigned char* a0 = (tid < 128) ? pw + tile * 16384 + tid * 128 : pu + tile * 16384 + (tid - 128) * 128;
      const unsigned char* a1 = (tid < 128) ? pk + tile * 16384 + tid * 128 : (tid < 192 ? pa + tile * 8192 + (tid - 128) * 128 : pe + tile * 256 + (tid & 1) * 128);
      const unsigned char* a2 = qn + ((size_t)b * SEQ + n * 64 + (tid >> 2)) * 1024 + hh * 256 + (tid & 1) * 128;
      v[i][0] = *(const unsigned*)a0; v[i][1] = *(const unsigned*)a1; v[i][2] = *(const unsigned*)a2;
    }
#pragma unroll
    for (int i = 0; i < PF_BATCH; ++i) acc ^= v[i][0] ^ v[i][1] ^ v[i][2];
    cur = cur + PF_BATCH < lim ? cur + PF_BATCH : lim;
  }
  if (acc == 0x9e3779b9u && p.ws == nullptr) *(unsigned*)p.out = acc;
}

__device__ void swa_mfma(const Params& p, int bid, int nb) {
  const int wave = threadIdx.x >> 6, lane = threadIdx.x & 63, col = lane & 15, quad = lane >> 4;
  const u16* kr = (const u16*)((const unsigned char*)p.out + DO_KR);
  const u16* vT = (const u16*)((const unsigned char*)p.out + DO_VT);
  const u16* qr = (const u16*)(p.ws + OFF_XN);
  const u16* projB = (const u16*)(p.ws + OFF_PROJB);
  u16* mix = (u16*)(p.ws + OFF_XN);
  for (int unit = bid; unit < 2048; unit += nb) {
    const int qblk = unit & 511, kvh = (unit >> 9) & 1, b = unit >> 10;
    const int t0 = qblk * 16, qh = kvh * 4 + wave;
    const size_t mq = (size_t)b * SEQ + t0 + col;
    bf16x8 bq[2];
#pragma unroll
    for (int ks = 0; ks < 2; ++ks) bq[ks] = *(const bf16x8*)(qr + mq * 1024 + qh * 64 + ks * 32 + quad * 8);
    f32x4 sc[18];
#pragma unroll
    for (int kt = 0; kt < 18; ++kt) {
      int key = t0 - 128 + 16 * kt + col;
      key = key < 0 ? 0 : (key > SEQ - 1 ? SEQ - 1 : key);
      const u16* kp = kr + ((size_t)b * SEQ + key) * 128 + kvh * 64 + quad * 8;
      bf16x8 a0 = *(const bf16x8*)kp, a1 = *(const bf16x8*)(kp + 32);
      f32x4 c = {0.f, 0.f, 0.f, 0.f};
      c = MFMA16(a0, bq[0], c);
      c = MFMA16(a1, bq[1], c);
      sc[kt] = c;
    }
    const float sink = p.sinks[qh];
    float mx = sink;
#pragma unroll
    for (int kt = 0; kt < 18; ++kt)
#pragma unroll
      for (int jj = 0; jj < 4; ++jj) {
        const int key = t0 - 128 + 16 * kt + quad * 4 + jj;
        const int rel = key - (t0 + col);
        const bool valid = (rel >= -128) && (rel <= 128) && (key >= 0) && (key < SEQ);
        float v = valid ? sc[kt][jj] : -1e30f;
        sc[kt][jj] = v;
        mx = fmaxf(mx, v);
      }
    mx = fmaxf(mx, __shfl_xor(mx, 16));
    mx = fmaxf(mx, __shfl_xor(mx, 32));
    float l = 0.f;
#pragma unroll
    for (int kt = 0; kt < 18; ++kt)
#pragma unroll
      for (int jj = 0; jj < 4; ++jj) { float e = __expf(sc[kt][jj] - mx); sc[kt][jj] = e; l += e; }
    l += __shfl_xor(l, 16);
    l += __shfl_xor(l, 32);
    l += __expf(sink - mx);
    f32x4 o[4];
#pragma unroll
    for (int dt = 0; dt < 4; ++dt) o[dt] = f32x4{0.f, 0.f, 0.f, 0.f};
#pragma unroll
    for (int kg = 0; kg < 9; ++kg) {
      union { bf16x8 v; unsigned u[4]; } bp;
      bp.u[0] = pack2(sc[2 * kg][0], sc[2 * kg][1]); bp.u[1] = pack2(sc[2 * kg][2], sc[2 * kg][3]);
      bp.u[2] = pack2(sc[2 * kg + 1][0], sc[2 * kg + 1][1]); bp.u[3] = pack2(sc[2 * kg + 1][2], sc[2 * kg + 1][3]);
      const int key0 = t0 - 128 + 32 * kg + quad * 4;
      const bool ok0 = key0 >= 0 && key0 < SEQ, ok1 = key0 + 16 >= 0 && key0 + 16 < SEQ;
#pragma unroll
      for (int dt = 0; dt < 4; ++dt) {
        const u16* vp = vT + ((size_t)((b * 2 + kvh) * 64 + dt * 16 + col)) * SEQ;
        uint2 lo = make_uint2(0u, 0u), hi = make_uint2(0u, 0u);
        if (ok0) lo = *(const uint2*)(vp + key0);
        if (ok1) hi = *(const uint2*)(vp + key0 + 16);
        union { bf16x8 v; unsigned u[4]; } av;
        av.u[0] = lo.x; av.u[1] = lo.y; av.u[2] = hi.x; av.u[3] = hi.y;
        o[dt] = MFMA16(av.v, bp.v, o[dt]);
      }
    }
    const float inv = 1.f / l;
#pragma unroll
    for (int dt = 0; dt < 4; ++dt) {
      const int d0 = dt * 16 + quad * 4;
      uint2 z = *(const uint2*)(projB + mq * LDB + B_SWZ + qh * 64 + d0);
      float z0 = __uint_as_float(z.x << 16), z1 = __uint_as_float(z.x & 0xffff0000u), z2 = __uint_as_float(z.y << 16), z3 = __uint_as_float(z.y & 0xffff0000u);
      *(uint2*)(mix + mq * 1024 + 512 + qh * 64 + d0) = make_uint2(pack2(o[dt][0] * inv * silu(z0), o[dt][1] * inv * silu(z1)), pack2(o[dt][2] * inv * silu(z2), o[dt][3] * inv * silu(z3)));
    }
  }
}

__device__ void phaseF(const Params& p, int bid, int nb) {
  const int tid = threadIdx.x, wave = tid >> 6, lane = tid & 63;
  const u16* proj = (const u16*)(p.ws + OFF_PROJB);
  u16* mix = (u16*)(p.ws + OFF_XN);
  const u16* of = (const u16*)p.out;
  const u16* ob = (const u16*)((const unsigned char*)p.out + DO_OB);
  for (int item = bid * 4 + wave; item < M * 4; item += nb * 4) {
    const int m = item >> 2, hh = item & 3;
    const size_t o = (size_t)m * 512 + hh * 128 + 2 * lane;
    unsigned ua = *(const unsigned*)(of + o), ub = *(const unsigned*)(ob + o);
    float v0 = bf2f((u16)(ua & 0xffff)) + bf2f((u16)(ub & 0xffff)), v1 = bf2f((u16)(ua >> 16)) + bf2f((u16)(ub >> 16));
    float ss = wave_sum(v0 * v0 + v1 * v1);
    float rstd = rsqrtf(ss * (1.f / 128.f) + EPS);
    float2 w = *(const float2*)(p.out_norm_w + 2 * lane);
    unsigned uz = *(const unsigned*)(proj + (size_t)m * LDB + B_DNZ + hh * 128 + 2 * lane);
    float z0 = bf2f((u16)(uz & 0xffff)), z1 = bf2f((u16)(uz >> 16));
    *(unsigned*)(mix + (size_t)m * 1024 + hh * 128 + 2 * lane) = pack2(v0 * rstd * w.x * silu(z0), v1 * rstd * w.y * silu(z1));
  }
}

#if MEGA
__global__ void __launch_bounds__(256, 2) k_mega(Params p) {
  __shared__ __attribute__((aligned(16))) unsigned char smem[65536];
  cg::grid_group grid = cg::this_grid();
  const int bid = blockIdx.x, nb = gridDim.x;
  __shared__ uint4 xb_words;
  if (threadIdx.x == 0) xb_words = make_uint4(0u, 0u, 0u, 0u);
  __syncthreads();
  const XcdBarrier xbar = xcd_barrier_post((unsigned*)(p.ws + OFF_BAR), (volatile unsigned*)&xb_words);
  if (p.ws == nullptr) grid.sync();
#define GBAR() xcd_barrier(xbar)
#define REPL(n) _Pragma("unroll 1") for (int rep_ = 0; rep_ < (n); ++rep_)
  REPL(REP_A) phaseA(p, bid, nb, smem);
  GBAR();
  REPL(REP_B) phaseB(p, bid, nb, smem);
  GBAR();
  REPL(REP_C) phaseC(p, bid, nb);
  GBAR();
  REPL(REP_P) for (int t = bid; t < 2048; t += nb) prep_tile(p, t, smem);
  GBAR();
  if (bid < 64) scan_chunked(p, bid, smem);
  else if (bid < 80) scan_helper(p, bid - 64);
  else { REPL(REP_W) swa_mfma(p, bid - 80, nb - 80); }
  GBAR();
  REPL(REP_F) phaseF(p, bid, nb);
  GBAR();
  REPL(REP_G) phaseG(p, bid, nb, smem);
}
#else
template <int PH>
__global__ void __launch_bounds__(256, 2) k_phase(Params p) {
  __shared__ __attribute__((aligned(16))) unsigned char smem[65536];
  const int bid = blockIdx.x, nb = gridDim.x;
  if (PH == 0) phaseA(p, bid, nb, smem);
  if (PH == 1) phaseB(p, bid, nb, smem);
  if (PH == 2) phaseC(p, bid, nb);
  if (PH == 3) scan_chunked(p, bid, smem);
  if (PH == 6) swa_mfma(p, bid, nb);
  if (PH == 7) for (int t = bid; t < 2048; t += nb) prep_tile(p, t, smem);
  if (PH == 4) phaseF(p, bid, nb);
  if (PH == 5) phaseG(p, bid, nb, smem);
}
#endif

extern "C" void kernel_launch(void* const* d_in, const int* in_sizes, int n_in, void* d_out, int out_size, void* d_ws, size_t ws_size, hipStream_t stream) {
  Params p{};
  p.x = (const float*)d_in[0]; p.norm_w = (const float*)d_in[1]; p.w_in = (const float*)d_in[2]; p.conv_w = (const float*)d_in[3];
  p.a_log = (const float*)d_in[4]; p.dt_bias = (const float*)d_in[5]; p.out_norm_w = (const float*)d_in[6]; p.qnw = (const float*)d_in[7];
  p.knw = (const float*)d_in[8]; p.sinks = (const float*)d_in[9]; p.w_out = (const float*)d_in[10];
  p.out = (float*)d_out; p.ws = (unsigned char*)d_ws;
  if (ws_size < OFF_CTL_END) { fprintf(stderr, "workspace too small: %zu < %zu\n", ws_size, (size_t)OFF_END); return; }
#if MEGA
  static int grid_blocks = 0;
  if (!grid_blocks) {
    int dev = 0, cus = 0, per_cu = 0;
    hipGetDevice(&dev);
    hipDeviceGetAttribute(&cus, hipDeviceAttributeMultiprocessorCount, dev);
    hipOccupancyMaxActiveBlocksPerMultiprocessor(&per_cu, k_mega, 256, 0);
    if (per_cu > 2) per_cu = 2;
    grid_blocks = cus * per_cu;
  }
  void* args[] = {&p};
  (void)hipMemsetAsync((unsigned char*)d_ws + OFF_BAR, 0, OFF_CTL_END - OFF_BAR, stream);
  hipError_t e = hipLaunchCooperativeKernel((void*)k_mega, dim3(grid_blocks), dim3(256), args, 0, stream);
  if (e != hipSuccess) fprintf(stderr, "cooperative launch failed: %s (grid %d)\n", hipGetErrorString(e), grid_blocks);
#else
  k_phase<0><<<512, 256, 0, stream>>>(p);
  k_phase<1><<<512, 256, 0, stream>>>(p);
  k_phase<2><<<512, 256, 0, stream>>>(p);
  k_phase<7><<<512, 256, 0, stream>>>(p);
  k_phase<3><<<64, 256, 0, stream>>>(p);
  k_phase<6><<<512, 256, 0, stream>>>(p);
  k_phase<4><<<512, 256, 0, stream>>>(p);
  k_phase<5><<<512, 256, 0, stream>>>(p);
#endif
}
```

```cpp
#include <hip/hip_runtime.h>
#include <hip/hip_bf16.h>
#include <hip/hip_cooperative_groups.h>
#include <cstdio>
namespace cg = cooperative_groups;

#ifndef MEGA
#define MEGA 1
#endif
#define REP_A 1
#define REP_B 1
#define REP_C 1
#define REP_P 1
#define REP_S 1
#define REP_W 1
#define REP_F 1
#define REP_G 1

typedef unsigned short u16;
using bf16x8 = __attribute__((ext_vector_type(8))) short;
using f32x16 = __attribute__((ext_vector_type(16))) float;
using f32x4  = __attribute__((ext_vector_type(4))) float;
#define DI __device__ __forceinline__
#define MFMA16(a, b, c) __builtin_amdgcn_mfma_f32_16x16x32_bf16((a), (b), (c), 0, 0, 0)

constexpr int SEQ = 8192, M = 16384, D = 1024, NIN = 3344, N1 = 3328;
constexpr int C_DNQ = 0, C_DNK = 512, C_DNV = 1024, C_DNZ = 1536, C_SWQ = 2048, C_SWK = 2560, C_SWV = 2688, C_SWZ = 2816;
constexpr float EPS = 1e-6f;

constexpr int LDA = 1536, LDB = 1792;
constexpr int B_DNZ = 0, B_SWQ = 512, B_SWK = 1024, B_SWV = 1152, B_SWZ = 1280;
constexpr size_t OFF_XN   = 0;
constexpr size_t OFF_W1   = OFF_XN + (size_t)M * 1024 * 2;
constexpr size_t OFF_W2   = OFF_W1 + (size_t)N1 * 1024 * 2;
constexpr size_t OFF_BETA = OFF_W2 + (size_t)1024 * 1024 * 2;
constexpr size_t OFF_G    = OFF_BETA + (size_t)M * 8 * 4;
constexpr size_t OFF_ROPC = OFF_G + (size_t)M * 8 * 4;
constexpr size_t OFF_ROPS = OFF_ROPC + (size_t)SEQ * 32 * 4;
constexpr size_t OFF_PROJB= OFF_ROPS + (size_t)SEQ * 32 * 4;
constexpr size_t OFF_QN   = OFF_PROJB + (size_t)M * LDB * 2;
constexpr size_t OFF_KN   = OFF_QN + (size_t)M * 512 * 2;
constexpr size_t OFF_VV   = OFF_KN + (size_t)M * 512 * 2;
constexpr size_t OFF_PROJA= OFF_VV + (size_t)M * 512 * 2;
constexpr size_t OFF_PW   = OFF_PROJA;
constexpr size_t OFF_PU   = OFF_PW + (size_t)2048 * 8192 * 2;
constexpr size_t OFF_PK   = OFF_PU + (size_t)2048 * 8192 * 2;
constexpr size_t OFF_END  = OFF_PK + (size_t)2048 * 8192 * 2;
constexpr size_t DO_OB = (size_t)M * 512 * 2, DO_KR = (size_t)M * 512 * 4, DO_PA = DO_KR + (size_t)M * 128 * 4, DO_PE = DO_PA + (size_t)2048 * 4096 * 2, DO_PGL = DO_PE + (size_t)2048 * 64 * 4;
constexpr size_t DO_VT = DO_PGL + 8192;
constexpr int VT_LD = SEQ + 64;
static_assert(DO_VT + (size_t)256 * VT_LD * 2 <= (size_t)M * 1024 * 4, "d_out scratch overflow");
constexpr size_t OFF_BAR  = OFF_END;
constexpr size_t OFF_PROG = OFF_BAR + 16384;
constexpr size_t OFF_CTL_END = OFF_PROG + 16 * 256;
static_assert(OFF_CTL_END <= (size_t)256 * 1024 * 1024, "workspace overflow");

struct Params {
  const float *x, *norm_w, *w_in, *conv_w, *a_log, *dt_bias, *out_norm_w, *qnw, *knw, *sinks, *w_out;
  float* out;
  unsigned char* ws;
};

DI u16 f2bf(float x) { __bf16 r = (__bf16)x; return __builtin_bit_cast(u16, r); }
DI float bf2f(u16 v) { return __uint_as_float(((unsigned)v) << 16); }
typedef float f32x2_t __attribute__((ext_vector_type(2)));
typedef __bf16 bf16x2_t __attribute__((ext_vector_type(2)));
DI unsigned pack2(float a, float b) { f32x2_t v = {a, b}; bf16x2_t r = __builtin_convertvector(v, bf16x2_t); return __builtin_bit_cast(unsigned, r); }
DI float wave_sum(float v) {
#pragma unroll
  for (int o = 32; o >= 1; o >>= 1) v += __shfl_xor(v, o);
  return v;
}
DI float silu(float y) { return y / (1.f + __expf(-y)); }
#define XB_TMO      128
#define XB_XCNT(j)  (256  + 64 * (j))
#define XB_XSUB(j)  (1280 + 64 * (j))
#define XB_XGEN(j)  (2304 + 64 * (j))
#define XB_TOP      3328
#define XB_TOPGEN   3392
#define XCD_BAR_WORDS 3456
#define XB_SPIN_CAP (1u << 20)
DI unsigned xb_ld(unsigned* p) { return __hip_atomic_load(p, __ATOMIC_RELAXED, __HIP_MEMORY_SCOPE_AGENT); }
DI unsigned xb_add(unsigned* p, unsigned v) { return __hip_atomic_fetch_add(p, v, __ATOMIC_RELAXED, __HIP_MEMORY_SCOPE_AGENT); }
DI unsigned xb_xcc_id() { return (unsigned)__builtin_amdgcn_s_getreg((3 << 11) | 20) & 0xFu; }
#define XB_SPIN(cond, bar) do { unsigned _sp = 0; while (cond) { __builtin_amdgcn_s_sleep(1); \
    if ((++_sp & 255u) == 0u) { if (xb_ld(&(bar)[XB_TMO])) break; if (_sp > XB_SPIN_CAP) { atomicAdd(&(bar)[XB_TMO], 1u); break; } } } } while (0)
struct XcdBarrier { unsigned* bar; unsigned x; volatile unsigned* st; };
DI XcdBarrier xcd_barrier_post(unsigned* bar, volatile unsigned* st) {
  XcdBarrier b; b.bar = bar; b.x = xb_xcc_id(); b.st = st;
  if (threadIdx.x == 0) (void)xb_add(&bar[XB_XCNT(b.x)], 1u);
  return b;
}
DI void xcd_barrier_complete(unsigned* bar, unsigned x, unsigned& nloc, unsigned& nx) {
  const unsigned G = gridDim.x;
  unsigned sum, cnt, mine, sp = 0u;
  for (;;) {
    sum = 0u; cnt = 0u; mine = 0u;
#pragma unroll
    for (unsigned j = 0; j < 16; ++j) { const unsigned c = xb_ld(&bar[XB_XCNT(j)]); sum += c; cnt += (c > 0u) ? 1u : 0u; mine = (j == x) ? c : mine; }
    if (sum == G) break;
    __builtin_amdgcn_s_sleep(1);
    if ((++sp & 255u) == 0u) { if (xb_ld(&bar[XB_TMO])) break; if (sp > XB_SPIN_CAP) { atomicAdd(&bar[XB_TMO], 1u); break; } }
  }
  nloc = mine > 0u ? mine : 1u; nx = cnt > 0u ? cnt : 1u;
}
DI void xcd_barrier(const XcdBarrier& b) {
  asm volatile("s_waitcnt vmcnt(0)" ::: "memory");
  __syncthreads();
  if (threadIdx.x == 0) {
    unsigned* bar = b.bar;
    __builtin_amdgcn_s_waitcnt(0);
    unsigned nloc = b.st[0], nx = b.st[1];
    if (nloc == 0u) { xcd_barrier_complete(bar, b.x, nloc, nx); b.st[0] = nloc; b.st[1] = nx; }
    const unsigned old = xb_add(&bar[XB_XSUB(b.x)], 1u);
    const unsigned gen = old / nloc;
    if (old + 1u == (gen + 1u) * nloc) {
      __builtin_amdgcn_fence(__ATOMIC_RELEASE, "agent");
      asm volatile("s_waitcnt vmcnt(0)" ::: "memory");
      const unsigned og = xb_add(&bar[XB_TOP], 1u);
      const unsigned tg = og / nx;
      if (og + 1u == (tg + 1u) * nx) xb_add(&bar[XB_TOPGEN], 1u);
      else XB_SPIN(xb_ld(&bar[XB_TOPGEN]) == tg, bar);
      __builtin_amdgcn_fence(__ATOMIC_ACQUIRE, "agent");
      xb_add(&bar[XB_XGEN(b.x)], 1u);
      asm volatile("s_waitcnt vmcnt(0)" ::: "memory");
    } else {
      XB_SPIN(xb_ld(&bar[XB_XGEN(b.x)]) == gen, bar);
      __builtin_amdgcn_fence(__ATOMIC_ACQUIRE, "agent");
      asm volatile("s_waitcnt vmcnt(0)" ::: "memory");
    }
  }
  __syncthreads();
}
DI int crow(int i, int h) { return (i & 3) + 8 * (i >> 2) + 4 * h; }

__device__ void phaseA(const Params& p, int bid, int nb, unsigned char* smem_raw) {
  float* smem = (float*)smem_raw;
  const int tid = threadIdx.x, wave = tid >> 6, lane = tid & 63;
  for (int i = tid; i < 16 * 1024; i += 256) { int k = i >> 4, j = i & 15; smem[j * 1024 + k] = p.w_in[(size_t)k * NIN + 2048 + j]; }
  __syncthreads();
  u16* xn = (u16*)(p.ws + OFF_XN);
  float* betaA = (float*)(p.ws + OFF_BETA);
  float* gA = (float*)(p.ws + OFF_G);
  for (int row = bid * 4 + wave; row < M; row += nb * 4) {
    const float4* xr = (const float4*)(p.x + (size_t)row * D);
    float4 v[4]; float ss = 0.f;
#pragma unroll
    for (int i = 0; i < 4; ++i) { v[i] = xr[lane + 64 * i]; ss += v[i].x * v[i].x + v[i].y * v[i].y + v[i].z * v[i].z + v[i].w * v[i].w; }
    ss = wave_sum(ss);
    const float rstd = rsqrtf(ss * (1.f / 1024.f) + EPS);
#pragma unroll
    for (int i = 0; i < 4; ++i) {
      float4 nw = ((const float4*)p.norm_w)[lane + 64 * i];
      v[i].x *= rstd * nw.x; v[i].y *= rstd * nw.y; v[i].z *= rstd * nw.z; v[i].w *= rstd * nw.w;
      uint2 pk; pk.x = pack2(v[i].x, v[i].y); pk.y = pack2(v[i].z, v[i].w);
      *(uint2*)(xn + (size_t)row * 1024 + (lane + 64 * i) * 4) = pk;
    }
    float r = 0.f;
#pragma unroll 2
    for (int j = 0; j < 16; ++j) {
      float a = 0.f;
#pragma unroll
      for (int i = 0; i < 4; ++i) {
        float4 w = *(const float4*)&smem[j * 1024 + (lane + 64 * i) * 4];
        a += v[i].x * w.x + v[i].y * w.y + v[i].z * w.z + v[i].w * w.w;
      }
      a = wave_sum(a);
      r = (lane == j) ? a : r;
    }
    if (lane < 8) betaA[(size_t)row * 8 + lane] = 1.f / (1.f + __expf(-r));
    else if (lane < 16) {
      int idx = lane - 8;
      float xx = r + p.dt_bias[idx];
      float sp = fmaxf(xx, 0.f) + log1pf(__expf(-fabsf(xx)));
      gA[(size_t)row * 8 + idx] = -__expf(p.a_log[idx]) * sp;
    }
  }
  u16* w1 = (u16*)(p.ws + OFF_W1);
  u16* w2 = (u16*)(p.ws + OFF_W2);
  const int gt = bid * 256 + tid, gs = nb * 256;
  for (int idx = gt; idx < N1 * 128; idx += gs) {
    int n = idx % N1, kb = idx / N1;
    int col = n < 2048 ? n : n + 16;
    float f[8];
#pragma unroll
    for (int i = 0; i < 8; ++i) f[i] = p.w_in[(size_t)(kb * 8 + i) * NIN + col];
    uint4 pk; pk.x = pack2(f[0], f[1]); pk.y = pack2(f[2], f[3]); pk.z = pack2(f[4], f[5]); pk.w = pack2(f[6], f[7]);
    *(uint4*)(w1 + (size_t)n * 1024 + kb * 8) = pk;
  }
  for (int idx = gt; idx < 1024 * 128; idx += gs) {
    int n = idx & 1023, kb = idx >> 10;
    float f[8];
#pragma unroll
    for (int i = 0; i < 8; ++i) f[i] = p.w_out[(size_t)(kb * 8 + i) * 1024 + n];
    uint4 pk; pk.x = pack2(f[0], f[1]); pk.y = pack2(f[2], f[3]); pk.z = pack2(f[4], f[5]); pk.w = pack2(f[6], f[7]);
    *(uint4*)(w2 + (size_t)n * 1024 + kb * 8) = pk;
  }
  float* rc = (float*)(p.ws + OFF_ROPC);
  float* rs = (float*)(p.ws + OFF_ROPS);
  for (int idx = gt; idx < SEQ * 32; idx += gs) {
    int pos = idx >> 5, i = idx & 31;
    float inv = exp2f(-(float)i * (13.287712379549449f / 32.f));
    float ang = (float)pos * inv;
    double a = (double)ang * 0.15915494309189535;
    float fr = (float)(a - rint(a));
    rc[idx] = __builtin_amdgcn_cosf(fr); rs[idx] = __builtin_amdgcn_sinf(fr);
  }
}

template <int MODE>
__device__ void gemm_tile(const Params& p, const u16* __restrict__ A, const u16* __restrict__ Bt, int K, int m0, int n0, unsigned char* smem) {
  const int tid = threadIdx.x, wave = tid >> 6, lane = tid & 63;
  const int wm = wave >> 1, wn = wave & 1, r = lane & 31, h = lane >> 5;
  unsigned char* As = smem;
  unsigned char* Bs = smem + 32768;
  f32x16 acc[2][2];
#pragma unroll
  for (int a = 0; a < 2; ++a)
#pragma unroll
    for (int b = 0; b < 2; ++b)
#pragma unroll
      for (int i = 0; i < 16; ++i) acc[a][b][i] = 0.f;
  uint4 ra[4], rb[4];
  const int KT = K / 64;
  auto gload = [&](int kt) {
#pragma unroll
    for (int i = 0; i < 4; ++i) {
      int id = tid + 256 * i, row = id >> 3, c = id & 7;
      ra[i] = *(const uint4*)(A + (size_t)(m0 + row) * K + kt * 64 + c * 8);
      rb[i] = *(const uint4*)(Bt + (size_t)(n0 + row) * K + kt * 64 + c * 8);
    }
  };
  auto lstore = [&](int buf) {
#pragma unroll
    for (int i = 0; i < 4; ++i) {
      int id = tid + 256 * i, row = id >> 3, c = id & 7;
      int off = buf * 16384 + row * 128 + ((c ^ ((row >> 1) & 7)) << 4);
      *(uint4*)(As + off) = ra[i];
      *(uint4*)(Bs + off) = rb[i];
    }
  };
  __syncthreads();
  gload(0); lstore(0);
  __syncthreads();
  for (int kt = 0; kt < KT; ++kt) {
    if (kt + 1 < KT) gload(kt + 1);
    const int buf = kt & 1;
#pragma unroll
    for (int ks = 0; ks < 4; ++ks) {
      const int c = ks * 2 + h;
      bf16x8 af[2], bfr[2];
#pragma unroll
      for (int t = 0; t < 2; ++t) {
        int rowa = wm * 64 + t * 32 + r;
        af[t] = *(const bf16x8*)(As + buf * 16384 + rowa * 128 + ((c ^ ((rowa >> 1) & 7)) << 4));
        int rowb = wn * 64 + t * 32 + r;
        bfr[t] = *(const bf16x8*)(Bs + buf * 16384 + rowb * 128 + ((c ^ ((rowb >> 1) & 7)) << 4));
      }
#pragma unroll
      for (int a = 0; a < 2; ++a)
#pragma unroll
        for (int b = 0; b < 2; ++b) acc[a][b] = __builtin_amdgcn_mfma_f32_32x32x16_bf16(af[a], bfr[b], acc[a][b], 0, 0, 0);
    }
    if (kt + 1 < KT) lstore((kt + 1) & 1);
    __syncthreads();
  }
#pragma unroll
  for (int a = 0; a < 2; ++a)
#pragma unroll
    for (int b = 0; b < 2; ++b)
#pragma unroll
      for (int i = 0; i < 16; ++i) {
        int m = m0 + wm * 64 + a * 32 + crow(i, h);
        int n = n0 + wn * 64 + b * 32 + r;
        if (MODE == 0) {
          if (n0 < 1536) ((u16*)(p.ws + OFF_PROJA))[(size_t)m * LDA + n] = f2bf(acc[a][b][i]);
          else ((u16*)(p.ws + OFF_PROJB))[(size_t)m * LDB + (n - 1536)] = f2bf(acc[a][b][i]);
        }
        else p.out[(size_t)m * 1024 + n] = p.x[(size_t)m * 1024 + n] + acc[a][b][i];
      }
}

__device__ void phaseB(const Params& p, int bid, int nb, unsigned char* smem) {
  const u16* xn = (const u16*)(p.ws + OFF_XN);
  const u16* w1 = (const u16*)(p.ws + OFF_W1);
  for (int t = bid; t < 128 * 26; t += nb) {
    int tn = t % 26, tm = t / 26;
    gemm_tile<0>(p, xn, w1, 1024, tm * 128, tn * 128, smem);
  }
}
__device__ void phaseG(const Params& p, int bid, int nb, unsigned char* smem) {
  const u16* mix = (const u16*)(p.ws + OFF_XN);
  const u16* w2 = (const u16*)(p.ws + OFF_W2);
  for (int t = bid; t < 128 * 8; t += nb) {
    int tn = t & 7, tm = t >> 3;
    gemm_tile<1>(p, mix, w2, 1024, tm * 128, tn * 128, smem);
  }
}

__device__ void phaseC(const Params& p, int bid, int nb) {
  const int tid = threadIdx.x, wave = tid >> 6, lane = tid & 63;
  const u16* projA = (const u16*)(p.ws + OFF_PROJA);
  const u16* projB = (const u16*)(p.ws + OFF_PROJB);
  u16* qn = (u16*)(p.ws + OFF_QN);
  u16* kn = (u16*)(p.ws + OFF_KN);
  u16* vv = (u16*)(p.ws + OFF_VV);
  u16* kr = (u16*)((unsigned char*)p.out + DO_KR);
  u16* vT = (u16*)((unsigned char*)p.out + DO_VT);
  u16* qr = (u16*)(p.ws + OFF_XN);
  const float* rc = (const float*)(p.ws + OFF_ROPC);
  const float* rs = (const float*)(p.ws + OFF_ROPS);
  for (int item = bid * 4 + wave; item < M * 9; item += nb * 4) {
    const int m = item / 9, hh = item % 9;
    const int t = m & (SEQ - 1), b = m >> 13;
    if (hh < 4) {
      const int c0 = hh * 128 + 2 * lane;
      float y[3][2] = {{0.f, 0.f}, {0.f, 0.f}, {0.f, 0.f}};
#pragma unroll
      for (int j = 0; j < 5; ++j) {
        int tt = t + j - 2;
        if (tt >= 0 && tt < SEQ) {
          const u16* pr = projA + (size_t)(m + j - 2) * LDA;
#pragma unroll
          for (int s = 0; s < 3; ++s) {
            unsigned u = *(const unsigned*)(pr + s * 512 + c0);
            float2 w = *(const float2*)(p.conv_w + j * 1536 + s * 512 + c0);
            y[s][0] += bf2f((u16)(u & 0xffff)) * w.x;
            y[s][1] += bf2f((u16)(u >> 16)) * w.y;
          }
        }
      }
#pragma unroll
      for (int s = 0; s < 3; ++s) { y[s][0] = silu(y[s][0]); y[s][1] = silu(y[s][1]); }
      float sq = wave_sum(y[0][0] * y[0][0] + y[0][1] * y[0][1]);
      float sk = wave_sum(y[1][0] * y[1][0] + y[1][1] * y[1][1]);
      float fq = rsqrtf(sq + EPS) * 0.08838834764831845f;
      float fk = rsqrtf(sk + EPS);
      *(unsigned*)(qn + (size_t)m * 512 + c0) = pack2(y[0][0] * fq, y[0][1] * fq);
      *(unsigned*)(kn + (size_t)m * 512 + c0) = pack2(y[1][0] * fk, y[1][1] * fk);
      *(unsigned*)(vv + (size_t)m * 512 + c0) = pack2(y[2][0], y[2][1]);
    } else {
      const int sub = lane >> 5, d = lane & 31;
      const bool isk = (hh == 4);
      const int head = isk ? sub : (hh - 5) * 2 + sub;
      const u16* pr = projB + (size_t)m * LDB + (isk ? B_SWK : B_SWQ) + head * 64;
      const float* nw = isk ? p.knw : p.qnw;
      float x0 = bf2f(pr[d]), x1 = bf2f(pr[d + 32]);
      float ss = x0 * x0 + x1 * x1;
#pragma unroll
      for (int o = 16; o >= 1; o >>= 1) ss += __shfl_xor(ss, o);
      float rstd = rsqrtf(ss * (1.f / 64.f) + EPS) * (isk ? 1.f : 0.125f);
      float y0 = x0 * rstd * nw[d], y1 = x1 * rstd * nw[d + 32];
      float c = rc[t * 32 + d], sn = rs[t * 32 + d];
      float o0 = y0 * c - y1 * sn, o1 = y1 * c + y0 * sn;
      if (isk) {
        kr[(size_t)m * 128 + head * 64 + d] = f2bf(o0);
        kr[(size_t)m * 128 + head * 64 + d + 32] = f2bf(o1);
        const u16* pv = projB + (size_t)m * LDB + B_SWV + head * 64;
        vT[((size_t)((b * 2 + head) * 64 + d)) * VT_LD + t] = pv[d];
        vT[((size_t)((b * 2 + head) * 64 + d + 32)) * VT_LD + t] = pv[d + 32];
      } else {
        qr[(size_t)m * 1024 + head * 64 + d] = f2bf(o0);
        qr[(size_t)m * 1024 + head * 64 + d + 32] = f2bf(o1);
      }
    }
  }
}

__device__ void prep_tile(const Params& p, int tile, unsigned char* smem) {
  int tid_ = threadIdx.x;
  asm volatile("" : "+v"(tid_));
  const int tid = tid_, wave = __builtin_amdgcn_readfirstlane(tid >> 6), lane = tid & 63;
  const int dir = tile & 1, n = (tile >> 1) & 127, bh = tile >> 8, b = bh >> 2, hh = bh & 3;
  unsigned char* ksb = smem;
  unsigned char* qsb = smem + 17408;
  float* Ms = (float*)(smem + 34816);
  float* gc = (float*)(smem + 51200);
  float* bt = gc + 64;
  const u16* qn = (const u16*)(p.ws + OFF_QN);
  const u16* kn = (const u16*)(p.ws + OFF_KN);
  const u16* vv = (const u16*)(p.ws + OFF_VV);
  const float* betaA = (const float*)(p.ws + OFF_BETA);
  const float* gA = (const float*)(p.ws + OFF_G);
  u16* pw = (u16*)(p.ws + OFF_PW) + (size_t)tile * 8192;
  u16* pu = (u16*)(p.ws + OFF_PU) + (size_t)tile * 8192;
  u16* pk = (u16*)(p.ws + OFF_PK) + (size_t)tile * 8192;
  u16* pa = (u16*)((unsigned char*)p.out + DO_PA) + (size_t)tile * 4096;
  float* pe = (float*)((unsigned char*)p.out + DO_PE) + (size_t)tile * 64;
  float* pgl = (float*)((unsigned char*)p.out + DO_PGL);
  const size_t row0 = (size_t)b * SEQ + n * 64;
  __syncthreads();
#pragma unroll
  for (int i = 0; i < 4; ++i) {
    int id = tid + 256 * i, c = id >> 4, ch = id & 15;
    int tok = dir ? 63 - c : c;
    *(uint4*)(ksb + c * 272 + ch * 16) = *(const uint4*)(kn + (row0 + tok) * 512 + hh * 128 + ch * 8);
    *(uint4*)(qsb + c * 272 + ch * 16) = *(const uint4*)(qn + (row0 + tok) * 512 + hh * 128 + ch * 8);
  }
  if (wave == 0) {
    int tok = dir ? 63 - lane : lane;
    float g = gA[(row0 + tok) * 8 + dir * 4 + hh];
    float bb = betaA[(row0 + tok) * 8 + dir * 4 + hh];
#pragma unroll
    for (int o = 1; o < 64; o <<= 1) { float t = __shfl_up(g, o); if (lane >= o) g += t; }
    gc[lane] = g; bt[lane] = bb;
    pe[lane] = __expf(g);
    if (lane == 63) pgl[tile] = __expf(g);
  }
  __syncthreads();
  {
    const int row = lane & 15, quad = lane >> 4;
    bf16x8 ak[4], aq[4];
#pragma unroll
    for (int k = 0; k < 4; ++k) {
      ak[k] = *(const bf16x8*)(ksb + (16 * wave + row) * 272 + k * 64 + quad * 16);
      aq[k] = *(const bf16x8*)(qsb + (16 * wave + row) * 272 + k * 64 + quad * 16);
    }
#pragma unroll
    for (int tc = 0; tc < 4; ++tc) {
      f32x4 ckk = {0.f, 0.f, 0.f, 0.f}, cqk = {0.f, 0.f, 0.f, 0.f};
#pragma unroll
      for (int k = 0; k < 4; ++k) {
        bf16x8 bk = *(const bf16x8*)(ksb + (16 * tc + row) * 272 + k * 64 + quad * 16);
        ckk = MFMA16(ak[k], bk, ckk);
        cqk = MFMA16(aq[k], bk, cqk);
      }
      const int s = 16 * tc + row;
      const float gs = gc[s];
#pragma unroll
      for (int j = 0; j < 4; ++j) {
        const int c = 16 * wave + quad * 4 + j;
        float dec = __expf(fminf(gc[c] - gs, 0.f));
        float mval = (s < c) ? bt[c] * ckk[j] * dec : 0.f;
        float aval = (s <= c) ? cqk[j] * dec : 0.f;
        Ms[c * 64 + s] = mval;
        pa[c * 64 + s] = f2bf(aval);
      }
    }
  }
  {
    const int dk = tid & 127, half = tid >> 7;
    const float gl = gc[63];
    unsigned pkd[16];
#pragma unroll
    for (int i = 0; i < 16; ++i) {
      int c0 = half * 32 + 2 * i;
      float k0 = bf2f(*(const u16*)(ksb + c0 * 272 + dk * 2)) * __expf(gl - gc[c0]);
      float k1 = bf2f(*(const u16*)(ksb + (c0 + 1) * 272 + dk * 2)) * __expf(gl - gc[c0 + 1]);
      pkd[i] = pack2(k0, k1);
    }
#pragma unroll
    for (int i = 0; i < 4; ++i) *(uint4*)(pk + dk * 64 + half * 32 + i * 8) = make_uint4(pkd[4 * i], pkd[4 * i + 1], pkd[4 * i + 2], pkd[4 * i + 3]);
  }
  __syncthreads();
  float x[64];
  if (tid < 128) {
#pragma unroll
    for (int c = 0; c < 64; ++c) { int tok = dir ? 63 - c : c; x[c] = bt[c] * bf2f(vv[(row0 + tok) * 512 + hh * 128 + tid]); }
  } else {
#pragma unroll
    for (int c = 0; c < 64; ++c) x[c] = bt[c] * __expf(gc[c]) * bf2f(*(const u16*)(ksb + c * 272 + (tid - 128) * 2));
  }
  __syncthreads();
  unsigned char* xs = smem;
  unsigned char* ys = smem + 51712;
  {
    const int row = lane & 15, quad = lane >> 4;
#pragma unroll
    for (int I = 0; I < 4; ++I) {
      asm volatile("" ::: "memory");
      if (I > 0) {
        f32x4 yacc[4];
#pragma unroll
        for (int nt = 0; nt < 4; ++nt) yacc[nt] = f32x4{0.f, 0.f, 0.f, 0.f};
#pragma unroll
        for (int ks = 0; ks < (16 * I + 31) / 32; ++ks) {
          const bool live = (ks * 32 + quad * 8) < 16 * I;
          const float4 m0 = *(const float4*)(Ms + (16 * I + row) * 64 + ks * 32 + quad * 8);
          const float4 m1 = *(const float4*)(Ms + (16 * I + row) * 64 + ks * 32 + quad * 8 + 4);
          union { bf16x8 v; unsigned u[4]; } af;
          af.u[0] = live ? pack2(m0.x, m0.y) : 0u; af.u[1] = live ? pack2(m0.z, m0.w) : 0u;
          af.u[2] = live ? pack2(m1.x, m1.y) : 0u; af.u[3] = live ? pack2(m1.z, m1.w) : 0u;
          const int qe = live ? quad : (quad & 1);
#pragma unroll
          for (int nt = 0; nt < 4; ++nt) {
            const bf16x8 bx = *(const bf16x8*)(xs + (64 * wave + 16 * nt + row) * 112 + (ks * 32 + qe * 8) * 2);
            yacc[nt] = MFMA16(af.v, bx, yacc[nt]);
          }
        }
#pragma unroll
        for (int nt = 0; nt < 4; ++nt)
          *(uint2*)(ys + (64 * wave + 16 * nt + row) * 48 + quad * 8) = make_uint2(pack2(yacc[nt][0], yacc[nt][1]), pack2(yacc[nt][2], yacc[nt][3]));
        const uint4 y0 = *(const uint4*)(ys + tid * 48), y1 = *(const uint4*)(ys + tid * 48 + 16);
        const unsigned yy[8] = {y0.x, y0.y, y0.z, y0.w, y1.x, y1.y, y1.z, y1.w};
#pragma unroll
        for (int r = 0; r < 16; ++r) x[16 * I + r] -= (r & 1) ? __uint_as_float(yy[r >> 1] & 0xffff0000u) : __uint_as_float(yy[r >> 1] << 16);
      }
      int mrow[16];
#pragma unroll
      for (int r = 1; r < 16; ++r) mrow[r] = __float_as_int(Ms[(16 * I + r) * 64 + lane]);
#pragma unroll
      for (int r = 1; r < 16; ++r) {
        float a0 = 0.f, a1 = 0.f;
#pragma unroll
        for (int sidx = 0; sidx < r; ++sidx) {
          const float m = __int_as_float(__builtin_amdgcn_readlane(mrow[r], 16 * I + sidx));
          if (sidx & 1) a1 = fmaf(m, x[16 * I + sidx], a1); else a0 = fmaf(m, x[16 * I + sidx], a0);
        }
        x[16 * I + r] -= a0 + a1;
      }
      if (I < 3) {
#pragma unroll
        for (int i = 0; i < 2; ++i)
          *(uint4*)(xs + tid * 112 + I * 32 + i * 16) = make_uint4(pack2(x[16 * I + 8 * i], x[16 * I + 8 * i + 1]), pack2(x[16 * I + 8 * i + 2], x[16 * I + 8 * i + 3]),
                                                                 pack2(x[16 * I + 8 * i + 4], x[16 * I + 8 * i + 5]), pack2(x[16 * I + 8 * i + 6], x[16 * I + 8 * i + 7]));
      }
    }
  }
  __syncthreads();
  if (tid < 128) {
#pragma unroll
    for (int i = 0; i < 8; ++i)
      *(uint4*)(pu + tid * 64 + i * 8) = make_uint4(pack2(x[8 * i], x[8 * i + 1]), pack2(x[8 * i + 2], x[8 * i + 3]), pack2(x[8 * i + 4], x[8 * i + 5]), pack2(x[8 * i + 6], x[8 * i + 7]));
  } else {
#pragma unroll
    for (int c = 0; c < 64; ++c) *(u16*)(qsb + c * 272 + (tid - 128) * 2) = f2bf(-x[c]);
  }
  __syncthreads();
#pragma unroll
  for (int i = 0; i < 4; ++i) {
    int id = tid + 256 * i, c = id >> 4, ch = id & 15;
    *(uint4*)(pw + c * 128 + ch * 8) = *(const uint4*)(qsb + c * 272 + ch * 16);
  }
}

struct ScanFrags { bf16x8 aw[4], aq[4], aa[2], akd[2][2]; uint2 u[2]; float eg; float egl; };
__device__ void scan_chunked(const Params& p, int sid, unsigned char* smem) {
  const int tid = threadIdx.x, wave = tid >> 6, lane = tid & 63, row = lane & 15, quad = lane >> 4;
  const int chain = (sid & 7) * 2 + (sid >> 5), dv0 = ((sid >> 3) & 3) * 32;
  const int b = chain >> 3, hh = (chain >> 1) & 3, dir = chain & 1;
  unsigned* prog = (unsigned*)(p.ws + OFF_PROG) + chain * 64;
  const bool publisher = (dv0 == 0) && (tid == 0);
  unsigned char* Sl = smem;
  unsigned char* Vl = smem + 8704;
  const u16* qn = (const u16*)(p.ws + OFF_QN);
  const u16* pwA = (const u16*)(p.ws + OFF_PW);
  const u16* puA = (const u16*)(p.ws + OFF_PU);
  const u16* pkA = (const u16*)(p.ws + OFF_PK);
  const u16* paA = (const u16*)((unsigned char*)p.out + DO_PA);
  const float* peA = (const float*)((unsigned char*)p.out + DO_PE);
  const float* pglA = (const float*)((unsigned char*)p.out + DO_PGL);
  u16* ob = (u16*)((unsigned char*)p.out + (dir ? DO_OB : 0));
#pragma unroll 1
  for (int rep = 0; rep < REP_S; ++rep) {
  __syncthreads();
  for (int i = tid; i < 8704 / 4; i += 256) ((unsigned*)Sl)[i] = 0u;
  f32x4 Sacc[2][2];
#pragma unroll
  for (int a = 0; a < 2; ++a)
#pragma unroll
    for (int c = 0; c < 2; ++c) Sacc[a][c] = f32x4{0.f, 0.f, 0.f, 0.f};
  auto gload = [&](ScanFrags& f, int step) {
    const int n = dir ? 127 - step : step;
    const size_t tile = ((size_t)(b * 4 + hh) * 128 + n) * 2 + dir;
    const int c = 16 * wave + row;
    const int tok = dir ? 63 - c : c;
    const size_t qrow = ((size_t)b * SEQ + n * 64 + tok) * 512 + hh * 128;
#pragma unroll
    for (int k = 0; k < 4; ++k) {
      f.aw[k] = *(const bf16x8*)(pwA + tile * 8192 + c * 128 + k * 32 + quad * 8);
      f.aq[k] = *(const bf16x8*)(qn + qrow + k * 32 + quad * 8);
    }
#pragma unroll
    for (int k = 0; k < 2; ++k) {
      f.aa[k] = *(const bf16x8*)(paA + tile * 4096 + c * 64 + k * 32 + quad * 8);
#pragma unroll
      for (int d = 0; d < 2; ++d) f.akd[d][k] = *(const bf16x8*)(pkA + tile * 8192 + (32 * wave + 16 * d + row) * 64 + k * 32 + quad * 8);
    }
#pragma unroll
    for (int nt = 0; nt < 2; ++nt) f.u[nt] = *(const uint2*)(puA + tile * 8192 + (dv0 + nt * 16 + row) * 64 + 16 * wave + quad * 4);
    f.eg = peA[tile * 64 + c];
    f.egl = pglA[tile];
  };
  auto body = [&](ScanFrags& f, ScanFrags& fn, int step) {
    if (publisher) __hip_atomic_store(prog, (unsigned)(step + 1), __ATOMIC_RELAXED, __HIP_MEMORY_SCOPE_AGENT);
    if (step + 1 < 128) gload(fn, step + 1);
    bf16x8 bS[4][2];
#pragma unroll
    for (int k = 0; k < 4; ++k)
#pragma unroll
      for (int nt = 0; nt < 2; ++nt) bS[k][nt] = *(const bf16x8*)(Sl + (nt * 16 + row) * 272 + k * 64 + quad * 16);
    f32x4 vacc[2], oacc[2];
#pragma unroll
    for (int nt = 0; nt < 2; ++nt) {
      vacc[nt] = f32x4{__uint_as_float(f.u[nt].x << 16), __uint_as_float(f.u[nt].x & 0xffff0000u), __uint_as_float(f.u[nt].y << 16), __uint_as_float(f.u[nt].y & 0xffff0000u)};
      oacc[nt] = f32x4{0.f, 0.f, 0.f, 0.f};
#pragma unroll
      for (int k = 0; k < 4; ++k) vacc[nt] = MFMA16(f.aw[k], bS[k][nt], vacc[nt]);
      *(uint2*)(Vl + (nt * 16 + row) * 144 + (16 * wave + quad * 4) * 2) = make_uint2(pack2(vacc[nt][0], vacc[nt][1]), pack2(vacc[nt][2], vacc[nt][3]));
    }
#pragma unroll
    for (int nt = 0; nt < 2; ++nt) {
#pragma unroll
      for (int k = 0; k < 4; ++k) oacc[nt] = MFMA16(bS[k][nt], f.aq[k], oacc[nt]);
      oacc[nt] *= f.eg;
    }
    asm volatile("s_waitcnt lgkmcnt(0)\n\ts_barrier" ::: "memory");
    bf16x8 bV[2][2];
#pragma unroll
    for (int k = 0; k < 2; ++k)
#pragma unroll
      for (int nt = 0; nt < 2; ++nt) bV[k][nt] = *(const bf16x8*)(Vl + (nt * 16 + row) * 144 + k * 64 + quad * 16);
#pragma unroll
    for (int d = 0; d < 2; ++d)
#pragma unroll
      for (int nt = 0; nt < 2; ++nt) {
        Sacc[d][nt] *= f.egl;
#pragma unroll
        for (int k = 0; k < 2; ++k) Sacc[d][nt] = MFMA16(f.akd[d][k], bV[k][nt], Sacc[d][nt]);
        *(uint2*)(Sl + (nt * 16 + row) * 272 + (32 * wave + 16 * d + quad * 4) * 2) = make_uint2(pack2(Sacc[d][nt][0], Sacc[d][nt][1]), pack2(Sacc[d][nt][2], Sacc[d][nt][3]));
      }
    const int n = dir ? 127 - step : step;
#pragma unroll
    for (int nt = 0; nt < 2; ++nt) {
#pragma unroll
      for (int k = 0; k < 2; ++k) oacc[nt] = MFMA16(bV[k][nt], f.aa[k], oacc[nt]);
      const int c = 16 * wave + row;
      const int tok = dir ? 63 - c : c;
      *(uint2*)(ob + ((size_t)b * SEQ + n * 64 + tok) * 512 + hh * 128 + dv0 + nt * 16 + quad * 4) = make_uint2(pack2(oacc[nt][0], oacc[nt][1]), pack2(oacc[nt][2], oacc[nt][3]));
    }
    asm volatile("s_waitcnt lgkmcnt(0)\n\ts_barrier" ::: "memory");
  };
  ScanFrags f0, f1;
  gload(f0, 0);
  __syncthreads();
#pragma unroll 1
  for (int step = 0; step < 128; step += 2) {
    body(f0, f1, step);
    body(f1, f0, step + 1);
  }
  }
}

constexpr int PF_DEPTH = 10, PF_BATCH = 4;
__device__ void scan_helper(const Params& p, int hid) {
  const int tid = threadIdx.x;
  const int chain = (hid & 7) * 2 + (hid >> 3);
  const int b = chain >> 3, hh = (chain >> 1) & 3, dir = chain & 1;
  unsigned* prog = (unsigned*)(p.ws + OFF_PROG) + chain * 64;
  const unsigned char* pw = p.ws + OFF_PW;
  const unsigned char* pu = p.ws + OFF_PU;
  const unsigned char* pk = p.ws + OFF_PK;
  const unsigned char* pa = (const unsigned char*)p.out + DO_PA;
  const unsigned char* pe = (const unsigned char*)p.out + DO_PE;
  const unsigned char* qn = p.ws + OFF_QN;
  unsigned acc = 0u;
  int cur = 1;
#pragma unroll 1
  while (cur < 128) {
    const int done = (int)__hip_atomic_load(prog, __ATOMIC_RELAXED, __HIP_MEMORY_SCOPE_AGENT);
    if (done >= 127) break;
    if (cur < done + 1) cur = done + 1;
    const int lim = done + PF_DEPTH < 128 ? done + PF_DEPTH : 128;
    if (cur >= lim) { __builtin_amdgcn_s_sleep(4); continue; }
    unsigned v[PF_BATCH][3];
#pragma unroll
    for (int i = 0; i < PF_BATCH; ++i) {
      const int st = cur + i < lim ? cur + i : lim - 1;
      const int n = dir ? 127 - st : st;
      const size_t tile = ((size_t)(b * 4 + hh) * 128 + n) * 2 + dir;
      const unsigned char* a0 = (tid < 128) ? pw + tile * 16384 + tid * 128 : pu + tile * 16384 + (tid - 128) * 128;
      const unsigned char* a1 = (tid < 128) ? pk + tile * 16384 + tid * 128 : (tid < 192 ? pa + tile * 8192 + (tid - 128) * 128 : pe + tile * 256 + (tid & 1) * 128);
      const unsigned char* a2 = qn + ((size_t)b * SEQ + n * 64 + (tid >> 2)) * 1024 + hh * 256 + (tid & 1) * 128;
      v[i][0] = *(const unsigned*)a0; v[i][1] = *(const unsigned*)a1; v[i][2] = *(const unsigned*)a2;
    }
#pragma unroll
    for (int i = 0; i < PF_BATCH; ++i) acc ^= v[i][0] ^ v[i][1] ^ v[i][2];
    cur = cur + PF_BATCH < lim ? cur + PF_BATCH : lim;
  }
  if (acc == 0x9e3779b9u && p.ws == nullptr) *(unsigned*)p.out = acc;
}

__device__ void swa_mfma(const Params& p, int bid, int nb) {
  const int wave = threadIdx.x >> 6, lane = threadIdx.x & 63, col = lane & 15, quad = lane >> 4;
  const u16* kr = (const u16*)((const unsigned char*)p.out + DO_KR);
  const u16* vT = (const u16*)((const unsigned char*)p.out + DO_VT);
  const u16* qr = (const u16*)(p.ws + OFF_XN);
  const u16* projB = (const u16*)(p.ws + OFF_PROJB);
  u16* mix = (u16*)(p.ws + OFF_XN);
  const int upw = (2048 + nb - 1) / nb;
  for (int unit = bid * upw; unit < (bid + 1) * upw && unit < 2048; ++unit) {
    const int qblk = unit & 511, kvh = (unit >> 9) & 1, b = unit >> 10;
    const int t0 = qblk * 16, qh = kvh * 4 + wave;
    const size_t mq = (size_t)b * SEQ + t0 + col;
    bf16x8 bq[2];
#pragma unroll
    for (int ks = 0; ks < 2; ++ks) bq[ks] = *(const bf16x8*)(qr + mq * 1024 + qh * 64 + ks * 32 + quad * 8);
    f32x4 sc[18];
#pragma unroll
    for (int kt = 0; kt < 18; ++kt) {
      int key = t0 - 128 + 32 * (kt >> 1) + (col >> 2) * 8 + (kt & 1) * 4 + (col & 3);
      key = key < 0 ? 0 : (key > SEQ - 1 ? SEQ - 1 : key);
      const u16* kp = kr + ((size_t)b * SEQ + key) * 128 + kvh * 64 + quad * 8;
      bf16x8 a0 = *(const bf16x8*)kp, a1 = *(const bf16x8*)(kp + 32);
      f32x4 c = {0.f, 0.f, 0.f, 0.f};
      c = MFMA16(a0, bq[0], c);
      c = MFMA16(a1, bq[1], c);
      sc[kt] = c;
    }
    const float sink = p.sinks[qh];
    float mx = sink;
#pragma unroll
    for (int kt = 0; kt < 18; ++kt)
#pragma unroll
      for (int jj = 0; jj < 4; ++jj) {
        const int key = t0 - 128 + 32 * (kt >> 1) + quad * 8 + (kt & 1) * 4 + jj;
        const int rel = key - (t0 + col);
        const bool valid = (rel >= -128) && (rel <= 128) && (key >= 0) && (key < SEQ);
        float v = valid ? sc[kt][jj] : -1e30f;
        sc[kt][jj] = v;
        mx = fmaxf(mx, v);
      }
    mx = fmaxf(mx, __shfl_xor(mx, 16));
    mx = fmaxf(mx, __shfl_xor(mx, 32));
    float l = 0.f;
#pragma unroll
    for (int kt = 0; kt < 18; ++kt)
#pragma unroll
      for (int jj = 0; jj < 4; ++jj) { float e = __expf(sc[kt][jj] - mx); sc[kt][jj] = e; l += e; }
    l += __shfl_xor(l, 16);
    l += __shfl_xor(l, 32);
    l += __expf(sink - mx);
    f32x4 o[4];
#pragma unroll
    for (int dt = 0; dt < 4; ++dt) o[dt] = f32x4{0.f, 0.f, 0.f, 0.f};
    bf16x8 bp[9];
#pragma unroll
    for (int kg = 0; kg < 9; ++kg) {
      union { bf16x8 v; unsigned u[4]; } t;
      t.u[0] = pack2(sc[2 * kg][0], sc[2 * kg][1]); t.u[1] = pack2(sc[2 * kg][2], sc[2 * kg][3]);
      t.u[2] = pack2(sc[2 * kg + 1][0], sc[2 * kg + 1][1]); t.u[3] = pack2(sc[2 * kg + 1][2], sc[2 * kg + 1][3]);
      bp[kg] = t.v;
    }
    const u16* vbase = vT + ((size_t)((b * 2 + kvh) * 64 + col)) * VT_LD;
#pragma unroll
    for (int hb = 0; hb < 2; ++hb) {
      bf16x8 av[5][4];
#pragma unroll
      for (int i = 0; i < 5; ++i) {
        const int kg = hb * 5 + i;
        if (kg < 9) {
          int key0 = t0 - 128 + 32 * kg + quad * 8;
          key0 = key0 < 0 ? 0 : (key0 > SEQ - 8 ? SEQ - 8 : key0);
#pragma unroll
          for (int dt = 0; dt < 4; ++dt) av[i][dt] = *(const bf16x8*)(vbase + (size_t)dt * 16 * VT_LD + key0);
        }
      }
      __builtin_amdgcn_sched_barrier(0);
#pragma unroll
      for (int i = 0; i < 5; ++i) {
        const int kg = hb * 5 + i;
        if (kg < 9) {
#pragma unroll
          for (int dt = 0; dt < 4; ++dt) o[dt] = MFMA16(av[i][dt], bp[kg], o[dt]);
        }
      }
      __builtin_amdgcn_sched_barrier(0);
    }
    const float inv = __frcp_rn(l);
#pragma unroll
    for (int dt = 0; dt < 4; ++dt) {
      const int d0 = dt * 16 + quad * 4;
      uint2 z = *(const uint2*)(projB + mq * LDB + B_SWZ + qh * 64 + d0);
      float z0 = __uint_as_float(z.x << 16), z1 = __uint_as_float(z.x & 0xffff0000u), z2 = __uint_as_float(z.y << 16), z3 = __uint_as_float(z.y & 0xffff0000u);
      *(uint2*)(mix + mq * 1024 + 512 + qh * 64 + d0) = make_uint2(pack2(o[dt][0] * inv * silu(z0), o[dt][1] * inv * silu(z1)), pack2(o[dt][2] * inv * silu(z2), o[dt][3] * inv * silu(z3)));
    }
  }
}

__device__ void phaseF(const Params& p, int bid, int nb) {
  const int tid = threadIdx.x, wave = tid >> 6, lane = tid & 63;
  const u16* proj = (const u16*)(p.ws + OFF_PROJB);
  u16* mix = (u16*)(p.ws + OFF_XN);
  const u16* of = (const u16*)p.out;
  const u16* ob = (const u16*)((const unsigned char*)p.out + DO_OB);
  for (int item = bid * 4 + wave; item < M * 4; item += nb * 4) {
    const int m = item >> 2, hh = item & 3;
    const size_t o = (size_t)m * 512 + hh * 128 + 2 * lane;
    unsigned ua = *(const unsigned*)(of + o), ub = *(const unsigned*)(ob + o);
    float v0 = bf2f((u16)(ua & 0xffff)) + bf2f((u16)(ub & 0xffff)), v1 = bf2f((u16)(ua >> 16)) + bf2f((u16)(ub >> 16));
    float ss = wave_sum(v0 * v0 + v1 * v1);
    float rstd = rsqrtf(ss * (1.f / 128.f) + EPS);
    float2 w = *(const float2*)(p.out_norm_w + 2 * lane);
    unsigned uz = *(const unsigned*)(proj + (size_t)m * LDB + B_DNZ + hh * 128 + 2 * lane);
    float z0 = bf2f((u16)(uz & 0xffff)), z1 = bf2f((u16)(uz >> 16));
    *(unsigned*)(mix + (size_t)m * 1024 + hh * 128 + 2 * lane) = pack2(v0 * rstd * w.x * silu(z0), v1 * rstd * w.y * silu(z1));
  }
}

#if MEGA
__global__ void __launch_bounds__(256, 2) k_mega(Params p) {
  __shared__ __attribute__((aligned(16))) unsigned char smem[65536];
  cg::grid_group grid = cg::this_grid();
  const int bid = blockIdx.x, nb = gridDim.x;
  __shared__ uint4 xb_words;
  if (threadIdx.x == 0) xb_words = make_uint4(0u, 0u, 0u, 0u);
  __syncthreads();
  const XcdBarrier xbar = xcd_barrier_post((unsigned*)(p.ws + OFF_BAR), (volatile unsigned*)&xb_words);
  if (p.ws == nullptr) grid.sync();
#define GBAR() xcd_barrier(xbar)
#define REPL(n) _Pragma("unroll 1") for (int rep_ = 0; rep_ < (n); ++rep_)
  REPL(REP_A) phaseA(p, bid, nb, smem);
  GBAR();
  REPL(REP_B) phaseB(p, bid, nb, smem);
  GBAR();
  REPL(REP_C) phaseC(p, bid, nb);
  GBAR();
  REPL(REP_P) for (int t = bid; t < 2048; t += nb) prep_tile(p, t, smem);
  GBAR();
  if (bid < 64) scan_chunked(p, bid, smem);
  else if (bid < 80) scan_helper(p, bid - 64);
  else { REPL(REP_W) swa_mfma(p, bid - 80, nb - 80); }
  GBAR();
  REPL(REP_F) phaseF(p, bid, nb);
  GBAR();
  REPL(REP_G) phaseG(p, bid, nb, smem);
}
#else
template <int PH>
__global__ void __launch_bounds__(256, 2) k_phase(Params p) {
  __shared__ __attribute__((aligned(16))) unsigned char smem[65536];
  const int bid = blockIdx.x, nb = gridDim.x;
  if (PH == 0) phaseA(p, bid, nb, smem);
  if (PH == 1) phaseB(p, bid, nb, smem);
  if (PH == 2) phaseC(p, bid, nb);
  if (PH == 3) scan_chunked(p, bid, smem);
  if (PH == 6) swa_mfma(p, bid, nb);
  if (PH == 7) for (int t = bid; t < 2048; t += nb) prep_tile(p, t, smem);
  if (PH == 4) phaseF(p, bid, nb);
  if (PH == 5) phaseG(p, bid, nb, smem);
}
#endif

extern "C" void kernel_launch(void* const* d_in, const int* in_sizes, int n_in, void* d_out, int out_size, void* d_ws, size_t ws_size, hipStream_t stream) {
  Params p{};
  p.x = (const float*)d_in[0]; p.norm_w = (const float*)d_in[1]; p.w_in = (const float*)d_in[2]; p.conv_w = (const float*)d_in[3];
  p.a_log = (const float*)d_in[4]; p.dt_bias = (const float*)d_in[5]; p.out_norm_w = (const float*)d_in[6]; p.qnw = (const float*)d_in[7];
  p.knw = (const float*)d_in[8]; p.sinks = (const float*)d_in[9]; p.w_out = (const float*)d_in[10];
  p.out = (float*)d_out; p.ws = (unsigned char*)d_ws;
  if (ws_size < OFF_CTL_END) { fprintf(stderr, "workspace too small: %zu < %zu\n", ws_size, (size_t)OFF_END); return; }
#if MEGA
  static int grid_blocks = 0;
  if (!grid_blocks) {
    int dev = 0, cus = 0, per_cu = 0;
    hipGetDevice(&dev);
    hipDeviceGetAttribute(&cus, hipDeviceAttributeMultiprocessorCount, dev);
    hipOccupancyMaxActiveBlocksPerMultiprocessor(&per_cu, k_mega, 256, 0);
    if (per_cu > 2) per_cu = 2;
    grid_blocks = cus * per_cu;
  }
  void* args[] = {&p};
  (void)hipMemsetAsync((unsigned char*)d_ws + OFF_BAR, 0, OFF_CTL_END - OFF_BAR, stream);
  hipError_t e = hipLaunchCooperativeKernel((void*)k_mega, dim3(grid_blocks), dim3(256), args, 0, stream);
  if (e != hipSuccess) fprintf(stderr, "cooperative launch failed: %s (grid %d)\n", hipGetErrorString(e), grid_blocks);
#else
  k_phase<0><<<512, 256, 0, stream>>>(p);
  k_phase<1><<<512, 256, 0, stream>>>(p);
  k_phase<2><<<512, 256, 0, stream>>>(p);
  k_phase<7><<<512, 256, 0, stream>>>(p);
  k_phase<3><<<64, 256, 0, stream>>>(p);
  k_phase<6><<<512, 256, 0, stream>>>(p);
  k_phase<4><<<512, 256, 0, stream>>>(p);
  k_phase<5><<<512, 256, 0, stream>>>(p);
#endif
}
```

```cpp
#include <hip/hip_runtime.h>
#include <hip/hip_bf16.h>
#include <hip/hip_cooperative_groups.h>
#include <cstdio>
namespace cg = cooperative_groups;

#ifndef MEGA
#define MEGA 1
#endif
#define REP_A 1
#define REP_B 1
#define REP_C 1
#define REP_P 1
#define REP_S 1
#define REP_W 1
#define REP_F 1
#define REP_G 1

typedef unsigned short u16;
using bf16x8 = __attribute__((ext_vector_type(8))) short;
using f32x16 = __attribute__((ext_vector_type(16))) float;
using f32x4  = __attribute__((ext_vector_type(4))) float;
#define DI __device__ __forceinline__
#define MFMA16(a, b, c) __builtin_amdgcn_mfma_f32_16x16x32_bf16((a), (b), (c), 0, 0, 0)

constexpr int SEQ = 8192, M = 16384, D = 1024, NIN = 3344, N1 = 3328;
constexpr int C_DNQ = 0, C_DNK = 512, C_DNV = 1024, C_DNZ = 1536, C_SWQ = 2048, C_SWK = 2560, C_SWV = 2688, C_SWZ = 2816;
constexpr float EPS = 1e-6f;

constexpr int LDA = 1536, LDB = 1792;
constexpr int B_DNZ = 0, B_SWQ = 512, B_SWK = 1024, B_SWV = 1152, B_SWZ = 1280;
constexpr size_t OFF_XN   = 0;
constexpr size_t OFF_W1   = OFF_XN + (size_t)M * 1024 * 2;
constexpr size_t OFF_W2   = OFF_W1 + (size_t)N1 * 1024 * 2;
constexpr size_t OFF_BETA = OFF_W2 + (size_t)1024 * 1024 * 2;
constexpr size_t OFF_G    = OFF_BETA + (size_t)M * 8 * 4;
constexpr size_t OFF_ROPC = OFF_G + (size_t)M * 8 * 4;
constexpr size_t OFF_ROPS = OFF_ROPC + (size_t)SEQ * 32 * 4;
constexpr size_t OFF_PROJB= OFF_ROPS + (size_t)SEQ * 32 * 4;
constexpr size_t OFF_QN   = OFF_PROJB + (size_t)M * LDB * 2;
constexpr size_t OFF_KN   = OFF_QN + (size_t)M * 512 * 2;
constexpr size_t OFF_VV   = OFF_KN + (size_t)M * 512 * 2;
constexpr size_t OFF_PROJA= OFF_VV + (size_t)M * 512 * 2;
constexpr size_t OFF_PW   = OFF_PROJA;
constexpr size_t OFF_PU   = OFF_PW + (size_t)2048 * 8192 * 2;
constexpr size_t OFF_PK   = OFF_PU + (size_t)2048 * 8192 * 2;
constexpr size_t OFF_END  = OFF_PK + (size_t)2048 * 8192 * 2;
constexpr size_t DO_OB = (size_t)M * 512 * 2, DO_KR = (size_t)M * 512 * 4, DO_PA = DO_KR + (size_t)M * 128 * 4, DO_PE = DO_PA + (size_t)2048 * 4096 * 2, DO_PGL = DO_PE + (size_t)2048 * 64 * 4;
constexpr size_t DO_VT = DO_PGL + 8192;
constexpr int VT_LD = SEQ + 64;
static_assert(DO_VT + (size_t)256 * VT_LD * 2 <= (size_t)M * 1024 * 4, "d_out scratch overflow");
constexpr size_t OFF_BAR  = OFF_END;
constexpr size_t OFF_PROG = OFF_BAR + 16384;
constexpr size_t OFF_CTL_END = OFF_PROG + 16 * 256;
static_assert(OFF_CTL_END <= (size_t)256 * 1024 * 1024, "workspace overflow");

struct Params {
  const float *x, *norm_w, *w_in, *conv_w, *a_log, *dt_bias, *out_norm_w, *qnw, *knw, *sinks, *w_out;
  float* out;
  unsigned char* ws;
};

DI u16 f2bf(float x) { __bf16 r = (__bf16)x; return __builtin_bit_cast(u16, r); }
DI float bf2f(u16 v) { return __uint_as_float(((unsigned)v) << 16); }
typedef float f32x2_t __attribute__((ext_vector_type(2)));
typedef __bf16 bf16x2_t __attribute__((ext_vector_type(2)));
DI unsigned pack2(float a, float b) { f32x2_t v = {a, b}; bf16x2_t r = __builtin_convertvector(v, bf16x2_t); return __builtin_bit_cast(unsigned, r); }
DI float wave_sum(float v) {
#pragma unroll
  for (int o = 32; o >= 1; o >>= 1) v += __shfl_xor(v, o);
  return v;
}
DI float silu(float y) { return y / (1.f + __expf(-y)); }
#define XB_TMO      128
#define XB_XCNT(j)  (256  + 64 * (j))
#define XB_XSUB(j)  (1280 + 64 * (j))
#define XB_XGEN(j)  (2304 + 64 * (j))
#define XB_TOP      3328
#define XB_TOPGEN   3392
#define XCD_BAR_WORDS 3456
#define XB_SPIN_CAP (1u << 20)
DI unsigned xb_ld(unsigned* p) { return __hip_atomic_load(p, __ATOMIC_RELAXED, __HIP_MEMORY_SCOPE_AGENT); }
DI unsigned xb_add(unsigned* p, unsigned v) { return __hip_atomic_fetch_add(p, v, __ATOMIC_RELAXED, __HIP_MEMORY_SCOPE_AGENT); }
DI unsigned xb_xcc_id() { return (unsigned)__builtin_amdgcn_s_getreg((3 << 11) | 20) & 0xFu; }
#define XB_SPIN(cond, bar) do { unsigned _sp = 0; while (cond) { __builtin_amdgcn_s_sleep(1); \
    if ((++_sp & 255u) == 0u) { if (xb_ld(&(bar)[XB_TMO])) break; if (_sp > XB_SPIN_CAP) { atomicAdd(&(bar)[XB_TMO], 1u); break; } } } } while (0)
struct XcdBarrier { unsigned* bar; unsigned x; volatile unsigned* st; };
DI XcdBarrier xcd_barrier_post(unsigned* bar, volatile unsigned* st) {
  XcdBarrier b; b.bar = bar; b.x = xb_xcc_id(); b.st = st;
  if (threadIdx.x == 0) (void)xb_add(&bar[XB_XCNT(b.x)], 1u);
  return b;
}
DI void xcd_barrier_complete(unsigned* bar, unsigned x, unsigned& nloc, unsigned& nx) {
  const unsigned G = gridDim.x;
  unsigned sum, cnt, mine, sp = 0u;
  for (;;) {
    sum = 0u; cnt = 0u; mine = 0u;
#pragma unroll
    for (unsigned j = 0; j < 16; ++j) { const unsigned c = xb_ld(&bar[XB_XCNT(j)]); sum += c; cnt += (c > 0u) ? 1u : 0u; mine = (j == x) ? c : mine; }
    if (sum == G) break;
    __builtin_amdgcn_s_sleep(1);
    if ((++sp & 255u) == 0u) { if (xb_ld(&bar[XB_TMO])) break; if (sp > XB_SPIN_CAP) { atomicAdd(&bar[XB_TMO], 1u); break; } }
  }
  nloc = mine > 0u ? mine : 1u; nx = cnt > 0u ? cnt : 1u;
}
DI void xcd_barrier(const XcdBarrier& b) {
  asm volatile("s_waitcnt vmcnt(0)" ::: "memory");
  __syncthreads();
  if (threadIdx.x == 0) {
    unsigned* bar = b.bar;
    __builtin_amdgcn_s_waitcnt(0);
    unsigned nloc = b.st[0], nx = b.st[1];
    if (nloc == 0u) { xcd_barrier_complete(bar, b.x, nloc, nx); b.st[0] = nloc; b.st[1] = nx; }
    const unsigned old = xb_add(&bar[XB_XSUB(b.x)], 1u);
    const unsigned gen = old / nloc;
    if (old + 1u == (gen + 1u) * nloc) {
      __builtin_amdgcn_fence(__ATOMIC_RELEASE, "agent");
      asm volatile("s_waitcnt vmcnt(0)" ::: "memory");
      const unsigned og = xb_add(&bar[XB_TOP], 1u);
      const unsigned tg = og / nx;
      if (og + 1u == (tg + 1u) * nx) xb_add(&bar[XB_TOPGEN], 1u);
      else XB_SPIN(xb_ld(&bar[XB_TOPGEN]) == tg, bar);
      __builtin_amdgcn_fence(__ATOMIC_ACQUIRE, "agent");
      xb_add(&bar[XB_XGEN(b.x)], 1u);
      asm volatile("s_waitcnt vmcnt(0)" ::: "memory");
    } else {
      XB_SPIN(xb_ld(&bar[XB_XGEN(b.x)]) == gen, bar);
      __builtin_amdgcn_fence(__ATOMIC_ACQUIRE, "agent");
      asm volatile("s_waitcnt vmcnt(0)" ::: "memory");
    }
  }
  __syncthreads();
}
DI int crow(int i, int h) { return (i & 3) + 8 * (i >> 2) + 4 * h; }

__device__ void phaseA(const Params& p, int bid, int nb, unsigned char* smem_raw) {
  float* smem = (float*)smem_raw;
  const int tid = threadIdx.x, wave = tid >> 6, lane = tid & 63;
  for (int i = tid; i < 16 * 1024; i += 256) { int k = i >> 4, j = i & 15; smem[j * 1024 + k] = p.w_in[(size_t)k * NIN + 2048 + j]; }
  __syncthreads();
  u16* xn = (u16*)(p.ws + OFF_XN);
  float* betaA = (float*)(p.ws + OFF_BETA);
  float* gA = (float*)(p.ws + OFF_G);
  for (int row = bid * 4 + wave; row < M; row += nb * 4) {
    const float4* xr = (const float4*)(p.x + (size_t)row * D);
    float4 v[4]; float ss = 0.f;
#pragma unroll
    for (int i = 0; i < 4; ++i) { v[i] = xr[lane + 64 * i]; ss += v[i].x * v[i].x + v[i].y * v[i].y + v[i].z * v[i].z + v[i].w * v[i].w; }
    ss = wave_sum(ss);
    const float rstd = rsqrtf(ss * (1.f / 1024.f) + EPS);
#pragma unroll
    for (int i = 0; i < 4; ++i) {
      float4 nw = ((const float4*)p.norm_w)[lane + 64 * i];
      v[i].x *= rstd * nw.x; v[i].y *= rstd * nw.y; v[i].z *= rstd * nw.z; v[i].w *= rstd * nw.w;
      uint2 pk; pk.x = pack2(v[i].x, v[i].y); pk.y = pack2(v[i].z, v[i].w);
      *(uint2*)(xn + (size_t)row * 1024 + (lane + 64 * i) * 4) = pk;
    }
    float r = 0.f;
#pragma unroll 2
    for (int j = 0; j < 16; ++j) {
      float a = 0.f;
#pragma unroll
      for (int i = 0; i < 4; ++i) {
        float4 w = *(const float4*)&smem[j * 1024 + (lane + 64 * i) * 4];
        a += v[i].x * w.x + v[i].y * w.y + v[i].z * w.z + v[i].w * w.w;
      }
      a = wave_sum(a);
      r = (lane == j) ? a : r;
    }
    if (lane < 8) betaA[(size_t)row * 8 + lane] = 1.f / (1.f + __expf(-r));
    else if (lane < 16) {
      int idx = lane - 8;
      float xx = r + p.dt_bias[idx];
      float sp = fmaxf(xx, 0.f) + log1pf(__expf(-fabsf(xx)));
      gA[(size_t)row * 8 + idx] = -__expf(p.a_log[idx]) * sp;
    }
  }
  u16* w1 = (u16*)(p.ws + OFF_W1);
  u16* w2 = (u16*)(p.ws + OFF_W2);
  const int gt = bid * 256 + tid, gs = nb * 256;
  for (int idx = gt; idx < N1 * 128; idx += gs) {
    int n = idx % N1, kb = idx / N1;
    int col = n < 2048 ? n : n + 16;
    float f[8];
#pragma unroll
    for (int i = 0; i < 8; ++i) f[i] = p.w_in[(size_t)(kb * 8 + i) * NIN + col];
    uint4 pk; pk.x = pack2(f[0], f[1]); pk.y = pack2(f[2], f[3]); pk.z = pack2(f[4], f[5]); pk.w = pack2(f[6], f[7]);
    *(uint4*)(w1 + (size_t)n * 1024 + kb * 8) = pk;
  }
  for (int idx = gt; idx < 1024 * 128; idx += gs) {
    int n = idx & 1023, kb = idx >> 10;
    float f[8];
#pragma unroll
    for (int i = 0; i < 8; ++i) f[i] = p.w_out[(size_t)(kb * 8 + i) * 1024 + n];
    uint4 pk; pk.x = pack2(f[0], f[1]); pk.y = pack2(f[2], f[3]); pk.z = pack2(f[4], f[5]); pk.w = pack2(f[6], f[7]);
    *(uint4*)(w2 + (size_t)n * 1024 + kb * 8) = pk;
  }
  float* rc = (float*)(p.ws + OFF_ROPC);
  float* rs = (float*)(p.ws + OFF_ROPS);
  for (int idx = gt; idx < SEQ * 32; idx += gs) {
    int pos = idx >> 5, i = idx & 31;
    float inv = exp2f(-(float)i * (13.287712379549449f / 32.f));
    float ang = (float)pos * inv;
    double a = (double)ang * 0.15915494309189535;
    float fr = (float)(a - rint(a));
    rc[idx] = __builtin_amdgcn_cosf(fr); rs[idx] = __builtin_amdgcn_sinf(fr);
  }
}

template <int MODE>
__device__ void gemm_tile(const Params& p, const u16* __restrict__ A, const u16* __restrict__ Bt, int K, int m0, int n0, unsigned char* smem) {
  const int tid = threadIdx.x, wave = tid >> 6, lane = tid & 63;
  const int wm = wave >> 1, wn = wave & 1, r = lane & 31, h = lane >> 5;
  unsigned char* As = smem;
  unsigned char* Bs = smem + 32768;
  f32x16 acc[2][2];
#pragma unroll
  for (int a = 0; a < 2; ++a)
#pragma unroll
    for (int b = 0; b < 2; ++b)
#pragma unroll
      for (int i = 0; i < 16; ++i) acc[a][b][i] = 0.f;
  uint4 ra[4], rb[4];
  const int KT = K / 64;
  auto gload = [&](int kt) {
#pragma unroll
    for (int i = 0; i < 4; ++i) {
      int id = tid + 256 * i, row = id >> 3, c = id & 7;
      ra[i] = *(const uint4*)(A + (size_t)(m0 + row) * K + kt * 64 + c * 8);
      rb[i] = *(const uint4*)(Bt + (size_t)(n0 + row) * K + kt * 64 + c * 8);
    }
  };
  auto lstore = [&](int buf) {
#pragma unroll
    for (int i = 0; i < 4; ++i) {
      int id = tid + 256 * i, row = id >> 3, c = id & 7;
      int off = buf * 16384 + row * 128 + ((c ^ ((row >> 1) & 7)) << 4);
      *(uint4*)(As + off) = ra[i];
      *(uint4*)(Bs + off) = rb[i];
    }
  };
  __syncthreads();
  gload(0); lstore(0);
  __syncthreads();
  for (int kt = 0; kt < KT; ++kt) {
    if (kt + 1 < KT) gload(kt + 1);
    const int buf = kt & 1;
#pragma unroll
    for (int ks = 0; ks < 4; ++ks) {
      const int c = ks * 2 + h;
      bf16x8 af[2], bfr[2];
#pragma unroll
      for (int t = 0; t < 2; ++t) {
        int rowa = wm * 64 + t * 32 + r;
        af[t] = *(const bf16x8*)(As + buf * 16384 + rowa * 128 + ((c ^ ((rowa >> 1) & 7)) << 4));
        int rowb = wn * 64 + t * 32 + r;
        bfr[t] = *(const bf16x8*)(Bs + buf * 16384 + rowb * 128 + ((c ^ ((rowb >> 1) & 7)) << 4));
      }
#pragma unroll
      for (int a = 0; a < 2; ++a)
#pragma unroll
        for (int b = 0; b < 2; ++b) acc[a][b] = __builtin_amdgcn_mfma_f32_32x32x16_bf16(af[a], bfr[b], acc[a][b], 0, 0, 0);
    }
    if (kt + 1 < KT) lstore((kt + 1) & 1);
    __syncthreads();
  }
#pragma unroll
  for (int a = 0; a < 2; ++a)
#pragma unroll
    for (int b = 0; b < 2; ++b)
#pragma unroll
      for (int i = 0; i < 16; ++i) {
        int m = m0 + wm * 64 + a * 32 + crow(i, h);
        int n = n0 + wn * 64 + b * 32 + r;
        if (MODE == 0) {
          if (n0 < 1536) ((u16*)(p.ws + OFF_PROJA))[(size_t)m * LDA + n] = f2bf(acc[a][b][i]);
          else ((u16*)(p.ws + OFF_PROJB))[(size_t)m * LDB + (n - 1536)] = f2bf(acc[a][b][i]);
        }
        else p.out[(size_t)m * 1024 + n] = p.x[(size_t)m * 1024 + n] + acc[a][b][i];
      }
}

__device__ void phaseB(const Params& p, int bid, int nb, unsigned char* smem) {
  const u16* xn = (const u16*)(p.ws + OFF_XN);
  const u16* w1 = (const u16*)(p.ws + OFF_W1);
  for (int t = bid; t < 128 * 26; t += nb) {
    int tn = t % 26, tm = t / 26;
    gemm_tile<0>(p, xn, w1, 1024, tm * 128, tn * 128, smem);
  }
}
__device__ void phaseG(const Params& p, int bid, int nb, unsigned char* smem) {
  const u16* mix = (const u16*)(p.ws + OFF_XN);
  const u16* w2 = (const u16*)(p.ws + OFF_W2);
  for (int t = bid; t < 128 * 8; t += nb) {
    int tn = t & 7, tm = t >> 3;
    gemm_tile<1>(p, mix, w2, 1024, tm * 128, tn * 128, smem);
  }
}

DI void unpack8(const uint4 u, float* f) {
  f[0] = __uint_as_float(u.x << 16); f[1] = __uint_as_float(u.x & 0xffff0000u); f[2] = __uint_as_float(u.y << 16); f[3] = __uint_as_float(u.y & 0xffff0000u);
  f[4] = __uint_as_float(u.z << 16); f[5] = __uint_as_float(u.z & 0xffff0000u); f[6] = __uint_as_float(u.w << 16); f[7] = __uint_as_float(u.w & 0xffff0000u);
}
DI uint4 pack8(const float* f) { return make_uint4(pack2(f[0], f[1]), pack2(f[2], f[3]), pack2(f[4], f[5]), pack2(f[6], f[7])); }

__device__ void phaseC(const Params& p, int bid, int nb) {
  const int tid = threadIdx.x, wave = tid >> 6, lane = tid & 63;
  const u16* projA = (const u16*)(p.ws + OFF_PROJA);
  const u16* projB = (const u16*)(p.ws + OFF_PROJB);
  u16* kr = (u16*)((unsigned char*)p.out + DO_KR);
  u16* vT = (u16*)((unsigned char*)p.out + DO_VT);
  u16* qr = (u16*)(p.ws + OFF_XN);
  const float* rc = (const float*)(p.ws + OFF_ROPC);
  const float* rs = (const float*)(p.ws + OFF_ROPS);
  if (tid < 192) {
    const int sec = tid >> 6, ch0 = (tid & 63) * 8;
    u16* dst = (u16*)(p.ws + (sec == 0 ? OFF_QN : (sec == 1 ? OFF_KN : OFF_VV)));
    float w[5][8];
#pragma unroll
    for (int j = 0; j < 5; ++j) {
      const float4 w0 = *(const float4*)(p.conv_w + j * 1536 + sec * 512 + ch0), w1 = *(const float4*)(p.conv_w + j * 1536 + sec * 512 + ch0 + 4);
      w[j][0] = w0.x; w[j][1] = w0.y; w[j][2] = w0.z; w[j][3] = w0.w; w[j][4] = w1.x; w[j][5] = w1.y; w[j][6] = w1.z; w[j][7] = w1.w;
    }
    for (int run = bid; run < M / 32; run += nb) {
      const int m0 = run * 32, t0 = m0 & (SEQ - 1);
      auto ldrow = [&](int i, float* f) {
        const int t = t0 + i;
        uint4 u = make_uint4(0u, 0u, 0u, 0u);
        if (t >= 0 && t < SEQ) u = *(const uint4*)(projA + (size_t)(m0 + i) * LDA + sec * 512 + ch0);
        unpack8(u, f);
      };
      float r[5][8];
      ldrow(-2, r[0]); ldrow(-1, r[1]); ldrow(0, r[2]); ldrow(1, r[3]);
#pragma unroll 1
      for (int i = 0; i < 32; ++i) {
        ldrow(i + 2, r[4]);
        float y[8]; float ss = 0.f;
#pragma unroll
        for (int c = 0; c < 8; ++c) {
          float a = r[0][c] * w[0][c] + r[1][c] * w[1][c] + r[2][c] * w[2][c] + r[3][c] * w[3][c] + r[4][c] * w[4][c];
          a = silu(a); y[c] = a; ss += a * a;
        }
        if (sec < 2) {
          ss += __shfl_xor(ss, 1); ss += __shfl_xor(ss, 2); ss += __shfl_xor(ss, 4); ss += __shfl_xor(ss, 8);
          const float f = rsqrtf(ss + EPS) * (sec == 0 ? 0.08838834764831845f : 1.f);
#pragma unroll
          for (int c = 0; c < 8; ++c) y[c] *= f;
        }
        if (sec == 0) {
          const int mm = m0 + i, tq = mm & (SEQ - 1), cq = tq & 63, chq = (ch0 & 127) >> 3;
          const size_t tileq = (size_t)(((mm >> 13) * 4 + (ch0 >> 7)) * 128 + (tq >> 6));
          *(uint4*)(dst + tileq * 8192 + (((cq >> 4) * 4 + (chq >> 2)) * 64 + (chq & 3) * 16 + (cq & 15)) * 8) = pack8(y);
        } else *(uint4*)(dst + (size_t)(m0 + i) * 512 + ch0) = pack8(y);
#pragma unroll
        for (int j = 0; j < 4; ++j)
#pragma unroll
          for (int c = 0; c < 8; ++c) r[j][c] = r[j + 1][c];
      }
    }
  }
  for (int item = bid * 4 + wave; item < M / 2 + M / 8; item += nb * 4) {
    const bool isk = item >= M / 2;
    const int j = lane & 3;
    int m, head;
    if (!isk) { m = item * 2 + (lane >> 5); head = (lane >> 2) & 7; }
    else      { m = (item - M / 2) * 8 + (lane >> 3); head = (lane >> 2) & 1; }
    const int t = m & (SEQ - 1);
    const u16* src = projB + (size_t)m * LDB + (isk ? B_SWK : B_SWQ) + head * 64 + 8 * j;
    float lo[8], hi[8];
    unpack8(*(const uint4*)src, lo); unpack8(*(const uint4*)(src + 32), hi);
    float ss = 0.f;
#pragma unroll
    for (int c = 0; c < 8; ++c) ss += lo[c] * lo[c] + hi[c] * hi[c];
    ss += __shfl_xor(ss, 1); ss += __shfl_xor(ss, 2);
    const float rstd = rsqrtf(ss * (1.f / 64.f) + EPS) * (isk ? 1.f : 0.125f);
    const float* nw = isk ? p.knw : p.qnw;
    float olo[8], ohi[8];
#pragma unroll
    for (int c = 0; c < 8; ++c) {
      const float y0 = lo[c] * rstd * nw[8 * j + c], y1 = hi[c] * rstd * nw[32 + 8 * j + c];
      const float cs = rc[t * 32 + 8 * j + c], sn = rs[t * 32 + 8 * j + c];
      olo[c] = y0 * cs - y1 * sn; ohi[c] = y1 * cs + y0 * sn;
    }
    u16* dst = isk ? kr + (size_t)m * 128 + head * 64 + 8 * j : qr + (size_t)m * 1024 + head * 64 + 8 * j;
    *(uint4*)dst = pack8(olo); *(uint4*)(dst + 32) = pack8(ohi);
  }
  for (int it = bid * 256 + tid; it < 128 * (M / 8); it += nb * 256) {
    const int c = it & 127, m0 = (it >> 7) * 8;
    const int b = m0 >> 13, t0 = m0 & (SEQ - 1);
    const u16* src = projB + (size_t)m0 * LDB + B_SWV + c;
    unsigned pk[4];
#pragma unroll
    for (int i = 0; i < 4; ++i) pk[i] = (unsigned)src[(size_t)(2 * i) * LDB] | ((unsigned)src[(size_t)(2 * i + 1) * LDB] << 16);
    *(uint4*)(vT + ((size_t)((b * 2 + (c >> 6)) * 64 + (c & 63))) * VT_LD + t0) = make_uint4(pk[0], pk[1], pk[2], pk[3]);
  }
}

__device__ void prep_tile(const Params& p, int tile, unsigned char* smem) {
  int tid_ = threadIdx.x;
  asm volatile("" : "+v"(tid_));
  const int tid = tid_, wave = __builtin_amdgcn_readfirstlane(tid >> 6), lane = tid & 63;
  const int dir = tile & 1, n = (tile >> 1) & 127, bh = tile >> 8, b = bh >> 2, hh = bh & 3;
  unsigned char* ksb = smem;
  unsigned char* qsb = smem + 17408;
  float* Ms = (float*)(smem + 34816);
  float* gc = (float*)(smem + 51200);
  float* bt = gc + 64;
  const u16* qn = (const u16*)(p.ws + OFF_QN);
  const u16* kn = (const u16*)(p.ws + OFF_KN);
  const u16* vv = (const u16*)(p.ws + OFF_VV);
  const float* betaA = (const float*)(p.ws + OFF_BETA);
  const float* gA = (const float*)(p.ws + OFF_G);
  u16* pw = (u16*)(p.ws + OFF_PW) + (size_t)tile * 8192;
  u16* pu = (u16*)(p.ws + OFF_PU) + (size_t)tile * 8192;
  u16* pk = (u16*)(p.ws + OFF_PK) + (size_t)tile * 8192;
  u16* pa = (u16*)((unsigned char*)p.out + DO_PA) + (size_t)tile * 4096;
  float* pe = (float*)((unsigned char*)p.out + DO_PE) + (size_t)tile * 64;
  float* pgl = (float*)((unsigned char*)p.out + DO_PGL);
  const size_t row0 = (size_t)b * SEQ + n * 64;
  __syncthreads();
#pragma unroll
  for (int i = 0; i < 4; ++i) {
    int id = tid + 256 * i, c = id >> 4, ch = id & 15;
    int tok = dir ? 63 - c : c;
    *(uint4*)(ksb + c * 272 + ch * 16) = *(const uint4*)(kn + (row0 + tok) * 512 + hh * 128 + ch * 8);
    *(uint4*)(qsb + c * 272 + ch * 16) = *(const uint4*)(qn + (size_t)(bh * 128 + n) * 8192 + (((tok >> 4) * 4 + (ch >> 2)) * 64 + (ch & 3) * 16 + (tok & 15)) * 8);
  }
  if (wave == 0) {
    int tok = dir ? 63 - lane : lane;
    float g = gA[(row0 + tok) * 8 + dir * 4 + hh];
    float bb = betaA[(row0 + tok) * 8 + dir * 4 + hh];
#pragma unroll
    for (int o = 1; o < 64; o <<= 1) { float t = __shfl_up(g, o); if (lane >= o) g += t; }
    gc[lane] = g; bt[lane] = bb;
    pe[lane] = __expf(g);
    if (lane == 63) pgl[tile] = __expf(g);
  }
  __syncthreads();
  {
    const int row = lane & 15, quad = lane >> 4;
    bf16x8 ak[4], aq[4];
#pragma unroll
    for (int k = 0; k < 4; ++k) {
      ak[k] = *(const bf16x8*)(ksb + (16 * wave + row) * 272 + k * 64 + quad * 16);
      aq[k] = *(const bf16x8*)(qsb + (16 * wave + row) * 272 + k * 64 + quad * 16);
    }
#pragma unroll
    for (int tc = 0; tc < 4; ++tc) {
      f32x4 ckk = {0.f, 0.f, 0.f, 0.f}, cqk = {0.f, 0.f, 0.f, 0.f};
#pragma unroll
      for (int k = 0; k < 4; ++k) {
        bf16x8 bk = *(const bf16x8*)(ksb + (16 * tc + row) * 272 + k * 64 + quad * 16);
        ckk = MFMA16(ak[k], bk, ckk);
        cqk = MFMA16(aq[k], bk, cqk);
      }
      const int s = 16 * tc + row;
      const float gs = gc[s];
#pragma unroll
      for (int j = 0; j < 4; ++j) {
        const int c = 16 * wave + quad * 4 + j;
        float dec = __expf(fminf(gc[c] - gs, 0.f));
        float mval = (s < c) ? bt[c] * ckk[j] * dec : 0.f;
        float aval = (s <= c) ? cqk[j] * dec : 0.f;
        Ms[c * 64 + s] = mval;
        pa[(((c >> 4) * 2 + (s >> 5)) * 64 + ((s >> 3) & 3) * 16 + (c & 15)) * 8 + (s & 7)] = f2bf(aval);
      }
    }
  }
  {
    const int dk = tid & 127, half = tid >> 7;
    const float gl = gc[63];
    unsigned pkd[16];
#pragma unroll
    for (int i = 0; i < 16; ++i) {
      int c0 = half * 32 + 2 * i;
      float k0 = bf2f(*(const u16*)(ksb + c0 * 272 + dk * 2)) * __expf(gl - gc[c0]);
      float k1 = bf2f(*(const u16*)(ksb + (c0 + 1) * 272 + dk * 2)) * __expf(gl - gc[c0 + 1]);
      pkd[i] = pack2(k0, k1);
    }
#pragma unroll
    for (int i = 0; i < 4; ++i) {
      const int cc = half * 4 + i;
      *(uint4*)(pk + ((((dk >> 5) * 2 + ((dk >> 4) & 1)) * 2 + (cc >> 2)) * 64 + (cc & 3) * 16 + (dk & 15)) * 8) = make_uint4(pkd[4 * i], pkd[4 * i + 1], pkd[4 * i + 2], pkd[4 * i + 3]);
    }
  }
  __syncthreads();
  float x[64];
  if (tid < 128) {
#pragma unroll
    for (int c = 0; c < 64; ++c) { int tok = dir ? 63 - c : c; x[c] = bt[c] * bf2f(vv[(row0 + tok) * 512 + hh * 128 + tid]); }
  } else {
#pragma unroll
    for (int c = 0; c < 64; ++c) x[c] = bt[c] * __expf(gc[c]) * bf2f(*(const u16*)(ksb + c * 272 + (tid - 128) * 2));
  }
  __syncthreads();
  unsigned char* xs = smem;
  unsigned char* ys = smem + 51712;
  {
    const int row = lane & 15, quad = lane >> 4;
#pragma unroll
    for (int I = 0; I < 4; ++I) {
      asm volatile("" ::: "memory");
      if (I > 0) {
        f32x4 yacc[4];
#pragma unroll
        for (int nt = 0; nt < 4; ++nt) yacc[nt] = f32x4{0.f, 0.f, 0.f, 0.f};
#pragma unroll
        for (int ks = 0; ks < (16 * I + 31) / 32; ++ks) {
          const bool live = (ks * 32 + quad * 8) < 16 * I;
          const float4 m0 = *(const float4*)(Ms + (16 * I + row) * 64 + ks * 32 + quad * 8);
          const float4 m1 = *(const float4*)(Ms + (16 * I + row) * 64 + ks * 32 + quad * 8 + 4);
          union { bf16x8 v; unsigned u[4]; } af;
          af.u[0] = live ? pack2(m0.x, m0.y) : 0u; af.u[1] = live ? pack2(m0.z, m0.w) : 0u;
          af.u[2] = live ? pack2(m1.x, m1.y) : 0u; af.u[3] = live ? pack2(m1.z, m1.w) : 0u;
          const int qe = live ? quad : (quad & 1);
#pragma unroll
          for (int nt = 0; nt < 4; ++nt) {
            const bf16x8 bx = *(const bf16x8*)(xs + (64 * wave + 16 * nt + row) * 112 + (ks * 32 + qe * 8) * 2);
            yacc[nt] = MFMA16(af.v, bx, yacc[nt]);
          }
        }
#pragma unroll
        for (int nt = 0; nt < 4; ++nt)
          *(uint2*)(ys + (64 * wave + 16 * nt + row) * 48 + quad * 8) = make_uint2(pack2(yacc[nt][0], yacc[nt][1]), pack2(yacc[nt][2], yacc[nt][3]));
        const uint4 y0 = *(const uint4*)(ys + tid * 48), y1 = *(const uint4*)(ys + tid * 48 + 16);
        const unsigned yy[8] = {y0.x, y0.y, y0.z, y0.w, y1.x, y1.y, y1.z, y1.w};
#pragma unroll
        for (int r = 0; r < 16; ++r) x[16 * I + r] -= (r & 1) ? __uint_as_float(yy[r >> 1] & 0xffff0000u) : __uint_as_float(yy[r >> 1] << 16);
      }
      int mrow[16];
#pragma unroll
      for (int r = 1; r < 16; ++r) mrow[r] = __float_as_int(Ms[(16 * I + r) * 64 + lane]);
#pragma unroll
      for (int r = 1; r < 16; ++r) {
        float a0 = 0.f, a1 = 0.f;
#pragma unroll
        for (int sidx = 0; sidx < r; ++sidx) {
          const float m = __int_as_float(__builtin_amdgcn_readlane(mrow[r], 16 * I + sidx));
          if (sidx & 1) a1 = fmaf(m, x[16 * I + sidx], a1); else a0 = fmaf(m, x[16 * I + sidx], a0);
        }
        x[16 * I + r] -= a0 + a1;
      }
      if (I < 3) {
#pragma unroll
        for (int i = 0; i < 2; ++i)
          *(uint4*)(xs + tid * 112 + I * 32 + i * 16) = make_uint4(pack2(x[16 * I + 8 * i], x[16 * I + 8 * i + 1]), pack2(x[16 * I + 8 * i + 2], x[16 * I + 8 * i + 3]),
                                                                 pack2(x[16 * I + 8 * i + 4], x[16 * I + 8 * i + 5]), pack2(x[16 * I + 8 * i + 6], x[16 * I + 8 * i + 7]));
      }
    }
  }
  __syncthreads();
  if (tid < 128) {
#pragma unroll
    for (int g = 0; g < 16; ++g)
      *(uint2*)(pu + (((((tid >> 5) * 2 + ((tid >> 4) & 1)) * 4 + (g >> 2)) * 64 + (g & 3) * 16 + (tid & 15)) * 4)) = make_uint2(pack2(x[4 * g], x[4 * g + 1]), pack2(x[4 * g + 2], x[4 * g + 3]));
  } else {
#pragma unroll
    for (int c = 0; c < 64; ++c) *(u16*)(qsb + c * 272 + (tid - 128) * 2) = f2bf(-x[c]);
  }
  __syncthreads();
#pragma unroll
  for (int i = 0; i < 4; ++i) {
    int id = tid + 256 * i, c = id >> 4, ch = id & 15;
    *(uint4*)(pw + (((c >> 4) * 4 + (ch >> 2)) * 64 + (ch & 3) * 16 + (c & 15)) * 8) = *(const uint4*)(qsb + c * 272 + ch * 16);
  }
}

struct ScanFrags { bf16x8 aw[4], aq[4], aa[2], akd[2][2]; uint2 u[2]; float eg; float egl; };
__device__ void scan_chunked(const Params& p, int sid, unsigned char* smem) {
  const int tid = threadIdx.x, wave = tid >> 6, lane = tid & 63, row = lane & 15, quad = lane >> 4;
  const int chain = (sid & 7) * 2 + (sid >> 5), dv0 = ((sid >> 3) & 3) * 32;
  const int b = chain >> 3, hh = (chain >> 1) & 3, dir = chain & 1;
  unsigned* prog = (unsigned*)(p.ws + OFF_PROG) + chain * 64;
  const bool publisher = (dv0 == 0) && (tid == 0);
  unsigned char* Sl = smem;
  unsigned char* Vl = smem + 8704;
  const u16* qn = (const u16*)(p.ws + OFF_QN);
  const u16* pwA = (const u16*)(p.ws + OFF_PW);
  const u16* puA = (const u16*)(p.ws + OFF_PU);
  const u16* pkA = (const u16*)(p.ws + OFF_PK);
  const u16* paA = (const u16*)((unsigned char*)p.out + DO_PA);
  const float* peA = (const float*)((unsigned char*)p.out + DO_PE);
  const float* pglA = (const float*)((unsigned char*)p.out + DO_PGL);
  u16* ob = (u16*)((unsigned char*)p.out + (dir ? DO_OB : 0));
#pragma unroll 1
  for (int rep = 0; rep < REP_S; ++rep) {
  __syncthreads();
  for (int i = tid; i < 8704 / 4; i += 256) ((unsigned*)Sl)[i] = 0u;
  f32x4 Sacc[2][2];
#pragma unroll
  for (int a = 0; a < 2; ++a)
#pragma unroll
    for (int c = 0; c < 2; ++c) Sacc[a][c] = f32x4{0.f, 0.f, 0.f, 0.f};
  auto gload = [&](ScanFrags& f, int step) {
    const int n = dir ? 127 - step : step;
    const size_t tile = ((size_t)(b * 4 + hh) * 128 + n) * 2 + dir;
    const int c = 16 * wave + row;
    const int tok = dir ? 63 - c : c;
    const size_t qtile = (size_t)((b * 4 + hh) * 128 + n) * 8192;
    const int qlane = dir ? quad * 16 + (15 - row) : lane, qw = dir ? 3 - wave : wave;
#pragma unroll
    for (int k = 0; k < 4; ++k) {
      f.aw[k] = *(const bf16x8*)(pwA + tile * 8192 + ((wave * 4 + k) * 64 + lane) * 8);
      f.aq[k] = *(const bf16x8*)(qn + qtile + ((qw * 4 + k) * 64 + qlane) * 8);
    }
#pragma unroll
    for (int k = 0; k < 2; ++k) {
      f.aa[k] = *(const bf16x8*)(paA + tile * 4096 + ((wave * 2 + k) * 64 + lane) * 8);
#pragma unroll
      for (int d = 0; d < 2; ++d) f.akd[d][k] = *(const bf16x8*)(pkA + tile * 8192 + (((wave * 2 + d) * 2 + k) * 64 + lane) * 8);
    }
#pragma unroll
    for (int nt = 0; nt < 2; ++nt) f.u[nt] = *(const uint2*)(puA + tile * 8192 + ((((dv0 >> 5) * 2 + nt) * 4 + wave) * 64 + lane) * 4);
    f.eg = peA[tile * 64 + c];
    f.egl = pglA[tile];
  };
  auto body = [&](ScanFrags& f, ScanFrags& fn, int step) {
    if (publisher) __hip_atomic_store(prog, (unsigned)(step + 1), __ATOMIC_RELAXED, __HIP_MEMORY_SCOPE_AGENT);
    if (step + 1 < 128) gload(fn, step + 1);
    bf16x8 bS[4][2];
#pragma unroll
    for (int k = 0; k < 4; ++k)
#pragma unroll
      for (int nt = 0; nt < 2; ++nt) bS[k][nt] = *(const bf16x8*)(Sl + (nt * 16 + row) * 272 + k * 64 + quad * 16);
    f32x4 vacc[2], oacc[2];
#pragma unroll
    for (int nt = 0; nt < 2; ++nt) {
      vacc[nt] = f32x4{__uint_as_float(f.u[nt].x << 16), __uint_as_float(f.u[nt].x & 0xffff0000u), __uint_as_float(f.u[nt].y << 16), __uint_as_float(f.u[nt].y & 0xffff0000u)};
      oacc[nt] = f32x4{0.f, 0.f, 0.f, 0.f};
#pragma unroll
      for (int k = 0; k < 4; ++k) vacc[nt] = MFMA16(f.aw[k], bS[k][nt], vacc[nt]);
      *(uint2*)(Vl + (nt * 16 + row) * 144 + (16 * wave + quad * 4) * 2) = make_uint2(pack2(vacc[nt][0], vacc[nt][1]), pack2(vacc[nt][2], vacc[nt][3]));
    }
#pragma unroll
    for (int nt = 0; nt < 2; ++nt) {
#pragma unroll
      for (int k = 0; k < 4; ++k) oacc[nt] = MFMA16(bS[k][nt], f.aq[k], oacc[nt]);
      oacc[nt] *= f.eg;
    }
    asm volatile("s_waitcnt lgkmcnt(0)\n\ts_barrier" ::: "memory");
    bf16x8 bV[2][2];
#pragma unroll
    for (int k = 0; k < 2; ++k)
#pragma unroll
      for (int nt = 0; nt < 2; ++nt) bV[k][nt] = *(const bf16x8*)(Vl + (nt * 16 + row) * 144 + k * 64 + quad * 16);
#pragma unroll
    for (int d = 0; d < 2; ++d)
#pragma unroll
      for (int nt = 0; nt < 2; ++nt) {
        Sacc[d][nt] *= f.egl;
#pragma unroll
        for (int k = 0; k < 2; ++k) Sacc[d][nt] = MFMA16(f.akd[d][k], bV[k][nt], Sacc[d][nt]);
        *(uint2*)(Sl + (nt * 16 + row) * 272 + (32 * wave + 16 * d + quad * 4) * 2) = make_uint2(pack2(Sacc[d][nt][0], Sacc[d][nt][1]), pack2(Sacc[d][nt][2], Sacc[d][nt][3]));
      }
    const int n = dir ? 127 - step : step;
#pragma unroll
    for (int nt = 0; nt < 2; ++nt) {
#pragma unroll
      for (int k = 0; k < 2; ++k) oacc[nt] = MFMA16(bV[k][nt], f.aa[k], oacc[nt]);
      const int c = 16 * wave + row;
      const int tok = dir ? 63 - c : c;
      *(uint2*)(ob + ((size_t)b * SEQ + n * 64 + tok) * 512 + hh * 128 + dv0 + nt * 16 + quad * 4) = make_uint2(pack2(oacc[nt][0], oacc[nt][1]), pack2(oacc[nt][2], oacc[nt][3]));
    }
    asm volatile("s_waitcnt lgkmcnt(0)\n\ts_barrier" ::: "memory");
  };
  ScanFrags f0, f1;
  gload(f0, 0);
  __syncthreads();
#pragma unroll 1
  for (int step = 0; step < 128; step += 2) {
    body(f0, f1, step);
    body(f1, f0, step + 1);
  }
  }
}

constexpr int PF_DEPTH = 10, PF_BATCH = 4;
__device__ void scan_helper(const Params& p, int hid) {
  const int tid = threadIdx.x;
  const int chain = (hid & 7) * 2 + (hid >> 3);
  const int b = chain >> 3, hh = (chain >> 1) & 3, dir = chain & 1;
  unsigned* prog = (unsigned*)(p.ws + OFF_PROG) + chain * 64;
  const unsigned char* pw = p.ws + OFF_PW;
  const unsigned char* pu = p.ws + OFF_PU;
  const unsigned char* pk = p.ws + OFF_PK;
  const unsigned char* pa = (const unsigned char*)p.out + DO_PA;
  const unsigned char* pe = (const unsigned char*)p.out + DO_PE;
  const unsigned char* qn = p.ws + OFF_QN;
  unsigned acc = 0u;
  int cur = 1;
#pragma unroll 1
  while (cur < 128) {
    const int done = (int)__hip_atomic_load(prog, __ATOMIC_RELAXED, __HIP_MEMORY_SCOPE_AGENT);
    if (done >= 127) break;
    if (cur < done + 1) cur = done + 1;
    const int lim = done + PF_DEPTH < 128 ? done + PF_DEPTH : 128;
    if (cur >= lim) { __builtin_amdgcn_s_sleep(4); continue; }
    unsigned v[PF_BATCH][3];
#pragma unroll
    for (int i = 0; i < PF_BATCH; ++i) {
      const int st = cur + i < lim ? cur + i : lim - 1;
      const int n = dir ? 127 - st : st;
      const size_t tile = ((size_t)(b * 4 + hh) * 128 + n) * 2 + dir;
      const unsigned char* a0 = (tid < 128) ? pw + tile * 16384 + tid * 128 : pu + tile * 16384 + (tid - 128) * 128;
      const unsigned char* a1 = (tid < 128) ? pk + tile * 16384 + tid * 128 : (tid < 192 ? pa + tile * 8192 + (tid - 128) * 128 : pe + tile * 256 + (tid & 1) * 128);
      const unsigned char* a2 = qn + (size_t)((b * 4 + hh) * 128 + n) * 16384 + (tid & 127) * 128;
      v[i][0] = *(const unsigned*)a0; v[i][1] = *(const unsigned*)a1; v[i][2] = *(const unsigned*)a2;
    }
#pragma unroll
    for (int i = 0; i < PF_BATCH; ++i) acc ^= v[i][0] ^ v[i][1] ^ v[i][2];
    cur = cur + PF_BATCH < lim ? cur + PF_BATCH : lim;
  }
  if (acc == 0x9e3779b9u && p.ws == nullptr) *(unsigned*)p.out = acc;
}

__device__ void swa_mfma(const Params& p, int bid, int nb) {
  const int wave = threadIdx.x >> 6, lane = threadIdx.x & 63, col = lane & 15, quad = lane >> 4;
  const u16* kr = (const u16*)((const unsigned char*)p.out + DO_KR);
  const u16* vT = (const u16*)((const unsigned char*)p.out + DO_VT);
  const u16* qr = (const u16*)(p.ws + OFF_XN);
  const u16* projB = (const u16*)(p.ws + OFF_PROJB);
  u16* mix = (u16*)(p.ws + OFF_XN);
  const int upw = (2048 + nb - 1) / nb;
  for (int unit = bid * upw; unit < (bid + 1) * upw && unit < 2048; ++unit) {
    const int qblk = unit & 511, kvh = (unit >> 9) & 1, b = unit >> 10;
    const int t0 = qblk * 16, qh = kvh * 4 + wave;
    const size_t mq = (size_t)b * SEQ + t0 + col;
    bf16x8 bq[2];
#pragma unroll
    for (int ks = 0; ks < 2; ++ks) bq[ks] = *(const bf16x8*)(qr + mq * 1024 + qh * 64 + ks * 32 + quad * 8);
    f32x4 sc[18];
#pragma unroll
    for (int kt = 0; kt < 18; ++kt) {
      int key = t0 - 128 + 32 * (kt >> 1) + (col >> 2) * 8 + (kt & 1) * 4 + (col & 3);
      key = key < 0 ? 0 : (key > SEQ - 1 ? SEQ - 1 : key);
      const u16* kp = kr + ((size_t)b * SEQ + key) * 128 + kvh * 64 + quad * 8;
      bf16x8 a0 = *(const bf16x8*)kp, a1 = *(const bf16x8*)(kp + 32);
      f32x4 c = {0.f, 0.f, 0.f, 0.f};
      c = MFMA16(a0, bq[0], c);
      c = MFMA16(a1, bq[1], c);
      sc[kt] = c;
    }
    const float sink = p.sinks[qh];
    float mx = sink;
#pragma unroll
    for (int kt = 0; kt < 18; ++kt)
#pragma unroll
      for (int jj = 0; jj < 4; ++jj) {
        const int key = t0 - 128 + 32 * (kt >> 1) + quad * 8 + (kt & 1) * 4 + jj;
        const int rel = key - (t0 + col);
        const bool valid = (rel >= -128) && (rel <= 128) && (key >= 0) && (key < SEQ);
        float v = valid ? sc[kt][jj] : -1e30f;
        sc[kt][jj] = v;
        mx = fmaxf(mx, v);
      }
    mx = fmaxf(mx, __shfl_xor(mx, 16));
    mx = fmaxf(mx, __shfl_xor(mx, 32));
    float l = 0.f;
#pragma unroll
    for (int kt = 0; kt < 18; ++kt)
#pragma unroll
      for (int jj = 0; jj < 4; ++jj) { float e = __expf(sc[kt][jj] - mx); sc[kt][jj] = e; l += e; }
    l += __shfl_xor(l, 16);
    l += __shfl_xor(l, 32);
    l += __expf(sink - mx);
    f32x4 o[4];
#pragma unroll
    for (int dt = 0; dt < 4; ++dt) o[dt] = f32x4{0.f, 0.f, 0.f, 0.f};
    bf16x8 bp[9];
#pragma unroll
    for (int kg = 0; kg < 9; ++kg) {
      union { bf16x8 v; unsigned u[4]; } t;
      t.u[0] = pack2(sc[2 * kg][0], sc[2 * kg][1]); t.u[1] = pack2(sc[2 * kg][2], sc[2 * kg][3]);
      t.u[2] = pack2(sc[2 * kg + 1][0], sc[2 * kg + 1][1]); t.u[3] = pack2(sc[2 * kg + 1][2], sc[2 * kg + 1][3]);
      bp[kg] = t.v;
    }
    const u16* vbase = vT + ((size_t)((b * 2 + kvh) * 64 + col)) * VT_LD;
#pragma unroll
    for (int hb = 0; hb < 2; ++hb) {
      bf16x8 av[5][4];
#pragma unroll
      for (int i = 0; i < 5; ++i) {
        const int kg = hb * 5 + i;
        if (kg < 9) {
          int key0 = t0 - 128 + 32 * kg + quad * 8;
          key0 = key0 < 0 ? 0 : (key0 > SEQ - 8 ? SEQ - 8 : key0);
#pragma unroll
          for (int dt = 0; dt < 4; ++dt) av[i][dt] = *(const bf16x8*)(vbase + (size_t)dt * 16 * VT_LD + key0);
        }
      }
      __builtin_amdgcn_sched_barrier(0);
#pragma unroll
      for (int i = 0; i < 5; ++i) {
        const int kg = hb * 5 + i;
        if (kg < 9) {
#pragma unroll
          for (int dt = 0; dt < 4; ++dt) o[dt] = MFMA16(av[i][dt], bp[kg], o[dt]);
        }
      }
      __builtin_amdgcn_sched_barrier(0);
    }
    const float inv = __frcp_rn(l);
#pragma unroll
    for (int dt = 0; dt < 4; ++dt) {
      const int d0 = dt * 16 + quad * 4;
      uint2 z = *(const uint2*)(projB + mq * LDB + B_SWZ + qh * 64 + d0);
      float z0 = __uint_as_float(z.x << 16), z1 = __uint_as_float(z.x & 0xffff0000u), z2 = __uint_as_float(z.y << 16), z3 = __uint_as_float(z.y & 0xffff0000u);
      *(uint2*)(mix + mq * 1024 + 512 + qh * 64 + d0) = make_uint2(pack2(o[dt][0] * inv * silu(z0), o[dt][1] * inv * silu(z1)), pack2(o[dt][2] * inv * silu(z2), o[dt][3] * inv * silu(z3)));
    }
  }
}

__device__ void phaseF(const Params& p, int bid, int nb) {
  const int tid = threadIdx.x, wave = tid >> 6, lane = tid & 63;
  const u16* proj = (const u16*)(p.ws + OFF_PROJB);
  u16* mix = (u16*)(p.ws + OFF_XN);
  const u16* of = (const u16*)p.out;
  const u16* ob = (const u16*)((const unsigned char*)p.out + DO_OB);
  float w[8];
#pragma unroll
  for (int c = 0; c < 8; ++c) w[c] = p.out_norm_w[(lane & 15) * 8 + c];
  for (int m = bid * 4 + wave; m < M; m += nb * 4) {
    const size_t o = (size_t)m * 512 + lane * 8;
    float a[8], b[8], z[8], y[8];
    unpack8(*(const uint4*)(of + o), a); unpack8(*(const uint4*)(ob + o), b);
    unpack8(*(const uint4*)(proj + (size_t)m * LDB + B_DNZ + lane * 8), z);
    float ss = 0.f;
#pragma unroll
    for (int c = 0; c < 8; ++c) { a[c] += b[c]; ss += a[c] * a[c]; }
    ss += __shfl_xor(ss, 1); ss += __shfl_xor(ss, 2); ss += __shfl_xor(ss, 4); ss += __shfl_xor(ss, 8);
    const float rstd = rsqrtf(ss * (1.f / 128.f) + EPS);
#pragma unroll
    for (int c = 0; c < 8; ++c) y[c] = a[c] * rstd * w[c] * silu(z[c]);
    *(uint4*)(mix + (size_t)m * 1024 + lane * 8) = pack8(y);
  }
}

#if MEGA
__global__ void __launch_bounds__(256, 2) k_mega(Params p) {
  __shared__ __attribute__((aligned(16))) unsigned char smem[65536];
  cg::grid_group grid = cg::this_grid();
  const int bid = blockIdx.x, nb = gridDim.x;
  __shared__ uint4 xb_words;
  if (threadIdx.x == 0) xb_words = make_uint4(0u, 0u, 0u, 0u);
  __syncthreads();
  const XcdBarrier xbar = xcd_barrier_post((unsigned*)(p.ws + OFF_BAR), (volatile unsigned*)&xb_words);
  if (p.ws == nullptr) grid.sync();
#define GBAR() xcd_barrier(xbar)
#define REPL(n) _Pragma("unroll 1") for (int rep_ = 0; rep_ < (n); ++rep_)
  REPL(REP_A) phaseA(p, bid, nb, smem);
  GBAR();
  REPL(REP_B) phaseB(p, bid, nb, smem);
  GBAR();
  REPL(REP_C) phaseC(p, bid, nb);
  GBAR();
  REPL(REP_P) for (int t = bid; t < 2048; t += nb) prep_tile(p, t, smem);
  GBAR();
  if (bid < 64) { __builtin_amdgcn_s_setprio(3); scan_chunked(p, bid, smem); __builtin_amdgcn_s_setprio(0); }
  else if (bid < 80) scan_helper(p, bid - 64);
  else if (bid < 256) swa_mfma(p, bid - 80, nb - 160);
  else if (bid >= 336) swa_mfma(p, bid - 160, nb - 160);
  GBAR();
  REPL(REP_F) phaseF(p, bid, nb);
  GBAR();
  REPL(REP_G) phaseG(p, bid, nb, smem);
}
#else
template <int PH>
__global__ void __launch_bounds__(256, 2) k_phase(Params p) {
  __shared__ __attribute__((aligned(16))) unsigned char smem[65536];
  const int bid = blockIdx.x, nb = gridDim.x;
  if (PH == 0) phaseA(p, bid, nb, smem);
  if (PH == 1) phaseB(p, bid, nb, smem);
  if (PH == 2) phaseC(p, bid, nb);
  if (PH == 3) scan_chunked(p, bid, smem);
  if (PH == 6) swa_mfma(p, bid, nb);
  if (PH == 7) for (int t = bid; t < 2048; t += nb) prep_tile(p, t, smem);
  if (PH == 4) phaseF(p, bid, nb);
  if (PH == 5) phaseG(p, bid, nb, smem);
}
#endif

extern "C" void kernel_launch(void* const* d_in, const int* in_sizes, int n_in, void* d_out, int out_size, void* d_ws, size_t ws_size, hipStream_t stream) {
  Params p{};
  p.x = (const float*)d_in[0]; p.norm_w = (const float*)d_in[1]; p.w_in = (const float*)d_in[2]; p.conv_w = (const float*)d_in[3];
  p.a_log = (const float*)d_in[4]; p.dt_bias = (const float*)d_in[5]; p.out_norm_w = (const float*)d_in[6]; p.qnw = (const float*)d_in[7];
  p.knw = (const float*)d_in[8]; p.sinks = (const float*)d_in[9]; p.w_out = (const float*)d_in[10];
  p.out = (float*)d_out; p.ws = (unsigned char*)d_ws;
  if (ws_size < OFF_CTL_END) { fprintf(stderr, "workspace too small: %zu < %zu\n", ws_size, (size_t)OFF_END); return; }
#if MEGA
  static int grid_blocks = 0;
  if (!grid_blocks) {
    int dev = 0, cus = 0, per_cu = 0;
    hipGetDevice(&dev);
    hipDeviceGetAttribute(&cus, hipDeviceAttributeMultiprocessorCount, dev);
    hipOccupancyMaxActiveBlocksPerMultiprocessor(&per_cu, k_mega, 256, 0);
    if (per_cu > 2) per_cu = 2;
    grid_blocks = cus * per_cu;
  }
  void* args[] = {&p};
  (void)hipMemsetAsync((unsigned char*)d_ws + OFF_BAR, 0, OFF_CTL_END - OFF_BAR, stream);
  hipError_t e = hipLaunchCooperativeKernel((void*)k_mega, dim3(grid_blocks), dim3(256), args, 0, stream);
  if (e != hipSuccess) fprintf(stderr, "cooperative launch failed: %s (grid %d)\n", hipGetErrorString(e), grid_blocks);
#else
  k_phase<0><<<512, 256, 0, stream>>>(p);
  k_phase<1><<<512, 256, 0, stream>>>(p);
  k_phase<2><<<512, 256, 0, stream>>>(p);
  k_phase<7><<<512, 256, 0, stream>>>(p);
  k_phase<3><<<64, 256, 0, stream>>>(p);
  k_phase<6><<<512, 256, 0, stream>>>(p);
  k_phase<4><<<512, 256, 0, stream>>>(p);
  k_phase<5><<<512, 256, 0, stream>>>(p);
#endif
}
```

```cpp
#include <hip/hip_runtime.h>
#include <hip/hip_bf16.h>
#include <hip/hip_cooperative_groups.h>
#include <cstdio>
namespace cg = cooperative_groups;

#ifndef MEGA
#define MEGA 1
#endif
#define AMP_SEL (-1)
#define REP_A 1
#define REP_B 1
#define REP_C 1
#define REP_P 1
#define REP_S 1
#define REP_W 1
#define REP_F 1
#define REP_G 1

typedef unsigned short u16;
using bf16x8 = __attribute__((ext_vector_type(8))) short;
using f32x16 = __attribute__((ext_vector_type(16))) float;
using f32x4  = __attribute__((ext_vector_type(4))) float;
#define DI __device__ __forceinline__
#define MFMA16(a, b, c) __builtin_amdgcn_mfma_f32_16x16x32_bf16((a), (b), (c), 0, 0, 0)

constexpr int SEQ = 8192, M = 16384, D = 1024, NIN = 3344, N1 = 3328;
constexpr int C_DNQ = 0, C_DNK = 512, C_DNV = 1024, C_DNZ = 1536, C_SWQ = 2048, C_SWK = 2560, C_SWV = 2688, C_SWZ = 2816;
constexpr float EPS = 1e-6f;

constexpr int LDA = 1536, LDB = 1792;
constexpr int B_DNZ = 0, B_SWQ = 512, B_SWK = 1024, B_SWV = 1152, B_SWZ = 1280;
constexpr size_t OFF_XN   = 0;
constexpr size_t OFF_W1   = OFF_XN + (size_t)M * 1024 * 2;
constexpr size_t OFF_W2   = OFF_W1 + (size_t)N1 * 1024 * 2;
constexpr size_t OFF_BETA = OFF_W2 + (size_t)1024 * 1024 * 2;
constexpr size_t OFF_G    = OFF_BETA + (size_t)M * 8 * 4;
constexpr size_t OFF_ROPC = OFF_G + (size_t)M * 8 * 4;
constexpr size_t OFF_ROPS = OFF_ROPC + (size_t)SEQ * 32 * 4;
constexpr size_t OFF_PROJB= OFF_ROPS + (size_t)SEQ * 32 * 4;
constexpr size_t OFF_QN   = OFF_PROJB + (size_t)M * LDB * 2;
constexpr size_t OFF_KN   = OFF_QN + (size_t)M * 512 * 2;
constexpr size_t OFF_VV   = OFF_KN + (size_t)M * 512 * 2;
constexpr size_t OFF_PROJA= OFF_VV + (size_t)M * 512 * 2;
constexpr size_t OFF_PW   = OFF_PROJA;
constexpr size_t OFF_PU   = OFF_PW + (size_t)2048 * 8192 * 2;
constexpr size_t OFF_PK   = OFF_PU + (size_t)2048 * 8192 * 2;
constexpr size_t OFF_END  = OFF_PK + (size_t)2048 * 8192 * 2;
constexpr size_t DO_OB = (size_t)M * 512 * 2, DO_KR = (size_t)M * 512 * 4, DO_PA = DO_KR + (size_t)M * 128 * 4, DO_PE = DO_PA + (size_t)2048 * 4096 * 2, DO_PGL = DO_PE + (size_t)2048 * 64 * 4;
constexpr size_t DO_VT = DO_PGL + 8192;
constexpr int VT_LD = SEQ + 64;
static_assert(DO_VT + (size_t)256 * VT_LD * 2 <= (size_t)M * 1024 * 4, "d_out scratch overflow");
constexpr size_t OFF_BAR  = OFF_END;
constexpr size_t OFF_PROG = OFF_BAR + 16384;
constexpr size_t OFF_CTL_END = OFF_PROG + 16 * 256;
static_assert(OFF_CTL_END <= (size_t)256 * 1024 * 1024, "workspace overflow");

struct Params {
  const float *x, *norm_w, *w_in, *conv_w, *a_log, *dt_bias, *out_norm_w, *qnw, *knw, *sinks, *w_out;
  float* out;
  unsigned char* ws;
};

DI u16 f2bf(float x) { __bf16 r = (__bf16)x; return __builtin_bit_cast(u16, r); }
DI float bf2f(u16 v) { return __uint_as_float(((unsigned)v) << 16); }
typedef float f32x2_t __attribute__((ext_vector_type(2)));
typedef __bf16 bf16x2_t __attribute__((ext_vector_type(2)));
DI unsigned pack2(float a, float b) { f32x2_t v = {a, b}; bf16x2_t r = __builtin_convertvector(v, bf16x2_t); return __builtin_bit_cast(unsigned, r); }
template <int CTRL> DI float dpp_mov(float v) { return __int_as_float(__builtin_amdgcn_update_dpp(0, __float_as_int(v), CTRL, 0xF, 0xF, true)); }
DI float sum4(float v) { v += dpp_mov<0xB1>(v); v += dpp_mov<0x4E>(v); return v; }
DI float sum16(float v) { v = sum4(v); v += dpp_mov<0x141>(v); v += dpp_mov<0x140>(v); return v; }
DI float wave_sum(float v) {
  v = sum16(v);
  return (__int_as_float(__builtin_amdgcn_readlane(__float_as_int(v), 0)) + __int_as_float(__builtin_amdgcn_readlane(__float_as_int(v), 16))) +
         (__int_as_float(__builtin_amdgcn_readlane(__float_as_int(v), 32)) + __int_as_float(__builtin_amdgcn_readlane(__float_as_int(v), 48)));
}
DI float silu(float y) { return y * __frcp_rn(1.f + __expf(-y)); }
#define XB_TMO      128
#define XB_XCNT(j)  (256  + 64 * (j))
#define XB_XSUB(j)  (1280 + 64 * (j))
#define XB_XGEN(j)  (2304 + 64 * (j))
#define XB_TOP      3328
#define XB_TOPGEN   3392
#define XCD_BAR_WORDS 3456
#define XB_SPIN_CAP (1u << 20)
DI unsigned xb_ld(unsigned* p) { return __hip_atomic_load(p, __ATOMIC_RELAXED, __HIP_MEMORY_SCOPE_AGENT); }
DI unsigned xb_add(unsigned* p, unsigned v) { return __hip_atomic_fetch_add(p, v, __ATOMIC_RELAXED, __HIP_MEMORY_SCOPE_AGENT); }
DI unsigned xb_xcc_id() { return (unsigned)__builtin_amdgcn_s_getreg((3 << 11) | 20) & 0xFu; }
#define XB_SPIN(cond, bar) do { unsigned _sp = 0; while (cond) { __builtin_amdgcn_s_sleep(1); \
    if ((++_sp & 255u) == 0u) { if (xb_ld(&(bar)[XB_TMO])) break; if (_sp > XB_SPIN_CAP) { atomicAdd(&(bar)[XB_TMO], 1u); break; } } } } while (0)
struct XcdBarrier { unsigned* bar; unsigned x; volatile unsigned* st; };
DI XcdBarrier xcd_barrier_post(unsigned* bar, volatile unsigned* st) {
  XcdBarrier b; b.bar = bar; b.x = xb_xcc_id(); b.st = st;
  if (threadIdx.x == 0) (void)xb_add(&bar[XB_XCNT(b.x)], 1u);
  return b;
}
DI void xcd_barrier_complete(unsigned* bar, unsigned x, unsigned& nloc, unsigned& nx) {
  const unsigned G = gridDim.x;
  unsigned sum, cnt, mine, sp = 0u;
  for (;;) {
    sum = 0u; cnt = 0u; mine = 0u;
#pragma unroll
    for (unsigned j = 0; j < 16; ++j) { const unsigned c = xb_ld(&bar[XB_XCNT(j)]); sum += c; cnt += (c > 0u) ? 1u : 0u; mine = (j == x) ? c : mine; }
    if (sum == G) break;
    __builtin_amdgcn_s_sleep(1);
    if ((++sp & 255u) == 0u) { if (xb_ld(&bar[XB_TMO])) break; if (sp > XB_SPIN_CAP) { atomicAdd(&bar[XB_TMO], 1u); break; } }
  }
  nloc = mine > 0u ? mine : 1u; nx = cnt > 0u ? cnt : 1u;
}
DI void xcd_barrier(const XcdBarrier& b) {
  asm volatile("s_waitcnt vmcnt(0)" ::: "memory");
  __syncthreads();
  if (threadIdx.x == 0) {
    unsigned* bar = b.bar;
    __builtin_amdgcn_s_waitcnt(0);
    unsigned nloc = b.st[0], nx = b.st[1];
    if (nloc == 0u) { xcd_barrier_complete(bar, b.x, nloc, nx); b.st[0] = nloc; b.st[1] = nx; }
    const unsigned old = xb_add(&bar[XB_XSUB(b.x)], 1u);
    const unsigned gen = old / nloc;
    if (old + 1u == (gen + 1u) * nloc) {
      __builtin_amdgcn_fence(__ATOMIC_RELEASE, "agent");
      asm volatile("s_waitcnt vmcnt(0)" ::: "memory");
      const unsigned og = xb_add(&bar[XB_TOP], 1u);
      const unsigned tg = og / nx;
      if (og + 1u == (tg + 1u) * nx) xb_add(&bar[XB_TOPGEN], 1u);
      else XB_SPIN(xb_ld(&bar[XB_TOPGEN]) == tg, bar);
      __builtin_amdgcn_fence(__ATOMIC_ACQUIRE, "agent");
      xb_add(&bar[XB_XGEN(b.x)], 1u);
      asm volatile("s_waitcnt vmcnt(0)" ::: "memory");
    } else {
      XB_SPIN(xb_ld(&bar[XB_XGEN(b.x)]) == gen, bar);
      __builtin_amdgcn_fence(__ATOMIC_ACQUIRE, "agent");
      asm volatile("s_waitcnt vmcnt(0)" ::: "memory");
    }
  }
  __syncthreads();
}
DI int crow(int i, int h) { return (i & 3) + 8 * (i >> 2) + 4 * h; }

__device__ void phaseA(const Params& p, int bid, int nb, unsigned char* smem_raw) {
  float* smem = (float*)smem_raw;
  const int tid = threadIdx.x, wave = tid >> 6, lane = tid & 63;
#pragma unroll
  for (int i = 0; i < 4; ++i) {
    const int k = tid + 256 * i;
    const float4* src = (const float4*)(p.w_in + (size_t)k * NIN + 2048);
#pragma unroll
    for (int q = 0; q < 4; ++q) {
      const float4 v4 = src[q];
      smem[(4 * q + 0) * 1024 + k] = v4.x; smem[(4 * q + 1) * 1024 + k] = v4.y; smem[(4 * q + 2) * 1024 + k] = v4.z; smem[(4 * q + 3) * 1024 + k] = v4.w;
    }
  }
  __syncthreads();
  u16* xn = (u16*)(p.ws + OFF_XN);
  float* betaA = (float*)(p.ws + OFF_BETA);
  float* gA = (float*)(p.ws + OFF_G);
  float4 nwv[4];
#pragma unroll
  for (int i = 0; i < 4; ++i) nwv[i] = ((const float4*)p.norm_w)[lane + 64 * i];
  const float dtb = lane < 16 && lane >= 8 ? p.dt_bias[lane - 8] : 0.f;
  const float nal = lane < 16 && lane >= 8 ? -__expf(p.a_log[lane - 8]) : 0.f;
  float4 v[4], vn[4];
  int row = bid * 4 + wave;
  if (row < M) {
#pragma unroll
    for (int i = 0; i < 4; ++i) v[i] = ((const float4*)(p.x + (size_t)row * D))[lane + 64 * i];
  }
  for (; row < M; row += nb * 4) {
    const int rown = row + nb * 4;
    if (rown < M) {
#pragma unroll
      for (int i = 0; i < 4; ++i) vn[i] = ((const float4*)(p.x + (size_t)rown * D))[lane + 64 * i];
    }
    float ss = 0.f;
#pragma unroll
    for (int i = 0; i < 4; ++i) ss += v[i].x * v[i].x + v[i].y * v[i].y + v[i].z * v[i].z + v[i].w * v[i].w;
    ss = wave_sum(ss);
    const float rstd = rsqrtf(ss * (1.f / 1024.f) + EPS);
#pragma unroll
    for (int i = 0; i < 4; ++i) {
      v[i].x *= rstd * nwv[i].x; v[i].y *= rstd * nwv[i].y; v[i].z *= rstd * nwv[i].z; v[i].w *= rstd * nwv[i].w;
      uint2 pk; pk.x = pack2(v[i].x, v[i].y); pk.y = pack2(v[i].z, v[i].w);
      *(uint2*)(xn + (size_t)row * 1024 + (lane + 64 * i) * 4) = pk;
    }
    float r = 0.f;
#pragma unroll 2
    for (int j = 0; j < 16; ++j) {
      float a = 0.f;
#pragma unroll
      for (int i = 0; i < 4; ++i) {
        float4 w = *(const float4*)&smem[j * 1024 + (lane + 64 * i) * 4];
        a += v[i].x * w.x + v[i].y * w.y + v[i].z * w.z + v[i].w * w.w;
      }
      a = wave_sum(a);
      r = (lane == j) ? a : r;
    }
    if (lane < 8) betaA[(size_t)row * 8 + lane] = 1.f / (1.f + __expf(-r));
    else if (lane < 16) {
      float xx = r + dtb;
      float sp = fmaxf(xx, 0.f) + log1pf(__expf(-fabsf(xx)));
      gA[(size_t)row * 8 + lane - 8] = nal * sp;
    }
#pragma unroll
    for (int i = 0; i < 4; ++i) v[i] = vn[i];
  }
  u16* w1 = (u16*)(p.ws + OFF_W1);
  u16* w2 = (u16*)(p.ws + OFF_W2);
  const int gt = bid * 256 + tid, gs = nb * 256;
  {
    unsigned char* Lt = smem_raw;
    const int kq = tid >> 4, n4 = (tid & 15) * 4;
    for (int tile = bid; tile < 52 * 16 + 16 * 16; tile += nb) {
      const bool isw1 = tile < 52 * 16;
      const int tt = isw1 ? tile : tile - 52 * 16;
      const int n0 = isw1 ? (tt >> 4) * 64 : (tt >> 4) * 64, k0 = (tt & 15) * 64;
      const float* src = isw1 ? p.w_in + (n0 < 2048 ? n0 : n0 + 16) : p.w_out + n0;
      const int ldw = isw1 ? NIN : 1024;
      __syncthreads();
#pragma unroll
      for (int i = 0; i < 4; ++i) {
        const int kl = kq + 16 * i;
        const float4 v4 = *(const float4*)(src + (size_t)(k0 + kl) * ldw + n4);
        *(u16*)(Lt + (n4 + 0) * 144 + kl * 2) = f2bf(v4.x); *(u16*)(Lt + (n4 + 1) * 144 + kl * 2) = f2bf(v4.y);
        *(u16*)(Lt + (n4 + 2) * 144 + kl * 2) = f2bf(v4.z); *(u16*)(Lt + (n4 + 3) * 144 + kl * 2) = f2bf(v4.w);
      }
      __syncthreads();
      u16* dst = (isw1 ? w1 : w2) + (size_t)(n0 + (tid >> 2)) * 1024 + k0;
      *(uint4*)(dst + (tid & 3) * 8) = *(const uint4*)(Lt + (tid >> 2) * 144 + (tid & 3) * 16);
      *(uint4*)(dst + (tid & 3) * 8 + 32) = *(const uint4*)(Lt + (tid >> 2) * 144 + (tid & 3) * 16 + 64);
    }
  }
  float* rc = (float*)(p.ws + OFF_ROPC);
  float* rs = (float*)(p.ws + OFF_ROPS);
  for (int idx = gt; idx < SEQ * 32; idx += gs) {
    int pos = idx >> 5, i = idx & 31;
    float inv = exp2f(-(float)i * (13.287712379549449f / 32.f));
    float ang = (float)pos * inv;
    double a = (double)ang * 0.15915494309189535;
    float fr = (float)(a - rint(a));
    rc[idx] = __builtin_amdgcn_cosf(fr); rs[idx] = __builtin_amdgcn_sinf(fr);
  }
}

template <int MODE>
__device__ void gemm_tile(const Params& p, const u16* __restrict__ A, const u16* __restrict__ Bt, int K, int m0, int n0, unsigned char* smem) {
  const int tid = threadIdx.x, wave = tid >> 6, lane = tid & 63;
  const int wm = wave >> 1, wn = wave & 1, r = lane & 31, h = lane >> 5;
  unsigned char* As = smem;
  unsigned char* Bs = smem + 32768;
  f32x16 acc[2][2];
#pragma unroll
  for (int a = 0; a < 2; ++a)
#pragma unroll
    for (int b = 0; b < 2; ++b)
#pragma unroll
      for (int i = 0; i < 16; ++i) acc[a][b][i] = 0.f;
  uint4 s0a0, s0a1, s0a2, s0a3, s0b0, s0b1, s0b2, s0b3, s1a0, s1a1, s1a2, s1a3, s1b0, s1b1, s1b2, s1b3;
  const int KT = K / 64;
  const int lrow = tid >> 3, lc = tid & 7;
  const u16* gA = A + (size_t)(m0 + lrow) * K + lc * 8;
  const u16* gB = Bt + (size_t)(n0 + lrow) * K + lc * 8;
  const int loff = lrow * 128 + ((lc ^ ((lrow >> 1) & 7)) << 4);
#define GLOAD(kt_, S) { const u16* pa_ = gA + (kt_) * 64; const u16* pb_ = gB + (kt_) * 64; \
    S##a0 = *(const uint4*)(pa_); S##a1 = *(const uint4*)(pa_ + (size_t)32 * K); S##a2 = *(const uint4*)(pa_ + (size_t)64 * K); S##a3 = *(const uint4*)(pa_ + (size_t)96 * K); \
    S##b0 = *(const uint4*)(pb_); S##b1 = *(const uint4*)(pb_ + (size_t)32 * K); S##b2 = *(const uint4*)(pb_ + (size_t)64 * K); S##b3 = *(const uint4*)(pb_ + (size_t)96 * K); }
#define LSTORE(buf_, S) { unsigned char* la_ = As + (buf_) * 16384 + loff; unsigned char* lb_ = Bs + (buf_) * 16384 + loff; \
    *(uint4*)(la_) = S##a0; *(uint4*)(la_ + 4096) = S##a1; *(uint4*)(la_ + 8192) = S##a2; *(uint4*)(la_ + 12288) = S##a3; \
    *(uint4*)(lb_) = S##b0; *(uint4*)(lb_ + 4096) = S##b1; *(uint4*)(lb_ + 8192) = S##b2; *(uint4*)(lb_ + 12288) = S##b3; }
  const int rowa0 = wm * 64 + r, rowb0 = wn * 64 + r;
  const int swa0 = (rowa0 >> 1) & 7, swb0 = (rowb0 >> 1) & 7;
#define LDFRAG(buf_, ks_, AF, BF) { const int c_ = (ks_) * 2 + h; \
    AF[0] = *(const bf16x8*)(As + (buf_) * 16384 + rowa0 * 128 + ((c_ ^ swa0) << 4)); AF[1] = *(const bf16x8*)(As + (buf_) * 16384 + (rowa0 + 32) * 128 + ((c_ ^ swa0) << 4)); \
    BF[0] = *(const bf16x8*)(Bs + (buf_) * 16384 + rowb0 * 128 + ((c_ ^ swb0) << 4)); BF[1] = *(const bf16x8*)(Bs + (buf_) * 16384 + (rowb0 + 32) * 128 + ((c_ ^ swb0) << 4)); }
#define MMA4(AF, BF) { acc[0][0] = __builtin_amdgcn_mfma_f32_32x32x16_bf16(BF[0], AF[0], acc[0][0], 0, 0, 0); acc[0][1] = __builtin_amdgcn_mfma_f32_32x32x16_bf16(BF[1], AF[0], acc[0][1], 0, 0, 0); \
    acc[1][0] = __builtin_amdgcn_mfma_f32_32x32x16_bf16(BF[0], AF[1], acc[1][0], 0, 0, 0); acc[1][1] = __builtin_amdgcn_mfma_f32_32x32x16_bf16(BF[1], AF[1], acc[1][1], 0, 0, 0); }
  auto compute = [&](int buf) {
    bf16x8 afA[2], bfA[2], afB[2], bfB[2];
    LDFRAG(buf, 0, afA, bfA)
    LDFRAG(buf, 1, afB, bfB)
    __builtin_amdgcn_sched_barrier(0);
    __builtin_amdgcn_s_setprio(1);
    MMA4(afA, bfA)
    __builtin_amdgcn_sched_barrier(0);
    LDFRAG(buf, 2, afA, bfA)
    __builtin_amdgcn_sched_barrier(0);
    MMA4(afB, bfB)
    __builtin_amdgcn_sched_barrier(0);
    LDFRAG(buf, 3, afB, bfB)
    __builtin_amdgcn_sched_barrier(0);
    MMA4(afA, bfA)
    MMA4(afB, bfB)
    __builtin_amdgcn_s_setprio(0);
    __builtin_amdgcn_sched_barrier(0);
  };
  __syncthreads();
  GLOAD(0, s0) LSTORE(0, s0)
  GLOAD(1, s1)
  __syncthreads();
  for (int kt = 0; kt < KT; kt += 2) {
    { const int k2 = kt + 2 < KT ? kt + 2 : KT - 1; GLOAD(k2, s0) }
    compute(0);
    LSTORE(1, s1)
    __syncthreads();
    { const int k3 = kt + 3 < KT ? kt + 3 : KT - 1; GLOAD(k3, s1) }
    compute(1);
    if (kt + 2 < KT) { LSTORE(0, s0) }
    __syncthreads();
  }
#undef GLOAD
#undef LSTORE
  if (MODE == 0) {
#pragma unroll
    for (int a = 0; a < 2; ++a)
#pragma unroll
      for (int b = 0; b < 2; ++b)
#pragma unroll
        for (int g = 0; g < 4; ++g)
          *(uint2*)(smem + (wm * 64 + a * 32 + r) * 272 + (wn * 64 + b * 32 + 8 * g + 4 * h) * 2) = make_uint2(pack2(acc[a][b][4 * g], acc[a][b][4 * g + 1]), pack2(acc[a][b][4 * g + 2], acc[a][b][4 * g + 3]));
    __syncthreads();
    u16* dstb = n0 < 1536 ? (u16*)(p.ws + OFF_PROJA) + n0 : (u16*)(p.ws + OFF_PROJB) + (n0 - 1536);
    const int ld = n0 < 1536 ? LDA : LDB;
#pragma unroll
    for (int i = 0; i < 8; ++i) {
      const int id = tid + 256 * i, row = id >> 4, ch = id & 15;
      *(uint4*)(dstb + (size_t)(m0 + row) * ld + ch * 8) = *(const uint4*)(smem + row * 272 + ch * 16);
    }
    __syncthreads();
  } else {
    float* Cs = (float*)smem;
#pragma unroll
    for (int half = 0; half < 2; ++half) {
      if (wm == half) {
#pragma unroll
        for (int a = 0; a < 2; ++a)
#pragma unroll
          for (int b = 0; b < 2; ++b)
#pragma unroll
            for (int g = 0; g < 4; ++g)
              *(float4*)(Cs + (a * 32 + r) * 132 + wn * 64 + b * 32 + 8 * g + 4 * h) = make_float4(acc[a][b][4 * g], acc[a][b][4 * g + 1], acc[a][b][4 * g + 2], acc[a][b][4 * g + 3]);
      }
      __syncthreads();
#pragma unroll
      for (int i = 0; i < 8; ++i) {
        const int id = tid + 256 * i, row = id >> 5, ch = id & 31;
        const size_t go = (size_t)(m0 + half * 64 + row) * 1024 + n0 + ch * 4;
        const float4 xv = *(const float4*)(p.x + go);
        const float4 cv = *(const float4*)(Cs + row * 132 + ch * 4);
        *(float4*)(p.out + go) = make_float4(xv.x + cv.x, xv.y + cv.y, xv.z + cv.z, xv.w + cv.w);
      }
      __syncthreads();
    }
  }
}

__device__ void phaseB(const Params& p, int bid, int nb, unsigned char* smem) {
  const u16* xn = (const u16*)(p.ws + OFF_XN);
  const u16* w1 = (const u16*)(p.ws + OFF_W1);
  if ((nb & 7) == 0) {
    const int x = bid & 7, w = bid >> 3, per = nb >> 3;
    for (int j = w; j < 16 * 26; j += per) {
      const int g = j / 208, rem = j % 208;
      const int tn = rem >> 3, tm = x * 16 + g * 8 + (rem & 7);
      gemm_tile<0>(p, xn, w1, 1024, tm * 128, tn * 128, smem);
    }
  } else {
    for (int t = bid; t < 128 * 26; t += nb) gemm_tile<0>(p, xn, w1, 1024, (t / 26) * 128, (t % 26) * 128, smem);
  }
}
__device__ void phaseG(const Params& p, int bid, int nb, unsigned char* smem) {
  const u16* mix = (const u16*)(p.ws + OFF_XN);
  const u16* w2 = (const u16*)(p.ws + OFF_W2);
  if ((nb & 7) == 0) {
    const int x = bid & 7, w = bid >> 3, per = nb >> 3;
    for (int j = w; j < 16 * 8; j += per) {
      const int g = j >> 6, rem = j & 63;
      const int tn = rem >> 3, tm = x * 16 + g * 8 + (rem & 7);
      gemm_tile<1>(p, mix, w2, 1024, tm * 128, tn * 128, smem);
    }
  } else {
    for (int t = bid; t < 128 * 8; t += nb) gemm_tile<1>(p, mix, w2, 1024, (t >> 3) * 128, (t & 7) * 128, smem);
  }
}

DI void unpack8(const uint4 u, float* f) {
  f[0] = __uint_as_float(u.x << 16); f[1] = __uint_as_float(u.x & 0xffff0000u); f[2] = __uint_as_float(u.y << 16); f[3] = __uint_as_float(u.y & 0xffff0000u);
  f[4] = __uint_as_float(u.z << 16); f[5] = __uint_as_float(u.z & 0xffff0000u); f[6] = __uint_as_float(u.w << 16); f[7] = __uint_as_float(u.w & 0xffff0000u);
}
DI uint4 pack8(const float* f) { return make_uint4(pack2(f[0], f[1]), pack2(f[2], f[3]), pack2(f[4], f[5]), pack2(f[6], f[7])); }

__device__ void phaseC(const Params& p, int bid, int nb, unsigned char* smem) {
  const int tid = threadIdx.x, wave = tid >> 6, lane = tid & 63;
  const u16* projA = (const u16*)(p.ws + OFF_PROJA);
  const u16* projB = (const u16*)(p.ws + OFF_PROJB);
  u16* kr = (u16*)((unsigned char*)p.out + DO_KR);
  u16* vT = (u16*)((unsigned char*)p.out + DO_VT);
  u16* qr = (u16*)(p.ws + OFF_XN);
  const float* rc = (const float*)(p.ws + OFF_ROPC);
  const float* rs = (const float*)(p.ws + OFF_ROPS);
  int* wctr = (int*)smem;
  __syncthreads();
  if (tid == 0) *wctr = 0;
  __syncthreads();
  if (tid < 192) {
    const int sec = tid >> 6, ch0 = (tid & 63) * 8;
    u16* dst = (u16*)(p.ws + (sec == 0 ? OFF_QN : (sec == 1 ? OFF_KN : OFF_VV)));
    float w[5][8];
#pragma unroll
    for (int j = 0; j < 5; ++j) {
      const float4 w0 = *(const float4*)(p.conv_w + j * 1536 + sec * 512 + ch0), w1 = *(const float4*)(p.conv_w + j * 1536 + sec * 512 + ch0 + 4);
      w[j][0] = w0.x; w[j][1] = w0.y; w[j][2] = w0.z; w[j][3] = w0.w; w[j][4] = w1.x; w[j][5] = w1.y; w[j][6] = w1.z; w[j][7] = w1.w;
    }
    for (int run = bid; run < M / 32; run += nb) {
      const int m0 = run * 32, t0 = m0 & (SEQ - 1);
      auto ldraw = [&](int i) {
        const int t = t0 + i;
        uint4 u = make_uint4(0u, 0u, 0u, 0u);
        if (t >= 0 && t < SEQ) u = *(const uint4*)(projA + (size_t)(m0 + i) * LDA + sec * 512 + ch0);
        return u;
      };
      float r[5][8];
      { uint4 u0 = ldraw(-2), u1 = ldraw(-1), u2 = ldraw(0), u3 = ldraw(1); unpack8(u0, r[0]); unpack8(u1, r[1]); unpack8(u2, r[2]); unpack8(u3, r[3]); }
      uint4 pre0 = ldraw(2), pre1 = ldraw(3), pre2 = ldraw(4);
#pragma unroll 1
      for (int i = 0; i < 32; ++i) {
        unpack8(pre0, r[4]);
        pre0 = pre1; pre1 = pre2; pre2 = ldraw(i + 5 < 34 ? i + 5 : 33);
        float y[8]; float ss = 0.f;
#pragma unroll
        for (int c = 0; c < 8; ++c) {
          float a = r[0][c] * w[0][c] + r[1][c] * w[1][c] + r[2][c] * w[2][c] + r[3][c] * w[3][c] + r[4][c] * w[4][c];
          a = silu(a); y[c] = a; ss += a * a;
        }
        if (sec < 2) {
          ss = sum16(ss);
          const float f = rsqrtf(ss + EPS) * (sec == 0 ? 0.08838834764831845f : 1.f);
#pragma unroll
          for (int c = 0; c < 8; ++c) y[c] *= f;
        }
        if (sec == 0) {
          const int mm = m0 + i, tq = mm & (SEQ - 1), cq = tq & 63, chq = (ch0 & 127) >> 3;
          const size_t tileq = (size_t)(((mm >> 13) * 4 + (ch0 >> 7)) * 128 + (tq >> 6));
          *(uint4*)(dst + tileq * 8192 + (((cq >> 4) * 4 + (chq >> 2)) * 64 + (chq & 3) * 16 + (cq & 15)) * 8) = pack8(y);
        } else *(uint4*)(dst + (size_t)(m0 + i) * 512 + ch0) = pack8(y);
#pragma unroll
        for (int j = 0; j < 4; ++j)
#pragma unroll
          for (int c = 0; c < 8; ++c) r[j][c] = r[j + 1][c];
      }
    }
  }
  const int nitems = M / 2 + M / 8, ipw = (nitems + nb - 1) / nb;
  for (;;) {
    int it = 0;
    if (lane == 0) it = atomicAdd(wctr, 1);
    it = __shfl(it, 0);
    const int item = bid * ipw + it;
    if (it >= ipw || item >= nitems) break;
    const bool isk = item >= M / 2;
    const int j = lane & 3;
    int m, head;
    if (!isk) { m = item * 2 + (lane >> 5); head = (lane >> 2) & 7; }
    else      { m = (item - M / 2) * 8 + (lane >> 3); head = (lane >> 2) & 1; }
    const int t = m & (SEQ - 1);
    const u16* src = projB + (size_t)m * LDB + (isk ? B_SWK : B_SWQ) + head * 64 + 8 * j;
    float lo[8], hi[8];
    unpack8(*(const uint4*)src, lo); unpack8(*(const uint4*)(src + 32), hi);
    float ss = 0.f;
#pragma unroll
    for (int c = 0; c < 8; ++c) ss += lo[c] * lo[c] + hi[c] * hi[c];
    ss = sum4(ss);
    const float rstd = rsqrtf(ss * (1.f / 64.f) + EPS) * (isk ? 1.f : 0.125f);
    const float* nw = isk ? p.knw : p.qnw;
    float olo[8], ohi[8];
#pragma unroll
    for (int c = 0; c < 8; ++c) {
      const float y0 = lo[c] * rstd * nw[8 * j + c], y1 = hi[c] * rstd * nw[32 + 8 * j + c];
      const float cs = rc[t * 32 + 8 * j + c], sn = rs[t * 32 + 8 * j + c];
      olo[c] = y0 * cs - y1 * sn; ohi[c] = y1 * cs + y0 * sn;
    }
    if (isk) {
      u16* dst = kr + ((size_t)(((m >> 13) * 2 + head) * 512 + (t >> 4)) * 2) * 512 + (j * 16 + (t & 15)) * 8;
      *(uint4*)dst = pack8(olo); *(uint4*)(dst + 512) = pack8(ohi);
    } else {
      u16* dst = qr + (size_t)m * 1024 + head * 64 + 8 * j;
      *(uint4*)dst = pack8(olo); *(uint4*)(dst + 32) = pack8(ohi);
    }
  }
  for (int it = bid * 256 + tid; it < 128 * (M / 8); it += nb * 256) {
    const int c = it & 127, m0 = (it >> 7) * 8;
    const int b = m0 >> 13, t0 = m0 & (SEQ - 1);
    const u16* src = projB + (size_t)m0 * LDB + B_SWV + c;
    unsigned pk[4];
#pragma unroll
    for (int i = 0; i < 4; ++i) pk[i] = (unsigned)src[(size_t)(2 * i) * LDB] | ((unsigned)src[(size_t)(2 * i + 1) * LDB] << 16);
    u16* dst = vT + ((size_t)(((b * 2 + (c >> 6)) * 512 + (t0 >> 4)) * 4 + ((c & 63) >> 4)) * 64 + ((t0 >> 2) & 3) * 16 + (c & 15)) * 4;
    *(uint2*)dst = make_uint2(pk[0], pk[1]);
    *(uint2*)(dst + 64) = make_uint2(pk[2], pk[3]);
  }
}

__device__ void prep_tile(const Params& p, int tile, unsigned char* smem) {
  int tid_ = threadIdx.x;
  asm volatile("" : "+v"(tid_));
  const int tid = tid_, wave = __builtin_amdgcn_readfirstlane(tid >> 6), lane = tid & 63;
  const int dir = tile & 1, n = (tile >> 1) & 127, bh = tile >> 8, b = bh >> 2, hh = bh & 3;
  unsigned char* ksb = smem;
  unsigned char* qsb = smem + 17408;
  float* Ms = (float*)(smem + 34816);
  float* gc = (float*)(smem + 51200);
  float* bt = gc + 64;
  float* cw = (float*)(smem + 64000);
  float* cd = (float*)(smem + 64256);
  const u16* qn = (const u16*)(p.ws + OFF_QN);
  const u16* kn = (const u16*)(p.ws + OFF_KN);
  const u16* vv = (const u16*)(p.ws + OFF_VV);
  const float* betaA = (const float*)(p.ws + OFF_BETA);
  const float* gA = (const float*)(p.ws + OFF_G);
  u16* pw = (u16*)(p.ws + OFF_PW) + (size_t)tile * 8192;
  u16* pu = (u16*)(p.ws + OFF_PU) + (size_t)tile * 8192;
  u16* pk = (u16*)(p.ws + OFF_PK) + (size_t)tile * 8192;
  u16* pa = (u16*)((unsigned char*)p.out + DO_PA) + (size_t)tile * 4096;
  float* pe = (float*)((unsigned char*)p.out + DO_PE) + (size_t)tile * 64;
  float* pgl = (float*)((unsigned char*)p.out + DO_PGL);
  const size_t row0 = (size_t)b * SEQ + n * 64;
  __syncthreads();
#pragma unroll
  for (int i = 0; i < 4; ++i) {
    int id = tid + 256 * i, c = id >> 4, ch = id & 15;
    int tok = dir ? 63 - c : c;
    *(uint4*)(ksb + c * 272 + ch * 16) = *(const uint4*)(kn + (row0 + tok) * 512 + hh * 128 + ch * 8);
    *(uint4*)(qsb + c * 272 + ch * 16) = *(const uint4*)(qn + (size_t)(bh * 128 + n) * 8192 + (((tok >> 4) * 4 + (ch >> 2)) * 64 + (ch & 3) * 16 + (tok & 15)) * 8);
  }
  if (wave == 0) {
    int tok = dir ? 63 - lane : lane;
    float g = gA[(row0 + tok) * 8 + dir * 4 + hh];
    float bb = betaA[(row0 + tok) * 8 + dir * 4 + hh];
#pragma unroll
    for (int o = 1; o < 64; o <<= 1) { float t = __shfl_up(g, o); if (lane >= o) g += t; }
    gc[lane] = g; bt[lane] = bb;
    const float eg_ = __expf(g);
    pe[lane] = eg_;
    if (lane == 63) pgl[tile] = eg_;
    cw[lane] = bb * eg_;
    cd[lane] = __expf(__shfl(g, 63) - g);
  }
  __syncthreads();
  {
    const int row = lane & 15, quad = lane >> 4;
    bf16x8 ak[4], aq[4];
#pragma unroll
    for (int k = 0; k < 4; ++k) {
      ak[k] = *(const bf16x8*)(ksb + (16 * wave + row) * 272 + k * 64 + quad * 16);
      aq[k] = *(const bf16x8*)(qsb + (16 * wave + row) * 272 + k * 64 + quad * 16);
    }
#pragma unroll
    for (int tc = 0; tc < 4; ++tc) {
      f32x4 ckk = {0.f, 0.f, 0.f, 0.f}, cqk = {0.f, 0.f, 0.f, 0.f};
#pragma unroll
      for (int k = 0; k < 4; ++k) {
        bf16x8 bk = *(const bf16x8*)(ksb + (16 * tc + row) * 272 + k * 64 + quad * 16);
        ckk = MFMA16(ak[k], bk, ckk);
        cqk = MFMA16(aq[k], bk, cqk);
      }
      const int s = 16 * tc + row;
      const float gs = gc[s];
#pragma unroll
      for (int j = 0; j < 4; ++j) {
        const int c = 16 * wave + quad * 4 + j;
        float dec = __expf(fminf(gc[c] - gs, 0.f));
        float mval = (s < c) ? bt[c] * ckk[j] * dec : 0.f;
        float aval = (s <= c) ? cqk[j] * dec : 0.f;
        Ms[c * 64 + s] = mval;
        *(u16*)(smem + 51712 + ((((c >> 4) * 2 + (s >> 5)) * 64 + ((s >> 3) & 3) * 16 + (c & 15)) * 8 + (s & 7)) * 2) = f2bf(aval);
      }
    }
  }
  {
    const int dk = tid & 127, half = tid >> 7;
    const float gl = gc[63];
    unsigned pkd[16];
#pragma unroll
    for (int i = 0; i < 16; ++i) {
      int c0 = half * 32 + 2 * i;
      float k0 = bf2f(*(const u16*)(ksb + c0 * 272 + dk * 2)) * cd[c0];
      float k1 = bf2f(*(const u16*)(ksb + (c0 + 1) * 272 + dk * 2)) * cd[c0 + 1];
      pkd[i] = pack2(k0, k1);
    }
#pragma unroll
    for (int i = 0; i < 4; ++i) {
      const int cc = half * 4 + i;
      *(uint4*)(pk + ((((dk >> 5) * 2 + ((dk >> 4) & 1)) * 2 + (cc >> 2)) * 64 + (cc & 3) * 16 + (dk & 15)) * 8) = make_uint4(pkd[4 * i], pkd[4 * i + 1], pkd[4 * i + 2], pkd[4 * i + 3]);
    }
  }
  __syncthreads();
  {
    const uint4* src = (const uint4*)(smem + 51712);
    ((uint4*)pa)[tid] = src[tid];
    ((uint4*)pa)[tid + 256] = src[tid + 256];
  }
  float x[64];
  if (tid < 128) {
#pragma unroll
    for (int c = 0; c < 64; ++c) { int tok = dir ? 63 - c : c; x[c] = bt[c] * bf2f(vv[(row0 + tok) * 512 + hh * 128 + tid]); }
  } else {
#pragma unroll
    for (int c = 0; c < 64; ++c) x[c] = cw[c] * bf2f(*(const u16*)(ksb + c * 272 + (tid - 128) * 2));
  }
  __syncthreads();
  unsigned char* xs = smem;
  unsigned char* ys = smem + 51712;
  {
    const int row = lane & 15, quad = lane >> 4;
#pragma unroll
    for (int I = 0; I < 4; ++I) {
      asm volatile("" ::: "memory");
      if (I > 0) {
        f32x4 yacc[4];
#pragma unroll
        for (int nt = 0; nt < 4; ++nt) yacc[nt] = f32x4{0.f, 0.f, 0.f, 0.f};
#pragma unroll
        for (int ks = 0; ks < (16 * I + 31) / 32; ++ks) {
          const bool live = (ks * 32 + quad * 8) < 16 * I;
          const float4 m0 = *(const float4*)(Ms + (16 * I + row) * 64 + ks * 32 + quad * 8);
          const float4 m1 = *(const float4*)(Ms + (16 * I + row) * 64 + ks * 32 + quad * 8 + 4);
          union { bf16x8 v; unsigned u[4]; } af;
          af.u[0] = live ? pack2(m0.x, m0.y) : 0u; af.u[1] = live ? pack2(m0.z, m0.w) : 0u;
          af.u[2] = live ? pack2(m1.x, m1.y) : 0u; af.u[3] = live ? pack2(m1.z, m1.w) : 0u;
          const int qe = live ? quad : (quad & 1);
#pragma unroll
          for (int nt = 0; nt < 4; ++nt) {
            const bf16x8 bx = *(const bf16x8*)(xs + (64 * wave + 16 * nt + row) * 112 + (ks * 32 + qe * 8) * 2);
            yacc[nt] = MFMA16(af.v, bx, yacc[nt]);
          }
        }
#pragma unroll
        for (int nt = 0; nt < 4; ++nt)
          *(uint2*)(ys + (64 * wave + 16 * nt + row) * 48 + quad * 8) = make_uint2(pack2(yacc[nt][0], yacc[nt][1]), pack2(yacc[nt][2], yacc[nt][3]));
        const uint4 y0 = *(const uint4*)(ys + tid * 48), y1 = *(const uint4*)(ys + tid * 48 + 16);
        const unsigned yy[8] = {y0.x, y0.y, y0.z, y0.w, y1.x, y1.y, y1.z, y1.w};
#pragma unroll
        for (int r = 0; r < 16; ++r) x[16 * I + r] -= (r & 1) ? __uint_as_float(yy[r >> 1] & 0xffff0000u) : __uint_as_float(yy[r >> 1] << 16);
      }
      int mrow[16];
#pragma unroll
      for (int r = 1; r < 16; ++r) mrow[r] = __float_as_int(Ms[(16 * I + r) * 64 + lane]);
#pragma unroll
      for (int r = 1; r < 16; ++r) {
        float a0 = 0.f, a1 = 0.f;
#pragma unroll
        for (int sidx = 0; sidx < r; ++sidx) {
          const float m = __int_as_float(__builtin_amdgcn_readlane(mrow[r], 16 * I + sidx));
          if (sidx & 1) a1 = fmaf(m, x[16 * I + sidx], a1); else a0 = fmaf(m, x[16 * I + sidx], a0);
        }
        x[16 * I + r] -= a0 + a1;
      }
      if (I < 3) {
#pragma unroll
        for (int i = 0; i < 2; ++i)
          *(uint4*)(xs + tid * 112 + I * 32 + i * 16) = make_uint4(pack2(x[16 * I + 8 * i], x[16 * I + 8 * i + 1]), pack2(x[16 * I + 8 * i + 2], x[16 * I + 8 * i + 3]),
                                                                 pack2(x[16 * I + 8 * i + 4], x[16 * I + 8 * i + 5]), pack2(x[16 * I + 8 * i + 6], x[16 * I + 8 * i + 7]));
      }
    }
  }
  __syncthreads();
  if (tid < 128) {
#pragma unroll
    for (int g = 0; g < 16; ++g)
      *(uint2*)(pu + (((((tid >> 5) * 2 + ((tid >> 4) & 1)) * 4 + (g >> 2)) * 64 + (g & 3) * 16 + (tid & 15)) * 4)) = make_uint2(pack2(x[4 * g], x[4 * g + 1]), pack2(x[4 * g + 2], x[4 * g + 3]));
  } else {
#pragma unroll
    for (int c = 0; c < 64; ++c) *(u16*)(qsb + c * 272 + (tid - 128) * 2) = f2bf(-x[c]);
  }
  __syncthreads();
#pragma unroll
  for (int i = 0; i < 4; ++i) {
    const int d = tid + 256 * i;
    const int c = (d >> 8) * 16 + (d & 15), ch = ((d >> 6) & 3) * 4 + ((d >> 4) & 3);
    *(uint4*)(pw + d * 8) = *(const uint4*)(qsb + c * 272 + ch * 16);
  }
}

struct ScanEarly { bf16x8 aw[4]; uint2 u[2]; };
struct ScanFrags { bf16x8 aq[4], aa[2], akd[2][2]; float eg; float egl; };
__device__ void scan_chunked(const Params& p, int chain, int slab, unsigned char* smem) {
  const int tid = threadIdx.x, wave = tid >> 6, lane = tid & 63, row = lane & 15, quad = lane >> 4;
  const int dv0 = slab * 32;
  const int b = chain >> 3, hh = (chain >> 1) & 3, dir = chain & 1;
  unsigned* prog = (unsigned*)(p.ws + OFF_PROG) + chain * 64;
  const bool publisher = (dv0 == 0) && (tid == 0);
  unsigned char* Sl = smem;
  unsigned char* Vl = smem + 8704;
  const u16* qn = (const u16*)(p.ws + OFF_QN);
  const u16* pwA = (const u16*)(p.ws + OFF_PW);
  const u16* puA = (const u16*)(p.ws + OFF_PU);
  const u16* pkA = (const u16*)(p.ws + OFF_PK);
  const u16* paA = (const u16*)((unsigned char*)p.out + DO_PA);
  const float* peA = (const float*)((unsigned char*)p.out + DO_PE);
  const float* pglA = (const float*)((unsigned char*)p.out + DO_PGL);
  u16* ob = (u16*)((unsigned char*)p.out + (dir ? DO_OB : 0));
#pragma unroll 1
  for (int rep = 0; rep < REP_S; ++rep) {
  __syncthreads();
  for (int i = tid; i < 8704 / 4; i += 256) ((unsigned*)Sl)[i] = 0u;
  f32x4 Sacc[2][2];
#pragma unroll
  for (int a = 0; a < 2; ++a)
#pragma unroll
    for (int c = 0; c < 2; ++c) Sacc[a][c] = f32x4{0.f, 0.f, 0.f, 0.f};
  auto gloadE = [&](ScanEarly& e, int step) {
    const int n = dir ? 127 - step : step;
    const size_t tile = ((size_t)(b * 4 + hh) * 128 + n) * 2 + dir;
#pragma unroll
    for (int k = 0; k < 4; ++k) e.aw[k] = *(const bf16x8*)(pwA + tile * 8192 + ((wave * 4 + k) * 64 + lane) * 8);
#pragma unroll
    for (int nt = 0; nt < 2; ++nt) e.u[nt] = *(const uint2*)(puA + tile * 8192 + ((((dv0 >> 5) * 2 + nt) * 4 + wave) * 64 + lane) * 4);
  };
  auto gload = [&](ScanFrags& f, int step) {
    const int n = dir ? 127 - step : step;
    const size_t tile = ((size_t)(b * 4 + hh) * 128 + n) * 2 + dir;
    const int c = 16 * wave + row;
    const size_t qtile = (size_t)((b * 4 + hh) * 128 + n) * 8192;
    const int qlane = dir ? quad * 16 + (15 - row) : lane, qw = dir ? 3 - wave : wave;
#pragma unroll
    for (int k = 0; k < 4; ++k) f.aq[k] = *(const bf16x8*)(qn + qtile + ((qw * 4 + k) * 64 + qlane) * 8);
#pragma unroll
    for (int k = 0; k < 2; ++k) {
      f.aa[k] = *(const bf16x8*)(paA + tile * 4096 + ((wave * 2 + k) * 64 + lane) * 8);
#pragma unroll
      for (int d = 0; d < 2; ++d) f.akd[d][k] = *(const bf16x8*)(pkA + tile * 8192 + (((wave * 2 + d) * 2 + k) * 64 + lane) * 8);
    }
    f.eg = peA[tile * 64 + c];
    f.egl = pglA[tile];
  };
  auto body = [&](ScanEarly& e, ScanEarly& en2, ScanFrags& f, ScanFrags& fn, int step) {
    if (publisher) __hip_atomic_store(prog, (unsigned)(step + 1), __ATOMIC_RELAXED, __HIP_MEMORY_SCOPE_AGENT);
    if (step + 2 < 128) gloadE(en2, step + 2);
    if (step + 1 < 128) gload(fn, step + 1);
    bf16x8 bS[4][2];
#pragma unroll
    for (int k = 0; k < 4; ++k)
#pragma unroll
      for (int nt = 0; nt < 2; ++nt) bS[k][nt] = *(const bf16x8*)(Sl + (nt * 16 + row) * 272 + k * 64 + quad * 16);
    f32x4 vacc[2], oacc[2];
#pragma unroll
    for (int nt = 0; nt < 2; ++nt) {
      vacc[nt] = f32x4{__uint_as_float(e.u[nt].x << 16), __uint_as_float(e.u[nt].x & 0xffff0000u), __uint_as_float(e.u[nt].y << 16), __uint_as_float(e.u[nt].y & 0xffff0000u)};
#pragma unroll
      for (int k = 0; k < 4; ++k) vacc[nt] = MFMA16(e.aw[k], bS[k][nt], vacc[nt]);
      *(uint2*)(Vl + (nt * 16 + row) * 144 + (16 * wave + quad * 4) * 2) = make_uint2(pack2(vacc[nt][0], vacc[nt][1]), pack2(vacc[nt][2], vacc[nt][3]));
    }
    asm volatile("s_waitcnt lgkmcnt(0)\n\ts_barrier" ::: "memory");
#pragma unroll
    for (int nt = 0; nt < 2; ++nt) {
      oacc[nt] = f32x4{0.f, 0.f, 0.f, 0.f};
#pragma unroll
      for (int k = 0; k < 4; ++k) oacc[nt] = MFMA16(bS[k][nt], f.aq[k], oacc[nt]);
      oacc[nt] *= f.eg;
    }
    bf16x8 bV[2][2];
#pragma unroll
    for (int k = 0; k < 2; ++k)
#pragma unroll
      for (int nt = 0; nt < 2; ++nt) bV[k][nt] = *(const bf16x8*)(Vl + (nt * 16 + row) * 144 + k * 64 + quad * 16);
#pragma unroll
    for (int d = 0; d < 2; ++d)
#pragma unroll
      for (int nt = 0; nt < 2; ++nt) {
        Sacc[d][nt] *= f.egl;
#pragma unroll
        for (int k = 0; k < 2; ++k) Sacc[d][nt] = MFMA16(f.akd[d][k], bV[k][nt], Sacc[d][nt]);
        *(uint2*)(Sl + (nt * 16 + row) * 272 + (32 * wave + 16 * d + quad * 4) * 2) = make_uint2(pack2(Sacc[d][nt][0], Sacc[d][nt][1]), pack2(Sacc[d][nt][2], Sacc[d][nt][3]));
      }
    const int n = dir ? 127 - step : step;
#pragma unroll
    for (int nt = 0; nt < 2; ++nt) {
#pragma unroll
      for (int k = 0; k < 2; ++k) oacc[nt] = MFMA16(bV[k][nt], f.aa[k], oacc[nt]);
      const int c = 16 * wave + row;
      const int tok = dir ? 63 - c : c;
      *(uint2*)(ob + ((size_t)b * SEQ + n * 64 + tok) * 512 + hh * 128 + dv0 + nt * 16 + quad * 4) = make_uint2(pack2(oacc[nt][0], oacc[nt][1]), pack2(oacc[nt][2], oacc[nt][3]));
    }
    asm volatile("s_waitcnt lgkmcnt(0)\n\ts_barrier" ::: "memory");
  };
  ScanEarly e0, e1, e2;
  ScanFrags f0, f1;
  gloadE(e0, 0); gloadE(e1, 1);
  gload(f0, 0);
  __syncthreads();
#pragma unroll 1
  for (int step = 0; step < 126; step += 6) {
    body(e0, e2, f0, f1, step);
    body(e1, e0, f1, f0, step + 1);
    body(e2, e1, f0, f1, step + 2);
    body(e0, e2, f1, f0, step + 3);
    body(e1, e0, f0, f1, step + 4);
    body(e2, e1, f1, f0, step + 5);
  }
  body(e0, e2, f0, f1, 126);
  body(e1, e0, f1, f0, 127);
  }
}

constexpr int PF_DEPTH = 10, PF_BATCH = 4;
__device__ void scan_helper(const Params& p, int chain) {
  const int tid = threadIdx.x;
  const int b = chain >> 3, hh = (chain >> 1) & 3, dir = chain & 1;
  unsigned* prog = (unsigned*)(p.ws + OFF_PROG) + chain * 64;
  const unsigned char* pw = p.ws + OFF_PW;
  const unsigned char* pu = p.ws + OFF_PU;
  const unsigned char* pk = p.ws + OFF_PK;
  const unsigned char* pa = (const unsigned char*)p.out + DO_PA;
  const unsigned char* pe = (const unsigned char*)p.out + DO_PE;
  const unsigned char* qn = p.ws + OFF_QN;
  unsigned acc = 0u;
  int cur = 1;
#pragma unroll 1
  while (cur < 128) {
    const int done = (int)__hip_atomic_load(prog, __ATOMIC_RELAXED, __HIP_MEMORY_SCOPE_AGENT);
    if (done >= 127) break;
    if (cur < done + 1) cur = done + 1;
    const int lim = done + PF_DEPTH < 128 ? done + PF_DEPTH : 128;
    if (cur >= lim) { __builtin_amdgcn_s_sleep(4); continue; }
    unsigned v[PF_BATCH][3];
#pragma unroll
    for (int i = 0; i < PF_BATCH; ++i) {
      const int st = cur + i < lim ? cur + i : lim - 1;
      const int n = dir ? 127 - st : st;
      const size_t tile = ((size_t)(b * 4 + hh) * 128 + n) * 2 + dir;
      const unsigned char* a0 = (tid < 128) ? pw + tile * 16384 + tid * 128 : pu + tile * 16384 + (tid - 128) * 128;
      const unsigned char* a1 = (tid < 128) ? pk + tile * 16384 + tid * 128 : (tid < 192 ? pa + tile * 8192 + (tid - 128) * 128 : pe + tile * 256 + (tid & 1) * 128);
      const unsigned char* a2 = qn + (size_t)((b * 4 + hh) * 128 + n) * 16384 + (tid & 127) * 128;
      v[i][0] = *(const unsigned*)a0; v[i][1] = *(const unsigned*)a1; v[i][2] = *(const unsigned*)a2;
    }
#pragma unroll
    for (int i = 0; i < PF_BATCH; ++i) acc ^= v[i][0] ^ v[i][1] ^ v[i][2];
    cur = cur + PF_BATCH < lim ? cur + PF_BATCH : lim;
  }
  if (acc == 0x9e3779b9u && p.ws == nullptr) *(unsigned*)p.out = acc;
}

__device__ void swa_mfma(const Params& p, int bid, int nb) {
  const int wave = threadIdx.x >> 6, lane = threadIdx.x & 63, col = lane & 15, quad = lane >> 4;
  const u16* kr = (const u16*)((const unsigned char*)p.out + DO_KR);
  const u16* vT = (const u16*)((const unsigned char*)p.out + DO_VT);
  const u16* qr = (const u16*)(p.ws + OFF_XN);
  const u16* projB = (const u16*)(p.ws + OFF_PROJB);
  u16* mix = (u16*)(p.ws + OFF_XN);
  const int upw = (2048 + nb - 1) / nb;
  for (int unit = bid * upw; unit < (bid + 1) * upw && unit < 2048; ++unit) {
    const int qblk = unit & 511, kvh = (unit >> 9) & 1, b = unit >> 10;
    const int t0 = qblk * 16, qh = kvh * 4 + wave;
    const size_t mq = (size_t)b * SEQ + t0 + col;
    bf16x8 bq[2];
#pragma unroll
    for (int ks = 0; ks < 2; ++ks) bq[ks] = *(const bf16x8*)(qr + mq * 1024 + qh * 64 + ks * 32 + quad * 8);
    f32x4 sc[18];
    const int kb0 = (t0 >> 4) - 8;
    const u16* kbase = kr + (size_t)((b * 2 + kvh) * 512) * 1024 + lane * 8;
#pragma unroll
    for (int kt = 0; kt < 18; ++kt) {
      int kb = kb0 + kt; kb = kb < 0 ? 0 : (kb > 511 ? 511 : kb);
      const bf16x8 a0 = *(const bf16x8*)(kbase + (size_t)kb * 1024), a1 = *(const bf16x8*)(kbase + (size_t)kb * 1024 + 512);
      f32x4 c = {0.f, 0.f, 0.f, 0.f};
      c = MFMA16(a0, bq[0], c);
      c = MFMA16(a1, bq[1], c);
      sc[kt] = c;
    }
    const float sink = p.sinks[qh];
    float mx = sink;
#pragma unroll
    for (int kt = 0; kt < 18; ++kt)
#pragma unroll
      for (int jj = 0; jj < 4; ++jj) {
        const int key = t0 - 128 + 16 * kt + quad * 4 + jj;
        const int rel = key - (t0 + col);
        const bool valid = (rel >= -128) && (rel <= 128) && (key >= 0) && (key < SEQ);
        float v = valid ? sc[kt][jj] : -1e30f;
        sc[kt][jj] = v;
        mx = fmaxf(mx, v);
      }
    mx = fmaxf(mx, __shfl_xor(mx, 16));
    mx = fmaxf(mx, __shfl_xor(mx, 32));
    float l = 0.f;
#pragma unroll
    for (int kt = 0; kt < 18; ++kt)
#pragma unroll
      for (int jj = 0; jj < 4; ++jj) { float e = __expf(sc[kt][jj] - mx); sc[kt][jj] = e; l += e; }
    l += __shfl_xor(l, 16);
    l += __shfl_xor(l, 32);
    l += __expf(sink - mx);
    f32x4 o[4];
#pragma unroll
    for (int dt = 0; dt < 4; ++dt) o[dt] = f32x4{0.f, 0.f, 0.f, 0.f};
    bf16x8 bp[9];
#pragma unroll
    for (int kg = 0; kg < 9; ++kg) {
      union { bf16x8 v; unsigned u[4]; } t;
      t.u[0] = pack2(sc[2 * kg][0], sc[2 * kg][1]); t.u[1] = pack2(sc[2 * kg][2], sc[2 * kg][3]);
      t.u[2] = pack2(sc[2 * kg + 1][0], sc[2 * kg + 1][1]); t.u[3] = pack2(sc[2 * kg + 1][2], sc[2 * kg + 1][3]);
      bp[kg] = t.v;
    }
    const u16* vbase = vT + (size_t)((b * 2 + kvh) * 512) * 1024 + lane * 4;
#pragma unroll
    for (int hb = 0; hb < 2; ++hb) {
      uint2 av[5][4][2];
#pragma unroll
      for (int i = 0; i < 5; ++i) {
        const int kg = hb * 5 + i;
        if (kg < 9) {
          int b0 = kb0 + 2 * kg, b1 = b0 + 1;
          b0 = b0 < 0 ? 0 : (b0 > 511 ? 511 : b0); b1 = b1 < 0 ? 0 : (b1 > 511 ? 511 : b1);
#pragma unroll
          for (int dt = 0; dt < 4; ++dt) {
            av[i][dt][0] = *(const uint2*)(vbase + ((size_t)b0 * 4 + dt) * 256);
            av[i][dt][1] = *(const uint2*)(vbase + ((size_t)b1 * 4 + dt) * 256);
          }
        }
      }
      __builtin_amdgcn_sched_barrier(0);
#pragma unroll
      for (int i = 0; i < 5; ++i) {
        const int kg = hb * 5 + i;
        if (kg < 9) {
#pragma unroll
          for (int dt = 0; dt < 4; ++dt) {
            union { bf16x8 v; unsigned u[4]; } a;
            a.u[0] = av[i][dt][0].x; a.u[1] = av[i][dt][0].y; a.u[2] = av[i][dt][1].x; a.u[3] = av[i][dt][1].y;
            o[dt] = MFMA16(a.v, bp[kg], o[dt]);
          }
        }
      }
      __builtin_amdgcn_sched_barrier(0);
    }
    const float inv = __frcp_rn(l);
#pragma unroll
    for (int dt = 0; dt < 4; ++dt) {
      const int d0 = dt * 16 + quad * 4;
      uint2 z = *(const uint2*)(projB + mq * LDB + B_SWZ + qh * 64 + d0);
      float z0 = __uint_as_float(z.x << 16), z1 = __uint_as_float(z.x & 0xffff0000u), z2 = __uint_as_float(z.y << 16), z3 = __uint_as_float(z.y & 0xffff0000u);
      *(uint2*)(mix + mq * 1024 + 512 + qh * 64 + d0) = make_uint2(pack2(o[dt][0] * inv * silu(z0), o[dt][1] * inv * silu(z1)), pack2(o[dt][2] * inv * silu(z2), o[dt][3] * inv * silu(z3)));
    }
  }
}

__device__ void phaseF(const Params& p, int bid, int nb) {
  const int tid = threadIdx.x, wave = tid >> 6, lane = tid & 63;
  const u16* proj = (const u16*)(p.ws + OFF_PROJB);
  u16* mix = (u16*)(p.ws + OFF_XN);
  const u16* of = (const u16*)p.out;
  const u16* ob = (const u16*)((const unsigned char*)p.out + DO_OB);
  float w[8];
#pragma unroll
  for (int c = 0; c < 8; ++c) w[c] = p.out_norm_w[(lane & 15) * 8 + c];
  int m = bid * 4 + wave;
  uint4 ra = make_uint4(0u, 0u, 0u, 0u), rb = ra, rz = ra;
  if (m < M) {
    ra = *(const uint4*)(of + (size_t)m * 512 + lane * 8); rb = *(const uint4*)(ob + (size_t)m * 512 + lane * 8);
    rz = *(const uint4*)(proj + (size_t)m * LDB + B_DNZ + lane * 8);
  }
  for (; m < M; m += nb * 4) {
    const int mn = m + nb * 4;
    uint4 na = ra, nb4 = rb, nz = rz;
    if (mn < M) {
      na = *(const uint4*)(of + (size_t)mn * 512 + lane * 8); nb4 = *(const uint4*)(ob + (size_t)mn * 512 + lane * 8);
      nz = *(const uint4*)(proj + (size_t)mn * LDB + B_DNZ + lane * 8);
    }
    float a[8], b[8], z[8], y[8];
    unpack8(ra, a); unpack8(rb, b); unpack8(rz, z);
    float ss = 0.f;
#pragma unroll
    for (int c = 0; c < 8; ++c) { a[c] += b[c]; ss += a[c] * a[c]; }
    ss = sum16(ss);
    const float rstd = rsqrtf(ss * (1.f / 128.f) + EPS);
#pragma unroll
    for (int c = 0; c < 8; ++c) y[c] = a[c] * rstd * w[c] * silu(z[c]);
    *(uint4*)(mix + (size_t)m * 1024 + lane * 8) = pack8(y);
    ra = na; rb = nb4; rz = nz;
  }
}

#if MEGA
__global__ void __launch_bounds__(256, 2) k_mega(Params p) {
  __shared__ __attribute__((aligned(16))) unsigned char smem[65536];
  cg::grid_group grid = cg::this_grid();
  const int bid = blockIdx.x, nb = gridDim.x;
  __shared__ uint4 xb_words;
  if (threadIdx.x == 0) xb_words = make_uint4(0u, 0u, 0u, 0u);
  __syncthreads();
  const XcdBarrier xbar = xcd_barrier_post((unsigned*)(p.ws + OFF_BAR), (volatile unsigned*)&xb_words);
  if (p.ws == nullptr) grid.sync();
#define GBAR() xcd_barrier(xbar)
#define AMP(i, ...) do { if (AMP_SEL == (i)) { const unsigned long long t0_ = __builtin_amdgcn_s_memrealtime(); __VA_ARGS__; const unsigned long long t1_ = __builtin_amdgcn_s_memrealtime(); \
    while (__builtin_amdgcn_s_memrealtime() - t1_ < (t1_ - t0_)) __builtin_amdgcn_s_sleep(8); } else { __VA_ARGS__; } } while (0)
  AMP(0, phaseA(p, bid, nb, smem));
  GBAR();
#define DESYNC(n) do { if (bid >= (nb >> 1)) { _Pragma("unroll") for (int i_ = 0; i_ < (n); ++i_) __builtin_amdgcn_s_sleep(24); } } while (0)
  DESYNC(1);
  AMP(1, phaseB(p, bid, nb, smem));
  GBAR();
  AMP(2, phaseC(p, bid, nb, smem));
  GBAR();
  DESYNC(4);
  AMP(3, for (int t = bid; t < 2048; t += nb) prep_tile(p, t, smem));
  GBAR();
  int role = 3, ra = 0, rb = 0;
  if (nb == 512) {
    const int x = bid & 7, j = bid >> 3, xh = x >> 1;
    if ((x & 1) == 0) { if (j < 16) { role = 0; ra = xh * 4 + (j >> 2); rb = j & 3; } else if (j < 20) { role = 1; ra = xh * 4 + (j - 16); } }
    else { role = 2; ra = j * 4 + xh; rb = 256; }
  } else {
    if (bid < 64) { role = 0; ra = (bid & 7) * 2 + (bid >> 5); rb = (bid >> 3) & 3; }
    else if (bid < 80) { role = 1; ra = ((bid - 64) & 7) * 2 + ((bid - 64) >> 3); }
    else { role = 2; ra = bid - 80; rb = nb - 80; }
  }
  if (role == 0) { __builtin_amdgcn_s_setprio(3); scan_chunked(p, ra, rb, smem); __builtin_amdgcn_s_setprio(0); }
  else if (role == 1) scan_helper(p, ra);
  else if (role == 2) swa_mfma(p, ra, rb);
  GBAR();
  AMP(4, phaseF(p, bid, nb));
  GBAR();
  DESYNC(1);
  AMP(5, phaseG(p, bid, nb, smem));
}
#else
template <int PH>
__global__ void __launch_bounds__(256, 2) k_phase(Params p) {
  __shared__ __attribute__((aligned(16))) unsigned char smem[65536];
  const int bid = blockIdx.x, nb = gridDim.x;
  if (PH == 0) phaseA(p, bid, nb, smem);
  if (PH == 1) phaseB(p, bid, nb, smem);
  if (PH == 2) phaseC(p, bid, nb, smem);
  if (PH == 3) scan_chunked(p, bid >> 2, bid & 3, smem);
  if (PH == 6) swa_mfma(p, bid, nb);
  if (PH == 7) for (int t = bid; t < 2048; t += nb) prep_tile(p, t, smem);
  if (PH == 4) phaseF(p, bid, nb);
  if (PH == 5) phaseG(p, bid, nb, smem);
}
#endif

extern "C" void kernel_launch(void* const* d_in, const int* in_sizes, int n_in, void* d_out, int out_size, void* d_ws, size_t ws_size, hipStream_t stream) {
  Params p{};
  p.x = (const float*)d_in[0]; p.norm_w = (const float*)d_in[1]; p.w_in = (const float*)d_in[2]; p.conv_w = (const float*)d_in[3];
  p.a_log = (const float*)d_in[4]; p.dt_bias = (const float*)d_in[5]; p.out_norm_w = (const float*)d_in[6]; p.qnw = (const float*)d_in[7];
  p.knw = (const float*)d_in[8]; p.sinks = (const float*)d_in[9]; p.w_out = (const float*)d_in[10];
  p.out = (float*)d_out; p.ws = (unsigned char*)d_ws;
  if (ws_size < OFF_CTL_END) { fprintf(stderr, "workspace too small: %zu < %zu\n", ws_size, (size_t)OFF_END); return; }
#if MEGA
  static int grid_blocks = 0;
  if (!grid_blocks) {
    int dev = 0, cus = 0, per_cu = 0;
    hipGetDevice(&dev);
    hipDeviceGetAttribute(&cus, hipDeviceAttributeMultiprocessorCount, dev);
    hipOccupancyMaxActiveBlocksPerMultiprocessor(&per_cu, k_mega, 256, 0);
    if (per_cu > 2) per_cu = 2;
    grid_blocks = cus * per_cu;
  }
  void* args[] = {&p};
  (void)hipMemsetAsync((unsigned char*)d_ws + OFF_BAR, 0, OFF_CTL_END - OFF_BAR, stream);
  hipError_t e = hipLaunchCooperativeKernel((void*)k_mega, dim3(grid_blocks), dim3(256), args, 0, stream);
  if (e != hipSuccess) fprintf(stderr, "cooperative launch failed: %s (grid %d)\n", hipGetErrorString(e), grid_blocks);
#else
  k_phase<0><<<512, 256, 0, stream>>>(p);
  k_phase<1><<<512, 256, 0, stream>>>(p);
  k_phase<2><<<512, 256, 0, stream>>>(p);
  k_phase<7><<<512, 256, 0, stream>>>(p);
  k_phase<3><<<64, 256, 0, stream>>>(p);
  k_phase<6><<<512, 256, 0, stream>>>(p);
  k_phase<4><<<512, 256, 0, stream>>>(p);
  k_phase<5><<<512, 256, 0, stream>>>(p);
#endif
}
```

```cpp
#include <hip/hip_runtime.h>
#include <hip/hip_bf16.h>
#include <hip/hip_cooperative_groups.h>
#include <cstdio>
namespace cg = cooperative_groups;

#ifndef MEGA
#define MEGA 1
#endif
#define AMP_SEL (-1)
#define REP_A 1
#define REP_B 1
#define REP_C 1
#define REP_P 1
#define REP_S 1
#define REP_W 1
#define REP_F 1
#define REP_G 1

typedef unsigned short u16;
using bf16x8 = __attribute__((ext_vector_type(8))) short;
using f32x16 = __attribute__((ext_vector_type(16))) float;
using f32x4  = __attribute__((ext_vector_type(4))) float;
#define DI __device__ __forceinline__
#define MFMA16(a, b, c) __builtin_amdgcn_mfma_f32_16x16x32_bf16((a), (b), (c), 0, 0, 0)

constexpr int SEQ = 8192, M = 16384, D = 1024, NIN = 3344, N1 = 3328;
constexpr int C_DNQ = 0, C_DNK = 512, C_DNV = 1024, C_DNZ = 1536, C_SWQ = 2048, C_SWK = 2560, C_SWV = 2688, C_SWZ = 2816;
constexpr float EPS = 1e-6f;

constexpr int LDA = 1536, LDB = 1792;
constexpr int B_DNZ = 0, B_SWQ = 512, B_SWK = 1024, B_SWV = 1152, B_SWZ = 1280;
constexpr size_t OFF_XN   = 0;
constexpr size_t OFF_W1   = OFF_XN + (size_t)M * 1024 * 2;
constexpr size_t OFF_W2   = OFF_W1 + (size_t)N1 * 1024 * 2;
constexpr size_t OFF_BETA = OFF_W2 + (size_t)1024 * 1024 * 2;
constexpr size_t OFF_G    = OFF_BETA + (size_t)M * 8 * 4;
constexpr size_t OFF_ROPC = OFF_G + (size_t)M * 8 * 4;
constexpr size_t OFF_ROPS = OFF_ROPC + (size_t)SEQ * 32 * 4;
constexpr size_t OFF_PROJB= OFF_ROPS + (size_t)SEQ * 32 * 4;
constexpr size_t OFF_QN   = OFF_PROJB + (size_t)M * LDB * 2;
constexpr size_t OFF_KN   = OFF_QN + (size_t)M * 512 * 2;
constexpr size_t OFF_VV   = OFF_KN + (size_t)M * 512 * 2;
constexpr size_t OFF_PROJA= OFF_VV + (size_t)M * 512 * 2;
constexpr size_t OFF_PW   = OFF_PROJA;
constexpr size_t OFF_PU   = OFF_PW + (size_t)2048 * 8192 * 2;
constexpr size_t OFF_PK   = OFF_PU + (size_t)2048 * 8192 * 2;
constexpr size_t OFF_END  = OFF_PK + (size_t)2048 * 8192 * 2;
constexpr size_t DO_OB = (size_t)M * 512 * 2, DO_KR = (size_t)M * 512 * 4, DO_PA = DO_KR + (size_t)M * 128 * 4, DO_PE = DO_PA + (size_t)2048 * 4096 * 2, DO_PGL = DO_PE + (size_t)2048 * 64 * 4;
constexpr size_t DO_VT = DO_PGL + 8192;
constexpr int VT_LD = SEQ + 64;
static_assert(DO_VT + (size_t)256 * VT_LD * 2 <= (size_t)M * 1024 * 4, "d_out scratch overflow");
constexpr size_t OFF_BAR  = OFF_END;
constexpr size_t OFF_PROG = OFF_BAR + 16384;
constexpr size_t OFF_CTL_END = OFF_PROG + 16 * 256;
static_assert(OFF_CTL_END <= (size_t)256 * 1024 * 1024, "workspace overflow");

struct Params {
  const float *x, *norm_w, *w_in, *conv_w, *a_log, *dt_bias, *out_norm_w, *qnw, *knw, *sinks, *w_out;
  float* out;
  unsigned char* ws;
};

DI u16 f2bf(float x) { __bf16 r = (__bf16)x; return __builtin_bit_cast(u16, r); }
DI float bf2f(u16 v) { return __uint_as_float(((unsigned)v) << 16); }
typedef float f32x2_t __attribute__((ext_vector_type(2)));
typedef __bf16 bf16x2_t __attribute__((ext_vector_type(2)));
DI unsigned pack2(float a, float b) { f32x2_t v = {a, b}; bf16x2_t r = __builtin_convertvector(v, bf16x2_t); return __builtin_bit_cast(unsigned, r); }
template <int CTRL> DI float dpp_mov(float v) { return __int_as_float(__builtin_amdgcn_update_dpp(0, __float_as_int(v), CTRL, 0xF, 0xF, true)); }
DI float sum4(float v) { v += dpp_mov<0xB1>(v); v += dpp_mov<0x4E>(v); return v; }
DI float sum16(float v) { v = sum4(v); v += dpp_mov<0x141>(v); v += dpp_mov<0x140>(v); return v; }
DI float wave_sum(float v) {
  v = sum16(v);
  return (__int_as_float(__builtin_amdgcn_readlane(__float_as_int(v), 0)) + __int_as_float(__builtin_amdgcn_readlane(__float_as_int(v), 16))) +
         (__int_as_float(__builtin_amdgcn_readlane(__float_as_int(v), 32)) + __int_as_float(__builtin_amdgcn_readlane(__float_as_int(v), 48)));
}
DI float silu(float y) { return y * __frcp_rn(1.f + __expf(-y)); }
#define XB_TMO      128
#define XB_XCNT(j)  (256  + 64 * (j))
#define XB_XSUB(j)  (1280 + 64 * (j))
#define XB_XGEN(j)  (2304 + 64 * (j))
#define XB_TOP      3328
#define XB_TOPGEN   3392
#define XCD_BAR_WORDS 3456
#define XB_SPIN_CAP (1u << 20)
DI unsigned xb_ld(unsigned* p) { return __hip_atomic_load(p, __ATOMIC_RELAXED, __HIP_MEMORY_SCOPE_AGENT); }
DI unsigned xb_add(unsigned* p, unsigned v) { return __hip_atomic_fetch_add(p, v, __ATOMIC_RELAXED, __HIP_MEMORY_SCOPE_AGENT); }
DI unsigned xb_xcc_id() { return (unsigned)__builtin_amdgcn_s_getreg((3 << 11) | 20) & 0xFu; }
#define XB_SPIN(cond, bar) do { unsigned _sp = 0; while (cond) { __builtin_amdgcn_s_sleep(1); \
    if ((++_sp & 255u) == 0u) { if (xb_ld(&(bar)[XB_TMO])) break; if (_sp > XB_SPIN_CAP) { atomicAdd(&(bar)[XB_TMO], 1u); break; } } } } while (0)
struct XcdBarrier { unsigned* bar; unsigned x; volatile unsigned* st; };
DI XcdBarrier xcd_barrier_post(unsigned* bar, volatile unsigned* st) {
  XcdBarrier b; b.bar = bar; b.x = xb_xcc_id(); b.st = st;
  if (threadIdx.x == 0) (void)xb_add(&bar[XB_XCNT(b.x)], 1u);
  return b;
}
DI void xcd_barrier_complete(unsigned* bar, unsigned x, unsigned& nloc, unsigned& nx) {
  const unsigned G = gridDim.x;
  unsigned sum, cnt, mine, sp = 0u;
  for (;;) {
    sum = 0u; cnt = 0u; mine = 0u;
#pragma unroll
    for (unsigned j = 0; j < 16; ++j) { const unsigned c = xb_ld(&bar[XB_XCNT(j)]); sum += c; cnt += (c > 0u) ? 1u : 0u; mine = (j == x) ? c : mine; }
    if (sum == G) break;
    __builtin_amdgcn_s_sleep(1);
    if ((++sp & 255u) == 0u) { if (xb_ld(&bar[XB_TMO])) break; if (sp > XB_SPIN_CAP) { atomicAdd(&bar[XB_TMO], 1u); break; } }
  }
  nloc = mine > 0u ? mine : 1u; nx = cnt > 0u ? cnt : 1u;
}
DI void xcd_barrier(const XcdBarrier& b) {
  asm volatile("s_waitcnt vmcnt(0)" ::: "memory");
  __syncthreads();
  if (threadIdx.x == 0) {
    unsigned* bar = b.bar;
    __builtin_amdgcn_s_waitcnt(0);
    unsigned nloc = b.st[0], nx = b.st[1];
    if (nloc == 0u) { xcd_barrier_complete(bar, b.x, nloc, nx); b.st[0] = nloc; b.st[1] = nx; }
    const unsigned old = xb_add(&bar[XB_XSUB(b.x)], 1u);
    const unsigned gen = old / nloc;
    if (old + 1u == (gen + 1u) * nloc) {
      __builtin_amdgcn_fence(__ATOMIC_RELEASE, "agent");
      asm volatile("s_waitcnt vmcnt(0)" ::: "memory");
      const unsigned og = xb_add(&bar[XB_TOP], 1u);
      const unsigned tg = og / nx;
      if (og + 1u == (tg + 1u) * nx) xb_add(&bar[XB_TOPGEN], 1u);
      else XB_SPIN(xb_ld(&bar[XB_TOPGEN]) == tg, bar);
      __builtin_amdgcn_fence(__ATOMIC_ACQUIRE, "agent");
      xb_add(&bar[XB_XGEN(b.x)], 1u);
      asm volatile("s_waitcnt vmcnt(0)" ::: "memory");
    } else {
      XB_SPIN(xb_ld(&bar[XB_XGEN(b.x)]) == gen, bar);
      __builtin_amdgcn_fence(__ATOMIC_ACQUIRE, "agent");
      asm volatile("s_waitcnt vmcnt(0)" ::: "memory");
    }
  }
  __syncthreads();
}
DI int crow(int i, int h) { return (i & 3) + 8 * (i >> 2) + 4 * h; }

__device__ void phaseA(const Params& p, int bid, int nb, unsigned char* smem_raw) {
  float* smem = (float*)smem_raw;
  const int tid = threadIdx.x, wave = tid >> 6, lane = tid & 63;
#pragma unroll
  for (int i = 0; i < 4; ++i) {
    const int k = tid + 256 * i;
    const float4* src = (const float4*)(p.w_in + (size_t)k * NIN + 2048);
#pragma unroll
    for (int q = 0; q < 4; ++q) {
      const float4 v4 = src[q];
      smem[(4 * q + 0) * 1024 + k] = v4.x; smem[(4 * q + 1) * 1024 + k] = v4.y; smem[(4 * q + 2) * 1024 + k] = v4.z; smem[(4 * q + 3) * 1024 + k] = v4.w;
    }
  }
  __syncthreads();
  u16* xn = (u16*)(p.ws + OFF_XN);
  float* betaA = (float*)(p.ws + OFF_BETA);
  float* gA = (float*)(p.ws + OFF_G);
  float4 nwv[4];
#pragma unroll
  for (int i = 0; i < 4; ++i) nwv[i] = ((const float4*)p.norm_w)[lane + 64 * i];
  const float dtb = lane < 16 && lane >= 8 ? p.dt_bias[lane - 8] : 0.f;
  const float nal = lane < 16 && lane >= 8 ? -__expf(p.a_log[lane - 8]) : 0.f;
  float4 v[4], vn[4];
  int row = bid * 4 + wave;
  if (row < M) {
#pragma unroll
    for (int i = 0; i < 4; ++i) v[i] = ((const float4*)(p.x + (size_t)row * D))[lane + 64 * i];
  }
  for (; row < M; row += nb * 4) {
    const int rown = row + nb * 4;
    if (rown < M) {
#pragma unroll
      for (int i = 0; i < 4; ++i) vn[i] = ((const float4*)(p.x + (size_t)rown * D))[lane + 64 * i];
    }
    float ss = 0.f;
#pragma unroll
    for (int i = 0; i < 4; ++i) ss += v[i].x * v[i].x + v[i].y * v[i].y + v[i].z * v[i].z + v[i].w * v[i].w;
    ss = wave_sum(ss);
    const float rstd = rsqrtf(ss * (1.f / 1024.f) + EPS);
#pragma unroll
    for (int i = 0; i < 4; ++i) {
      v[i].x *= rstd * nwv[i].x; v[i].y *= rstd * nwv[i].y; v[i].z *= rstd * nwv[i].z; v[i].w *= rstd * nwv[i].w;
      uint2 pk; pk.x = pack2(v[i].x, v[i].y); pk.y = pack2(v[i].z, v[i].w);
      *(uint2*)(xn + (size_t)row * 1024 + (lane + 64 * i) * 4) = pk;
    }
    float r = 0.f;
#pragma unroll 2
    for (int j = 0; j < 16; ++j) {
      float a = 0.f;
#pragma unroll
      for (int i = 0; i < 4; ++i) {
        float4 w = *(const float4*)&smem[j * 1024 + (lane + 64 * i) * 4];
        a += v[i].x * w.x + v[i].y * w.y + v[i].z * w.z + v[i].w * w.w;
      }
      a = wave_sum(a);
      r = (lane == j) ? a : r;
    }
    if (lane < 8) betaA[(size_t)row * 8 + lane] = 1.f / (1.f + __expf(-r));
    else if (lane < 16) {
      float xx = r + dtb;
      float sp = fmaxf(xx, 0.f) + log1pf(__expf(-fabsf(xx)));
      gA[(size_t)row * 8 + lane - 8] = nal * sp;
    }
#pragma unroll
    for (int i = 0; i < 4; ++i) v[i] = vn[i];
  }
  u16* w1 = (u16*)(p.ws + OFF_W1);
  u16* w2 = (u16*)(p.ws + OFF_W2);
  const int gt = bid * 256 + tid, gs = nb * 256;
  {
    unsigned char* Lt = smem_raw;
    const int kq = tid >> 4, n4 = (tid & 15) * 4;
    for (int tile = bid; tile < 52 * 16 + 16 * 16; tile += nb) {
      const bool isw1 = tile < 52 * 16;
      const int tt = isw1 ? tile : tile - 52 * 16;
      const int n0 = isw1 ? (tt >> 4) * 64 : (tt >> 4) * 64, k0 = (tt & 15) * 64;
      const float* src = isw1 ? p.w_in + (n0 < 2048 ? n0 : n0 + 16) : p.w_out + n0;
      const int ldw = isw1 ? NIN : 1024;
      __syncthreads();
#pragma unroll
      for (int i = 0; i < 4; ++i) {
        const int kl = kq + 16 * i;
        const float4 v4 = *(const float4*)(src + (size_t)(k0 + kl) * ldw + n4);
        *(u16*)(Lt + (n4 + 0) * 144 + kl * 2) = f2bf(v4.x); *(u16*)(Lt + (n4 + 1) * 144 + kl * 2) = f2bf(v4.y);
        *(u16*)(Lt + (n4 + 2) * 144 + kl * 2) = f2bf(v4.z); *(u16*)(Lt + (n4 + 3) * 144 + kl * 2) = f2bf(v4.w);
      }
      __syncthreads();
      u16* dst = (isw1 ? w1 : w2) + (size_t)(n0 + (tid >> 2)) * 1024 + k0;
      *(uint4*)(dst + (tid & 3) * 8) = *(const uint4*)(Lt + (tid >> 2) * 144 + (tid & 3) * 16);
      *(uint4*)(dst + (tid & 3) * 8 + 32) = *(const uint4*)(Lt + (tid >> 2) * 144 + (tid & 3) * 16 + 64);
    }
  }
  float* rc = (float*)(p.ws + OFF_ROPC);
  float* rs = (float*)(p.ws + OFF_ROPS);
  for (int idx = gt; idx < SEQ * 32; idx += gs) {
    int pos = idx >> 5, i = idx & 31;
    float inv = exp2f(-(float)i * (13.287712379549449f / 32.f));
    float ang = (float)pos * inv;
    double a = (double)ang * 0.15915494309189535;
    float fr = (float)(a - rint(a));
    rc[idx] = __builtin_amdgcn_cosf(fr); rs[idx] = __builtin_amdgcn_sinf(fr);
  }
}

template <int MODE>
__device__ void gemm_tile(const Params& p, const u16* __restrict__ A, const u16* __restrict__ Bt, int K, int m0, int n0, unsigned char* smem) {
  const int tid = threadIdx.x, wave = tid >> 6, lane = tid & 63;
  const int wm = wave >> 1, wn = wave & 1, r = lane & 31, h = lane >> 5;
  unsigned char* As = smem;
  unsigned char* Bs = smem + 32768;
  f32x16 acc[2][2];
#pragma unroll
  for (int a = 0; a < 2; ++a)
#pragma unroll
    for (int b = 0; b < 2; ++b)
#pragma unroll
      for (int i = 0; i < 16; ++i) acc[a][b][i] = 0.f;
  uint4 s0a0, s0a1, s0a2, s0a3, s0b0, s0b1, s0b2, s0b3, s1a0, s1a1, s1a2, s1a3, s1b0, s1b1, s1b2, s1b3;
  const int KT = K / 64;
  const int lrow = tid >> 3, lc = tid & 7;
  const u16* gA = A + (size_t)(m0 + lrow) * K + lc * 8;
  const u16* gB = Bt + (size_t)(n0 + lrow) * K + lc * 8;
  const int loff = lrow * 128 + ((lc ^ ((lrow >> 1) & 7)) << 4);
#define GLOAD(kt_, S) { const u16* pa_ = gA + (kt_) * 64; const u16* pb_ = gB + (kt_) * 64; \
    S##a0 = *(const uint4*)(pa_); S##a1 = *(const uint4*)(pa_ + (size_t)32 * K); S##a2 = *(const uint4*)(pa_ + (size_t)64 * K); S##a3 = *(const uint4*)(pa_ + (size_t)96 * K); \
    S##b0 = *(const uint4*)(pb_); S##b1 = *(const uint4*)(pb_ + (size_t)32 * K); S##b2 = *(const uint4*)(pb_ + (size_t)64 * K); S##b3 = *(const uint4*)(pb_ + (size_t)96 * K); }
#define LSTORE(buf_, S) { unsigned char* la_ = As + (buf_) * 16384 + loff; unsigned char* lb_ = Bs + (buf_) * 16384 + loff; \
    *(uint4*)(la_) = S##a0; *(uint4*)(la_ + 4096) = S##a1; *(uint4*)(la_ + 8192) = S##a2; *(uint4*)(la_ + 12288) = S##a3; \
    *(uint4*)(lb_) = S##b0; *(uint4*)(lb_ + 4096) = S##b1; *(uint4*)(lb_ + 8192) = S##b2; *(uint4*)(lb_ + 12288) = S##b3; }
  const int rowa0 = wm * 64 + r, rowb0 = wn * 64 + r;
  const int swa0 = (rowa0 >> 1) & 7, swb0 = (rowb0 >> 1) & 7;
#define LDFRAG(buf_, ks_, AF, BF) { const int c_ = (ks_) * 2 + h; \
    AF[0] = *(const bf16x8*)(As + (buf_) * 16384 + rowa0 * 128 + ((c_ ^ swa0) << 4)); AF[1] = *(const bf16x8*)(As + (buf_) * 16384 + (rowa0 + 32) * 128 + ((c_ ^ swa0) << 4)); \
    BF[0] = *(const bf16x8*)(Bs + (buf_) * 16384 + rowb0 * 128 + ((c_ ^ swb0) << 4)); BF[1] = *(const bf16x8*)(Bs + (buf_) * 16384 + (rowb0 + 32) * 128 + ((c_ ^ swb0) << 4)); }
#define MMA4(AF, BF) { acc[0][0] = __builtin_amdgcn_mfma_f32_32x32x16_bf16(BF[0], AF[0], acc[0][0], 0, 0, 0); acc[0][1] = __builtin_amdgcn_mfma_f32_32x32x16_bf16(BF[1], AF[0], acc[0][1], 0, 0, 0); \
    acc[1][0] = __builtin_amdgcn_mfma_f32_32x32x16_bf16(BF[0], AF[1], acc[1][0], 0, 0, 0); acc[1][1] = __builtin_amdgcn_mfma_f32_32x32x16_bf16(BF[1], AF[1], acc[1][1], 0, 0, 0); }
  auto compute = [&](int buf) {
    bf16x8 afA[2], bfA[2], afB[2], bfB[2];
    LDFRAG(buf, 0, afA, bfA)
    LDFRAG(buf, 1, afB, bfB)
    __builtin_amdgcn_sched_barrier(0);
    __builtin_amdgcn_s_setprio(1);
    MMA4(afA, bfA)
    __builtin_amdgcn_sched_barrier(0);
    LDFRAG(buf, 2, afA, bfA)
    __builtin_amdgcn_sched_barrier(0);
    MMA4(afB, bfB)
    __builtin_amdgcn_sched_barrier(0);
    LDFRAG(buf, 3, afB, bfB)
    __builtin_amdgcn_sched_barrier(0);
    MMA4(afA, bfA)
    MMA4(afB, bfB)
    __builtin_amdgcn_s_setprio(0);
    __builtin_amdgcn_sched_barrier(0);
  };
  __syncthreads();
  GLOAD(0, s0) LSTORE(0, s0)
  GLOAD(1, s1)
  __syncthreads();
  for (int kt = 0; kt < KT; kt += 2) {
    { const int k2 = kt + 2 < KT ? kt + 2 : KT - 1; GLOAD(k2, s0) }
    compute(0);
    LSTORE(1, s1)
    __syncthreads();
    { const int k3 = kt + 3 < KT ? kt + 3 : KT - 1; GLOAD(k3, s1) }
    compute(1);
    if (kt + 2 < KT) { LSTORE(0, s0) }
    __syncthreads();
  }
#undef GLOAD
#undef LSTORE
  if (MODE == 0) {
#pragma unroll
    for (int a = 0; a < 2; ++a)
#pragma unroll
      for (int b = 0; b < 2; ++b)
#pragma unroll
        for (int g = 0; g < 4; ++g)
          *(uint2*)(smem + (wm * 64 + a * 32 + r) * 272 + (wn * 64 + b * 32 + 8 * g + 4 * h) * 2) = make_uint2(pack2(acc[a][b][4 * g], acc[a][b][4 * g + 1]), pack2(acc[a][b][4 * g + 2], acc[a][b][4 * g + 3]));
    __syncthreads();
    u16* dstb = n0 < 1536 ? (u16*)(p.ws + OFF_PROJA) + n0 : (u16*)(p.ws + OFF_PROJB) + (n0 - 1536);
    const int ld = n0 < 1536 ? LDA : LDB;
#pragma unroll
    for (int i = 0; i < 8; ++i) {
      const int id = tid + 256 * i, row = id >> 4, ch = id & 15;
      *(uint4*)(dstb + (size_t)(m0 + row) * ld + ch * 8) = *(const uint4*)(smem + row * 272 + ch * 16);
    }
    __syncthreads();
  } else {
    float* Cs = (float*)smem;
#pragma unroll
    for (int half = 0; half < 2; ++half) {
      if (wm == half) {
#pragma unroll
        for (int a = 0; a < 2; ++a)
#pragma unroll
          for (int b = 0; b < 2; ++b)
#pragma unroll
            for (int g = 0; g < 4; ++g)
              *(float4*)(Cs + (a * 32 + r) * 132 + wn * 64 + b * 32 + 8 * g + 4 * h) = make_float4(acc[a][b][4 * g], acc[a][b][4 * g + 1], acc[a][b][4 * g + 2], acc[a][b][4 * g + 3]);
      }
      __syncthreads();
#pragma unroll
      for (int i = 0; i < 8; ++i) {
        const int id = tid + 256 * i, row = id >> 5, ch = id & 31;
        const size_t go = (size_t)(m0 + half * 64 + row) * 1024 + n0 + ch * 4;
        const float4 xv = *(const float4*)(p.x + go);
        const float4 cv = *(const float4*)(Cs + row * 132 + ch * 4);
        *(float4*)(p.out + go) = make_float4(xv.x + cv.x, xv.y + cv.y, xv.z + cv.z, xv.w + cv.w);
      }
      __syncthreads();
    }
  }
}

__device__ void phaseB(const Params& p, int bid, int nb, unsigned char* smem) {
  const u16* xn = (const u16*)(p.ws + OFF_XN);
  const u16* w1 = (const u16*)(p.ws + OFF_W1);
  if ((nb & 7) == 0) {
    const int x = bid & 7, w = bid >> 3, per = nb >> 3;
    for (int j = w; j < 16 * 26; j += per) {
      const int g = j / 208, rem = j % 208;
      const int tn = rem >> 3, tm = x * 16 + g * 8 + (rem & 7);
      gemm_tile<0>(p, xn, w1, 1024, tm * 128, tn * 128, smem);
    }
  } else {
    for (int t = bid; t < 128 * 26; t += nb) gemm_tile<0>(p, xn, w1, 1024, (t / 26) * 128, (t % 26) * 128, smem);
  }
}
__device__ void phaseG(const Params& p, int bid, int nb, unsigned char* smem) {
  const u16* mix = (const u16*)(p.ws + OFF_XN);
  const u16* w2 = (const u16*)(p.ws + OFF_W2);
  if ((nb & 7) == 0) {
    const int x = bid & 7, w = bid >> 3, per = nb >> 3;
    for (int j = w; j < 16 * 8; j += per) {
      const int g = j >> 6, rem = j & 63;
      const int tn = rem >> 3, tm = x * 16 + g * 8 + (rem & 7);
      gemm_tile<1>(p, mix, w2, 1024, tm * 128, tn * 128, smem);
    }
  } else {
    for (int t = bid; t < 128 * 8; t += nb) gemm_tile<1>(p, mix, w2, 1024, (t >> 3) * 128, (t & 7) * 128, smem);
  }
}

DI void unpack8(const uint4 u, float* f) {
  f[0] = __uint_as_float(u.x << 16); f[1] = __uint_as_float(u.x & 0xffff0000u); f[2] = __uint_as_float(u.y << 16); f[3] = __uint_as_float(u.y & 0xffff0000u);
  f[4] = __uint_as_float(u.z << 16); f[5] = __uint_as_float(u.z & 0xffff0000u); f[6] = __uint_as_float(u.w << 16); f[7] = __uint_as_float(u.w & 0xffff0000u);
}
DI uint4 pack8(const float* f) { return make_uint4(pack2(f[0], f[1]), pack2(f[2], f[3]), pack2(f[4], f[5]), pack2(f[6], f[7])); }

__device__ void phaseC(const Params& p, int bid, int nb, unsigned char* smem) {
  const int tid = threadIdx.x, wave = tid >> 6, lane = tid & 63;
  const u16* projA = (const u16*)(p.ws + OFF_PROJA);
  const u16* projB = (const u16*)(p.ws + OFF_PROJB);
  u16* kr = (u16*)((unsigned char*)p.out + DO_KR);
  u16* vT = (u16*)((unsigned char*)p.out + DO_VT);
  u16* qr = (u16*)(p.ws + OFF_XN);
  const float* rc = (const float*)(p.ws + OFF_ROPC);
  const float* rs = (const float*)(p.ws + OFF_ROPS);
  int* wctr = (int*)smem;
  __syncthreads();
  if (tid == 0) *wctr = 0;
  __syncthreads();
  if (tid < 192) {
    const int sec = tid >> 6, ch0 = (tid & 63) * 8;
    u16* dst = (u16*)(p.ws + (sec == 0 ? OFF_QN : (sec == 1 ? OFF_KN : OFF_VV)));
    float w[5][8];
#pragma unroll
    for (int j = 0; j < 5; ++j) {
      const float4 w0 = *(const float4*)(p.conv_w + j * 1536 + sec * 512 + ch0), w1 = *(const float4*)(p.conv_w + j * 1536 + sec * 512 + ch0 + 4);
      w[j][0] = w0.x; w[j][1] = w0.y; w[j][2] = w0.z; w[j][3] = w0.w; w[j][4] = w1.x; w[j][5] = w1.y; w[j][6] = w1.z; w[j][7] = w1.w;
    }
    for (int run = bid; run < M / 32; run += nb) {
      const int m0 = run * 32, t0 = m0 & (SEQ - 1);
      auto ldraw = [&](int i) {
        const int t = t0 + i;
        uint4 u = make_uint4(0u, 0u, 0u, 0u);
        if (t >= 0 && t < SEQ) u = *(const uint4*)(projA + (size_t)(m0 + i) * LDA + sec * 512 + ch0);
        return u;
      };
      float r[5][8];
      { uint4 u0 = ldraw(-2), u1 = ldraw(-1), u2 = ldraw(0), u3 = ldraw(1); unpack8(u0, r[0]); unpack8(u1, r[1]); unpack8(u2, r[2]); unpack8(u3, r[3]); }
      uint4 pre0 = ldraw(2), pre1 = ldraw(3), pre2 = ldraw(4);
#pragma unroll 1
      for (int i = 0; i < 32; ++i) {
        unpack8(pre0, r[4]);
        pre0 = pre1; pre1 = pre2; pre2 = ldraw(i + 5 < 34 ? i + 5 : 33);
        float y[8]; float ss = 0.f;
#pragma unroll
        for (int c = 0; c < 8; ++c) {
          float a = r[0][c] * w[0][c] + r[1][c] * w[1][c] + r[2][c] * w[2][c] + r[3][c] * w[3][c] + r[4][c] * w[4][c];
          a = silu(a); y[c] = a; ss += a * a;
        }
        if (sec < 2) {
          ss = sum16(ss);
          const float f = rsqrtf(ss + EPS) * (sec == 0 ? 0.08838834764831845f : 1.f);
#pragma unroll
          for (int c = 0; c < 8; ++c) y[c] *= f;
        }
        if (sec == 0) {
          const int mm = m0 + i, tq = mm & (SEQ - 1), cq = tq & 63, chq = (ch0 & 127) >> 3;
          const size_t tileq = (size_t)(((mm >> 13) * 4 + (ch0 >> 7)) * 128 + (tq >> 6));
          *(uint4*)(dst + tileq * 8192 + (((cq >> 4) * 4 + (chq >> 2)) * 64 + (chq & 3) * 16 + (cq & 15)) * 8) = pack8(y);
        } else *(uint4*)(dst + (size_t)(m0 + i) * 512 + ch0) = pack8(y);
#pragma unroll
        for (int j = 0; j < 4; ++j)
#pragma unroll
          for (int c = 0; c < 8; ++c) r[j][c] = r[j + 1][c];
      }
    }
  }
  const int nitems = M / 2 + M / 8, ipw = (nitems + nb - 1) / nb;
  for (;;) {
    int it = 0;
    if (lane == 0) it = atomicAdd(wctr, 1);
    it = __shfl(it, 0);
    const int item = bid * ipw + it;
    if (it >= ipw || item >= nitems) break;
    const bool isk = item >= M / 2;
    const int j = lane & 3;
    int m, head;
    if (!isk) { m = item * 2 + (lane >> 5); head = (lane >> 2) & 7; }
    else      { m = (item - M / 2) * 8 + (lane >> 3); head = (lane >> 2) & 1; }
    const int t = m & (SEQ - 1);
    const u16* src = projB + (size_t)m * LDB + (isk ? B_SWK : B_SWQ) + head * 64 + 8 * j;
    float lo[8], hi[8];
    unpack8(*(const uint4*)src, lo); unpack8(*(const uint4*)(src + 32), hi);
    float ss = 0.f;
#pragma unroll
    for (int c = 0; c < 8; ++c) ss += lo[c] * lo[c] + hi[c] * hi[c];
    ss = sum4(ss);
    const float rstd = rsqrtf(ss * (1.f / 64.f) + EPS) * (isk ? 1.f : 0.125f);
    const float* nw = isk ? p.knw : p.qnw;
    float olo[8], ohi[8];
#pragma unroll
    for (int c = 0; c < 8; ++c) {
      const float y0 = lo[c] * rstd * nw[8 * j + c], y1 = hi[c] * rstd * nw[32 + 8 * j + c];
      const float cs = rc[t * 32 + 8 * j + c], sn = rs[t * 32 + 8 * j + c];
      olo[c] = y0 * cs - y1 * sn; ohi[c] = y1 * cs + y0 * sn;
    }
    if (isk) {
      u16* dst = kr + ((size_t)(((m >> 13) * 2 + head) * 512 + (t >> 4)) * 2) * 512 + (j * 16 + (t & 15)) * 8;
      *(uint4*)dst = pack8(olo); *(uint4*)(dst + 512) = pack8(ohi);
    } else {
      u16* dst = qr + (size_t)m * 1024 + head * 64 + 8 * j;
      *(uint4*)dst = pack8(olo); *(uint4*)(dst + 32) = pack8(ohi);
    }
  }
  for (int it = bid * 256 + tid; it < 128 * (M / 8); it += nb * 256) {
    const int c = it & 127, m0 = (it >> 7) * 8;
    const int b = m0 >> 13, t0 = m0 & (SEQ - 1);
    const u16* src = projB + (size_t)m0 * LDB + B_SWV + c;
    unsigned pk[4];
#pragma unroll
    for (int i = 0; i < 4; ++i) pk[i] = (unsigned)src[(size_t)(2 * i) * LDB] | ((unsigned)src[(size_t)(2 * i + 1) * LDB] << 16);
    u16* dst = vT + ((size_t)(((b * 2 + (c >> 6)) * 512 + (t0 >> 4)) * 4 + ((c & 63) >> 4)) * 64 + ((t0 >> 2) & 3) * 16 + (c & 15)) * 4;
    *(uint2*)dst = make_uint2(pk[0], pk[1]);
    *(uint2*)(dst + 64) = make_uint2(pk[2], pk[3]);
  }
}

__device__ void prep_tile(const Params& p, int tile, unsigned char* smem) {
  int tid_ = threadIdx.x;
  asm volatile("" : "+v"(tid_));
  const int tid = tid_, wave = __builtin_amdgcn_readfirstlane(tid >> 6), lane = tid & 63;
  const int dir = tile & 1, n = (tile >> 1) & 127, bh = tile >> 8, b = bh >> 2, hh = bh & 3;
  unsigned char* ksb = smem;
  unsigned char* qsb = smem + 17408;
  float* Ms = (float*)(smem + 34816);
  float* gc = (float*)(smem + 51200);
  float* bt = gc + 64;
  float* cw = (float*)(smem + 64000);
  float* cd = (float*)(smem + 64256);
  const u16* qn = (const u16*)(p.ws + OFF_QN);
  const u16* kn = (const u16*)(p.ws + OFF_KN);
  const u16* vv = (const u16*)(p.ws + OFF_VV);
  const float* betaA = (const float*)(p.ws + OFF_BETA);
  const float* gA = (const float*)(p.ws + OFF_G);
  u16* pw = (u16*)(p.ws + OFF_PW) + (size_t)tile * 8192;
  u16* pu = (u16*)(p.ws + OFF_PU) + (size_t)tile * 8192;
  u16* pk = (u16*)(p.ws + OFF_PK) + (size_t)tile * 8192;
  u16* pa = (u16*)((unsigned char*)p.out + DO_PA) + (size_t)tile * 4096;
  float* pe = (float*)((unsigned char*)p.out + DO_PE) + (size_t)tile * 64;
  float* pgl = (float*)((unsigned char*)p.out + DO_PGL);
  const size_t row0 = (size_t)b * SEQ + n * 64;
  __syncthreads();
#pragma unroll
  for (int i = 0; i < 4; ++i) {
    int id = tid + 256 * i, c = id >> 4, ch = id & 15;
    int tok = dir ? 63 - c : c;
    *(uint4*)(ksb + c * 272 + ch * 16) = *(const uint4*)(kn + (row0 + tok) * 512 + hh * 128 + ch * 8);
    *(uint4*)(qsb + c * 272 + ch * 16) = *(const uint4*)(qn + (size_t)(bh * 128 + n) * 8192 + (((tok >> 4) * 4 + (ch >> 2)) * 64 + (ch & 3) * 16 + (tok & 15)) * 8);
  }
  if (wave == 0) {
    int tok = dir ? 63 - lane : lane;
    float g = gA[(row0 + tok) * 8 + dir * 4 + hh];
    float bb = betaA[(row0 + tok) * 8 + dir * 4 + hh];
#pragma unroll
    for (int o = 1; o < 64; o <<= 1) { float t = __shfl_up(g, o); if (lane >= o) g += t; }
    gc[lane] = g; bt[lane] = bb;
    const float eg_ = __expf(g);
    pe[lane] = eg_;
    if (lane == 63) pgl[tile] = eg_;
    cw[lane] = bb * eg_;
    cd[lane] = __expf(__shfl(g, 63) - g);
  }
  __syncthreads();
  {
    const int row = lane & 15, quad = lane >> 4;
    bf16x8 ak[4], aq[4];
#pragma unroll
    for (int k = 0; k < 4; ++k) {
      ak[k] = *(const bf16x8*)(ksb + (16 * wave + row) * 272 + k * 64 + quad * 16);
      aq[k] = *(const bf16x8*)(qsb + (16 * wave + row) * 272 + k * 64 + quad * 16);
    }
#pragma unroll
    for (int tc = 0; tc < 4; ++tc) {
      f32x4 ckk = {0.f, 0.f, 0.f, 0.f}, cqk = {0.f, 0.f, 0.f, 0.f};
#pragma unroll
      for (int k = 0; k < 4; ++k) {
        bf16x8 bk = *(const bf16x8*)(ksb + (16 * tc + row) * 272 + k * 64 + quad * 16);
        ckk = MFMA16(ak[k], bk, ckk);
        cqk = MFMA16(aq[k], bk, cqk);
      }
      const int s = 16 * tc + row;
      const float gs = gc[s];
#pragma unroll
      for (int j = 0; j < 4; ++j) {
        const int c = 16 * wave + quad * 4 + j;
        float dec = __expf(fminf(gc[c] - gs, 0.f));
        float mval = (s < c) ? bt[c] * ckk[j] * dec : 0.f;
        float aval = (s <= c) ? cqk[j] * dec : 0.f;
        Ms[c * 64 + s] = mval;
        *(u16*)(smem + 51712 + ((((c >> 4) * 2 + (s >> 5)) * 64 + ((s >> 3) & 3) * 16 + (c & 15)) * 8 + (s & 7)) * 2) = f2bf(aval);
      }
    }
  }
  {
    const int dk = tid & 127, half = tid >> 7;
    const float gl = gc[63];
    unsigned pkd[16];
#pragma unroll
    for (int i = 0; i < 16; ++i) {
      int c0 = half * 32 + 2 * i;
      float k0 = bf2f(*(const u16*)(ksb + c0 * 272 + dk * 2)) * cd[c0];
      float k1 = bf2f(*(const u16*)(ksb + (c0 + 1) * 272 + dk * 2)) * cd[c0 + 1];
      pkd[i] = pack2(k0, k1);
    }
#pragma unroll
    for (int i = 0; i < 4; ++i) {
      const int cc = half * 4 + i;
      *(uint4*)(pk + ((((dk >> 5) * 2 + ((dk >> 4) & 1)) * 2 + (cc >> 2)) * 64 + (cc & 3) * 16 + (dk & 15)) * 8) = make_uint4(pkd[4 * i], pkd[4 * i + 1], pkd[4 * i + 2], pkd[4 * i + 3]);
    }
  }
  __syncthreads();
  {
    const uint4* src = (const uint4*)(smem + 51712);
    ((uint4*)pa)[tid] = src[tid];
    ((uint4*)pa)[tid + 256] = src[tid + 256];
  }
  float x[64];
  if (tid < 128) {
#pragma unroll
    for (int c = 0; c < 64; ++c) { int tok = dir ? 63 - c : c; x[c] = bt[c] * bf2f(vv[(row0 + tok) * 512 + hh * 128 + tid]); }
  } else {
#pragma unroll
    for (int c = 0; c < 64; ++c) x[c] = cw[c] * bf2f(*(const u16*)(ksb + c * 272 + (tid - 128) * 2));
  }
  __syncthreads();
  unsigned char* xs = smem;
  unsigned char* ys = smem + 51712;
  {
    const int row = lane & 15, quad = lane >> 4;
#pragma unroll
    for (int I = 0; I < 4; ++I) {
      asm volatile("" ::: "memory");
      if (I > 0) {
        f32x4 yacc[4];
#pragma unroll
        for (int nt = 0; nt < 4; ++nt) yacc[nt] = f32x4{0.f, 0.f, 0.f, 0.f};
#pragma unroll
        for (int ks = 0; ks < (16 * I + 31) / 32; ++ks) {
          const bool live = (ks * 32 + quad * 8) < 16 * I;
          const float4 m0 = *(const float4*)(Ms + (16 * I + row) * 64 + ks * 32 + quad * 8);
          const float4 m1 = *(const float4*)(Ms + (16 * I + row) * 64 + ks * 32 + quad * 8 + 4);
          union { bf16x8 v; unsigned u[4]; } af;
          af.u[0] = live ? pack2(m0.x, m0.y) : 0u; af.u[1] = live ? pack2(m0.z, m0.w) : 0u;
          af.u[2] = live ? pack2(m1.x, m1.y) : 0u; af.u[3] = live ? pack2(m1.z, m1.w) : 0u;
          const int qe = live ? quad : (quad & 1);
#pragma unroll
          for (int nt = 0; nt < 4; ++nt) {
            const bf16x8 bx = *(const bf16x8*)(xs + (64 * wave + 16 * nt + row) * 112 + (ks * 32 + qe * 8) * 2);
            yacc[nt] = MFMA16(af.v, bx, yacc[nt]);
          }
        }
#pragma unroll
        for (int nt = 0; nt < 4; ++nt)
          *(uint2*)(ys + (64 * wave + 16 * nt + row) * 48 + quad * 8) = make_uint2(pack2(yacc[nt][0], yacc[nt][1]), pack2(yacc[nt][2], yacc[nt][3]));
        const uint4 y0 = *(const uint4*)(ys + tid * 48), y1 = *(const uint4*)(ys + tid * 48 + 16);
        const unsigned yy[8] = {y0.x, y0.y, y0.z, y0.w, y1.x, y1.y, y1.z, y1.w};
#pragma unroll
        for (int r = 0; r < 16; ++r) x[16 * I + r] -= (r & 1) ? __uint_as_float(yy[r >> 1] & 0xffff0000u) : __uint_as_float(yy[r >> 1] << 16);
      }
      int mrow[16];
#pragma unroll
      for (int r = 1; r < 16; ++r) mrow[r] = __float_as_int(Ms[(16 * I + r) * 64 + lane]);
#pragma unroll
      for (int r = 1; r < 16; ++r) {
        float a0 = 0.f, a1 = 0.f;
#pragma unroll
        for (int sidx = 0; sidx < r; ++sidx) {
          const float m = __int_as_float(__builtin_amdgcn_readlane(mrow[r], 16 * I + sidx));
          if (sidx & 1) a1 = fmaf(m, x[16 * I + sidx], a1); else a0 = fmaf(m, x[16 * I + sidx], a0);
        }
        x[16 * I + r] -= a0 + a1;
      }
      if (I < 3) {
#pragma unroll
        for (int i = 0; i < 2; ++i)
          *(uint4*)(xs + tid * 112 + I * 32 + i * 16) = make_uint4(pack2(x[16 * I + 8 * i], x[16 * I + 8 * i + 1]), pack2(x[16 * I + 8 * i + 2], x[16 * I + 8 * i + 3]),
                                                                 pack2(x[16 * I + 8 * i + 4], x[16 * I + 8 * i + 5]), pack2(x[16 * I + 8 * i + 6], x[16 * I + 8 * i + 7]));
      }
    }
  }
  __syncthreads();
  if (tid < 128) {
#pragma unroll
    for (int g = 0; g < 16; ++g)
      *(uint2*)(pu + (((((tid >> 5) * 2 + ((tid >> 4) & 1)) * 4 + (g >> 2)) * 64 + (g & 3) * 16 + (tid & 15)) * 4)) = make_uint2(pack2(x[4 * g], x[4 * g + 1]), pack2(x[4 * g + 2], x[4 * g + 3]));
  } else {
#pragma unroll
    for (int c = 0; c < 64; ++c) *(u16*)(qsb + c * 272 + (tid - 128) * 2) = f2bf(-x[c]);
  }
  __syncthreads();
#pragma unroll
  for (int i = 0; i < 4; ++i) {
    const int d = tid + 256 * i;
    const int c = (d >> 8) * 16 + (d & 15), ch = ((d >> 6) & 3) * 4 + ((d >> 4) & 3);
    *(uint4*)(pw + d * 8) = *(const uint4*)(qsb + c * 272 + ch * 16);
  }
}

struct ScanEarly { bf16x8 aw[4]; uint2 u[2]; };
struct ScanFrags { bf16x8 aq[4], aa[2], akd[2][2]; float eg; float egl; };
__device__ void scan_chunked(const Params& p, int chain, int slab, unsigned char* smem) {
  const int tid = threadIdx.x, wave = tid >> 6, lane = tid & 63, row = lane & 15, quad = lane >> 4;
  const int dv0 = slab * 32;
  const int b = chain >> 3, hh = (chain >> 1) & 3, dir = chain & 1;
  unsigned* prog = (unsigned*)(p.ws + OFF_PROG) + chain * 64;
  const bool publisher = (dv0 == 0) && (tid == 0);
  unsigned char* Sl = smem;
  unsigned char* Vl = smem + 8704;
  const u16* qn = (const u16*)(p.ws + OFF_QN);
  const u16* pwA = (const u16*)(p.ws + OFF_PW);
  const u16* puA = (const u16*)(p.ws + OFF_PU);
  const u16* pkA = (const u16*)(p.ws + OFF_PK);
  const u16* paA = (const u16*)((unsigned char*)p.out + DO_PA);
  const float* peA = (const float*)((unsigned char*)p.out + DO_PE);
  const float* pglA = (const float*)((unsigned char*)p.out + DO_PGL);
  u16* ob = (u16*)((unsigned char*)p.out + (dir ? DO_OB : 0));
#pragma unroll 1
  for (int rep = 0; rep < REP_S; ++rep) {
  __syncthreads();
  for (int i = tid; i < 8704 / 4; i += 256) ((unsigned*)Sl)[i] = 0u;
  f32x4 Sacc[2][2];
#pragma unroll
  for (int a = 0; a < 2; ++a)
#pragma unroll
    for (int c = 0; c < 2; ++c) Sacc[a][c] = f32x4{0.f, 0.f, 0.f, 0.f};
  auto gloadE = [&](ScanEarly& e, int step) {
    const int n = dir ? 127 - step : step;
    const size_t tile = ((size_t)(b * 4 + hh) * 128 + n) * 2 + dir;
#pragma unroll
    for (int k = 0; k < 4; ++k) e.aw[k] = *(const bf16x8*)(pwA + tile * 8192 + ((wave * 4 + k) * 64 + lane) * 8);
#pragma unroll
    for (int nt = 0; nt < 2; ++nt) e.u[nt] = *(const uint2*)(puA + tile * 8192 + ((((dv0 >> 5) * 2 + nt) * 4 + wave) * 64 + lane) * 4);
  };
  auto gload = [&](ScanFrags& f, int step) {
    const int n = dir ? 127 - step : step;
    const size_t tile = ((size_t)(b * 4 + hh) * 128 + n) * 2 + dir;
    const int c = 16 * wave + row;
    const size_t qtile = (size_t)((b * 4 + hh) * 128 + n) * 8192;
    const int qlane = dir ? quad * 16 + (15 - row) : lane, qw = dir ? 3 - wave : wave;
#pragma unroll
    for (int k = 0; k < 4; ++k) f.aq[k] = *(const bf16x8*)(qn + qtile + ((qw * 4 + k) * 64 + qlane) * 8);
#pragma unroll
    for (int k = 0; k < 2; ++k) {
      f.aa[k] = *(const bf16x8*)(paA + tile * 4096 + ((wave * 2 + k) * 64 + lane) * 8);
#pragma unroll
      for (int d = 0; d < 2; ++d) f.akd[d][k] = *(const bf16x8*)(pkA + tile * 8192 + (((wave * 2 + d) * 2 + k) * 64 + lane) * 8);
    }
    f.eg = peA[tile * 64 + c];
    f.egl = pglA[tile];
  };
  auto body = [&](ScanEarly& e, ScanEarly& en2, ScanFrags& f, ScanFrags& fn, int step) {
    if (publisher) __hip_atomic_store(prog, (unsigned)(step + 1), __ATOMIC_RELAXED, __HIP_MEMORY_SCOPE_AGENT);
    if (step + 2 < 128) gloadE(en2, step + 2);
    if (step + 1 < 128) gload(fn, step + 1);
    bf16x8 bS[4][2];
#pragma unroll
    for (int k = 0; k < 4; ++k)
#pragma unroll
      for (int nt = 0; nt < 2; ++nt) bS[k][nt] = *(const bf16x8*)(Sl + (nt * 16 + row) * 272 + k * 64 + quad * 16);
    f32x4 vacc[2], oacc[2];
#pragma unroll
    for (int nt = 0; nt < 2; ++nt) {
      vacc[nt] = f32x4{__uint_as_float(e.u[nt].x << 16), __uint_as_float(e.u[nt].x & 0xffff0000u), __uint_as_float(e.u[nt].y << 16), __uint_as_float(e.u[nt].y & 0xffff0000u)};
#pragma unroll
      for (int k = 0; k < 4; ++k) vacc[nt] = MFMA16(e.aw[k], bS[k][nt], vacc[nt]);
      *(uint2*)(Vl + (nt * 16 + row) * 144 + (16 * wave + quad * 4) * 2) = make_uint2(pack2(vacc[nt][0], vacc[nt][1]), pack2(vacc[nt][2], vacc[nt][3]));
    }
    asm volatile("s_waitcnt lgkmcnt(0)\n\ts_barrier" ::: "memory");
#pragma unroll
    for (int nt = 0; nt < 2; ++nt) {
      oacc[nt] = f32x4{0.f, 0.f, 0.f, 0.f};
#pragma unroll
      for (int k = 0; k < 4; ++k) oacc[nt] = MFMA16(bS[k][nt], f.aq[k], oacc[nt]);
      oacc[nt] *= f.eg;
    }
    bf16x8 bV[2][2];
#pragma unroll
    for (int k = 0; k < 2; ++k)
#pragma unroll
      for (int nt = 0; nt < 2; ++nt) bV[k][nt] = *(const bf16x8*)(Vl + (nt * 16 + row) * 144 + k * 64 + quad * 16);
#pragma unroll
    for (int d = 0; d < 2; ++d)
#pragma unroll
      for (int nt = 0; nt < 2; ++nt) {
        Sacc[d][nt] *= f.egl;
#pragma unroll
        for (int k = 0; k < 2; ++k) Sacc[d][nt] = MFMA16(f.akd[d][k], bV[k][nt], Sacc[d][nt]);
        *(uint2*)(Sl + (nt * 16 + row) * 272 + (32 * wave + 16 * d + quad * 4) * 2) = make_uint2(pack2(Sacc[d][nt][0], Sacc[d][nt][1]), pack2(Sacc[d][nt][2], Sacc[d][nt][3]));
      }
    const int n = dir ? 127 - step : step;
#pragma unroll
    for (int nt = 0; nt < 2; ++nt) {
#pragma unroll
      for (int k = 0; k < 2; ++k) oacc[nt] = MFMA16(bV[k][nt], f.aa[k], oacc[nt]);
      const int c = 16 * wave + row;
      const int tok = dir ? 63 - c : c;
      *(uint2*)(ob + ((size_t)b * SEQ + n * 64 + tok) * 512 + hh * 128 + dv0 + nt * 16 + quad * 4) = make_uint2(pack2(oacc[nt][0], oacc[nt][1]), pack2(oacc[nt][2], oacc[nt][3]));
    }
    asm volatile("s_waitcnt lgkmcnt(0)\n\ts_barrier" ::: "memory");
  };
  ScanEarly e0, e1, e2;
  ScanFrags f0, f1;
  gloadE(e0, 0); gloadE(e1, 1);
  gload(f0, 0);
  __syncthreads();
#pragma unroll 1
  for (int step = 0; step < 126; step += 6) {
    body(e0, e2, f0, f1, step);
    body(e1, e0, f1, f0, step + 1);
    body(e2, e1, f0, f1, step + 2);
    body(e0, e2, f1, f0, step + 3);
    body(e1, e0, f0, f1, step + 4);
    body(e2, e1, f1, f0, step + 5);
  }
  body(e0, e2, f0, f1, 126);
  body(e1, e0, f1, f0, 127);
  }
}

constexpr int PF_DEPTH = 24, PF_BATCH = 8;
__device__ void scan_helper(const Params& p, int chain) {
  const int tid = threadIdx.x;
  const int b = chain >> 3, hh = (chain >> 1) & 3, dir = chain & 1;
  unsigned* prog = (unsigned*)(p.ws + OFF_PROG) + chain * 64;
  const unsigned char* pw = p.ws + OFF_PW;
  const unsigned char* pu = p.ws + OFF_PU;
  const unsigned char* pk = p.ws + OFF_PK;
  const unsigned char* pa = (const unsigned char*)p.out + DO_PA;
  const unsigned char* pe = (const unsigned char*)p.out + DO_PE;
  const unsigned char* qn = p.ws + OFF_QN;
  unsigned acc = 0u;
  int cur = 1;
#pragma unroll 1
  while (cur < 128) {
    const int done = (int)__hip_atomic_load(prog, __ATOMIC_RELAXED, __HIP_MEMORY_SCOPE_AGENT);
    if (done >= 127) break;
    if (cur < done + 1) cur = done + 1;
    const int lim = done + PF_DEPTH < 128 ? done + PF_DEPTH : 128;
    if (cur >= lim) { __builtin_amdgcn_s_sleep(4); continue; }
    unsigned v[PF_BATCH][3];
#pragma unroll
    for (int i = 0; i < PF_BATCH; ++i) {
      const int st = cur + i < lim ? cur + i : lim - 1;
      const int n = dir ? 127 - st : st;
      const size_t tile = ((size_t)(b * 4 + hh) * 128 + n) * 2 + dir;
      const unsigned char* a0 = (tid < 128) ? pw + tile * 16384 + tid * 128 : pu + tile * 16384 + (tid - 128) * 128;
      const unsigned char* a1 = (tid < 128) ? pk + tile * 16384 + tid * 128 : (tid < 192 ? pa + tile * 8192 + (tid - 128) * 128 : pe + tile * 256 + (tid & 1) * 128);
      const unsigned char* a2 = qn + (size_t)((b * 4 + hh) * 128 + n) * 16384 + (tid & 127) * 128;
      v[i][0] = *(const unsigned*)a0; v[i][1] = *(const unsigned*)a1; v[i][2] = *(const unsigned*)a2;
    }
#pragma unroll
    for (int i = 0; i < PF_BATCH; ++i) acc ^= v[i][0] ^ v[i][1] ^ v[i][2];
    cur = cur + PF_BATCH < lim ? cur + PF_BATCH : lim;
  }
  if (acc == 0x9e3779b9u && p.ws == nullptr) *(unsigned*)p.out = acc;
}

__device__ void swa_mfma(const Params& p, int bid, int nb) {
  const int wave = threadIdx.x >> 6, lane = threadIdx.x & 63, col = lane & 15, quad = lane >> 4;
  const u16* kr = (const u16*)((const unsigned char*)p.out + DO_KR);
  const u16* vT = (const u16*)((const unsigned char*)p.out + DO_VT);
  const u16* qr = (const u16*)(p.ws + OFF_XN);
  const u16* projB = (const u16*)(p.ws + OFF_PROJB);
  u16* mix = (u16*)(p.ws + OFF_XN);
  const int upw = (2048 + nb - 1) / nb;
  for (int unit = bid * upw; unit < (bid + 1) * upw && unit < 2048; ++unit) {
    const int qblk = unit & 511, kvh = (unit >> 9) & 1, b = unit >> 10;
    const int t0 = qblk * 16, qh = kvh * 4 + wave;
    const size_t mq = (size_t)b * SEQ + t0 + col;
    bf16x8 bq[2];
#pragma unroll
    for (int ks = 0; ks < 2; ++ks) bq[ks] = *(const bf16x8*)(qr + mq * 1024 + qh * 64 + ks * 32 + quad * 8);
    f32x4 sc[18];
    const int kb0 = (t0 >> 4) - 8;
    const u16* kbase = kr + (size_t)((b * 2 + kvh) * 512) * 1024 + lane * 8;
#pragma unroll
    for (int kt = 0; kt < 18; ++kt) {
      int kb = kb0 + kt; kb = kb < 0 ? 0 : (kb > 511 ? 511 : kb);
      const bf16x8 a0 = *(const bf16x8*)(kbase + (size_t)kb * 1024), a1 = *(const bf16x8*)(kbase + (size_t)kb * 1024 + 512);
      f32x4 c = {0.f, 0.f, 0.f, 0.f};
      c = MFMA16(a0, bq[0], c);
      c = MFMA16(a1, bq[1], c);
      sc[kt] = c;
    }
    const float sink = p.sinks[qh];
    float mx = sink;
#pragma unroll
    for (int kt = 0; kt < 18; ++kt)
#pragma unroll
      for (int jj = 0; jj < 4; ++jj) {
        const int key = t0 - 128 + 16 * kt + quad * 4 + jj;
        const int rel = key - (t0 + col);
        const bool valid = (rel >= -128) && (rel <= 128) && (key >= 0) && (key < SEQ);
        float v = valid ? sc[kt][jj] : -1e30f;
        sc[kt][jj] = v;
        mx = fmaxf(mx, v);
      }
    mx = fmaxf(mx, __shfl_xor(mx, 16));
    mx = fmaxf(mx, __shfl_xor(mx, 32));
    float l = 0.f;
#pragma unroll
    for (int kt = 0; kt < 18; ++kt)
#pragma unroll
      for (int jj = 0; jj < 4; ++jj) { float e = __expf(sc[kt][jj] - mx); sc[kt][jj] = e; l += e; }
    l += __shfl_xor(l, 16);
    l += __shfl_xor(l, 32);
    l += __expf(sink - mx);
    f32x4 o[4];
#pragma unroll
    for (int dt = 0; dt < 4; ++dt) o[dt] = f32x4{0.f, 0.f, 0.f, 0.f};
    bf16x8 bp[9];
#pragma unroll
    for (int kg = 0; kg < 9; ++kg) {
      union { bf16x8 v; unsigned u[4]; } t;
      t.u[0] = pack2(sc[2 * kg][0], sc[2 * kg][1]); t.u[1] = pack2(sc[2 * kg][2], sc[2 * kg][3]);
      t.u[2] = pack2(sc[2 * kg + 1][0], sc[2 * kg + 1][1]); t.u[3] = pack2(sc[2 * kg + 1][2], sc[2 * kg + 1][3]);
      bp[kg] = t.v;
    }
    const u16* vbase = vT + (size_t)((b * 2 + kvh) * 512) * 1024 + lane * 4;
#pragma unroll
    for (int hb = 0; hb < 2; ++hb) {
      uint2 av[5][4][2];
#pragma unroll
      for (int i = 0; i < 5; ++i) {
        const int kg = hb * 5 + i;
        if (kg < 9) {
          int b0 = kb0 + 2 * kg, b1 = b0 + 1;
          b0 = b0 < 0 ? 0 : (b0 > 511 ? 511 : b0); b1 = b1 < 0 ? 0 : (b1 > 511 ? 511 : b1);
#pragma unroll
          for (int dt = 0; dt < 4; ++dt) {
            av[i][dt][0] = *(const uint2*)(vbase + ((size_t)b0 * 4 + dt) * 256);
            av[i][dt][1] = *(const uint2*)(vbase + ((size_t)b1 * 4 + dt) * 256);
          }
        }
      }
      __builtin_amdgcn_sched_barrier(0);
#pragma unroll
      for (int i = 0; i < 5; ++i) {
        const int kg = hb * 5 + i;
        if (kg < 9) {
#pragma unroll
          for (int dt = 0; dt < 4; ++dt) {
            union { bf16x8 v; unsigned u[4]; } a;
            a.u[0] = av[i][dt][0].x; a.u[1] = av[i][dt][0].y; a.u[2] = av[i][dt][1].x; a.u[3] = av[i][dt][1].y;
            o[dt] = MFMA16(a.v, bp[kg], o[dt]);
          }
        }
      }
      __builtin_amdgcn_sched_barrier(0);
    }
    const float inv = __frcp_rn(l);
#pragma unroll
    for (int dt = 0; dt < 4; ++dt) {
      const int d0 = dt * 16 + quad * 4;
      uint2 z = *(const uint2*)(projB + mq * LDB + B_SWZ + qh * 64 + d0);
      float z0 = __uint_as_float(z.x << 16), z1 = __uint_as_float(z.x & 0xffff0000u), z2 = __uint_as_float(z.y << 16), z3 = __uint_as_float(z.y & 0xffff0000u);
      *(uint2*)(mix + mq * 1024 + 512 + qh * 64 + d0) = make_uint2(pack2(o[dt][0] * inv * silu(z0), o[dt][1] * inv * silu(z1)), pack2(o[dt][2] * inv * silu(z2), o[dt][3] * inv * silu(z3)));
    }
  }
}

__device__ void phaseF(const Params& p, int bid, int nb) {
  const int tid = threadIdx.x, wave = tid >> 6, lane = tid & 63;
  const u16* proj = (const u16*)(p.ws + OFF_PROJB);
  u16* mix = (u16*)(p.ws + OFF_XN);
  const u16* of = (const u16*)p.out;
  const u16* ob = (const u16*)((const unsigned char*)p.out + DO_OB);
  float w[8];
#pragma unroll
  for (int c = 0; c < 8; ++c) w[c] = p.out_norm_w[(lane & 15) * 8 + c];
  int m = bid * 4 + wave;
  uint4 ra = make_uint4(0u, 0u, 0u, 0u), rb = ra, rz = ra;
  if (m < M) {
    ra = *(const uint4*)(of + (size_t)m * 512 + lane * 8); rb = *(const uint4*)(ob + (size_t)m * 512 + lane * 8);
    rz = *(const uint4*)(proj + (size_t)m * LDB + B_DNZ + lane * 8);
  }
  for (; m < M; m += nb * 4) {
    const int mn = m + nb * 4;
    uint4 na = ra, nb4 = rb, nz = rz;
    if (mn < M) {
      na = *(const uint4*)(of + (size_t)mn * 512 + lane * 8); nb4 = *(const uint4*)(ob + (size_t)mn * 512 + lane * 8);
      nz = *(const uint4*)(proj + (size_t)mn * LDB + B_DNZ + lane * 8);
    }
    float a[8], b[8], z[8], y[8];
    unpack8(ra, a); unpack8(rb, b); unpack8(rz, z);
    float ss = 0.f;
#pragma unroll
    for (int c = 0; c < 8; ++c) { a[c] += b[c]; ss += a[c] * a[c]; }
    ss = sum16(ss);
    const float rstd = rsqrtf(ss * (1.f / 128.f) + EPS);
#pragma unroll
    for (int c = 0; c < 8; ++c) y[c] = a[c] * rstd * w[c] * silu(z[c]);
    *(uint4*)(mix + (size_t)m * 1024 + lane * 8) = pack8(y);
    ra = na; rb = nb4; rz = nz;
  }
}

#if MEGA
__global__ void __launch_bounds__(256, 2) k_mega(Params p) {
  __shared__ __attribute__((aligned(16))) unsigned char smem[65536];
  cg::grid_group grid = cg::this_grid();
  const int bid = blockIdx.x, nb = gridDim.x;
  __shared__ uint4 xb_words;
  if (threadIdx.x == 0) xb_words = make_uint4(0u, 0u, 0u, 0u);
  __syncthreads();
  const XcdBarrier xbar = xcd_barrier_post((unsigned*)(p.ws + OFF_BAR), (volatile unsigned*)&xb_words);
  if (p.ws == nullptr) grid.sync();
#define GBAR() xcd_barrier(xbar)
#define AMP(i, ...) do { if (AMP_SEL == (i)) { const unsigned long long t0_ = __builtin_amdgcn_s_memrealtime(); __VA_ARGS__; const unsigned long long t1_ = __builtin_amdgcn_s_memrealtime(); \
    while (__builtin_amdgcn_s_memrealtime() - t1_ < (t1_ - t0_)) __builtin_amdgcn_s_sleep(8); } else { __VA_ARGS__; } } while (0)
  AMP(0, phaseA(p, bid, nb, smem));
  GBAR();
  AMP(1, phaseB(p, bid, nb, smem));
  GBAR();
  AMP(2, phaseC(p, bid, nb, smem));
  GBAR();
  AMP(3, for (int t = bid; t < 2048; t += nb) prep_tile(p, t, smem));
  GBAR();
  int role = 3, ra = 0, rb = 0;
  if (nb == 512) {
    const int x = bid & 7, j = bid >> 3, xh = x >> 1;
    if ((x & 1) == 0) { if (j < 16) { role = 0; ra = xh * 4 + (j >> 2); rb = j & 3; } else if (j < 20) { role = 1; ra = xh * 4 + (j - 16); } }
    else { role = 2; ra = j * 4 + xh; rb = 256; }
  } else {
    if (bid < 64) { role = 0; ra = (bid & 7) * 2 + (bid >> 5); rb = (bid >> 3) & 3; }
    else if (bid < 80) { role = 1; ra = ((bid - 64) & 7) * 2 + ((bid - 64) >> 3); }
    else { role = 2; ra = bid - 80; rb = nb - 80; }
  }
  if (role == 0) { __builtin_amdgcn_s_setprio(3); scan_chunked(p, ra, rb, smem); __builtin_amdgcn_s_setprio(0); }
  else if (role == 1) scan_helper(p, ra);
  else if (role == 2) swa_mfma(p, ra, rb);
  GBAR();
  AMP(4, phaseF(p, bid, nb));
  GBAR();
  AMP(5, phaseG(p, bid, nb, smem));
}
#else
template <int PH>
__global__ void __launch_bounds__(256, 2) k_phase(Params p) {
  __shared__ __attribute__((aligned(16))) unsigned char smem[65536];
  const int bid = blockIdx.x, nb = gridDim.x;
  if (PH == 0) phaseA(p, bid, nb, smem);
  if (PH == 1) phaseB(p, bid, nb, smem);
  if (PH == 2) phaseC(p, bid, nb, smem);
  if (PH == 3) scan_chunked(p, bid >> 2, bid & 3, smem);
  if (PH == 6) swa_mfma(p, bid, nb);
  if (PH == 7) for (int t = bid; t < 2048; t += nb) prep_tile(p, t, smem);
  if (PH == 4) phaseF(p, bid, nb);
  if (PH == 5) phaseG(p, bid, nb, smem);
}
#endif

extern "C" void kernel_launch(void* const* d_in, const int* in_sizes, int n_in, void* d_out, int out_size, void* d_ws, size_t ws_size, hipStream_t stream) {
  Params p{};
  p.x = (const float*)d_in[0]; p.norm_w = (const float*)d_in[1]; p.w_in = (const float*)d_in[2]; p.conv_w = (const float*)d_in[3];
  p.a_log = (const float*)d_in[4]; p.dt_bias = (const float*)d_in[5]; p.out_norm_w = (const float*)d_in[6]; p.qnw = (const float*)d_in[7];
  p.knw = (const float*)d_in[8]; p.sinks = (const float*)d_in[9]; p.w_out = (const float*)d_in[10];
  p.out = (float*)d_out; p.ws = (unsigned char*)d_ws;
  if (ws_size < OFF_CTL_END) { fprintf(stderr, "workspace too small: %zu < %zu\n", ws_size, (size_t)OFF_END); return; }
#if MEGA
  static int grid_blocks = 0;
  if (!grid_blocks) {
    int dev = 0, cus = 0, per_cu = 0;
    hipGetDevice(&dev);
    hipDeviceGetAttribute(&cus, hipDeviceAttributeMultiprocessorCount, dev);
    hipOccupancyMaxActiveBlocksPerMultiprocessor(&per_cu, k_mega, 256, 0);
    if (per_cu > 2) per_cu = 2;
    grid_blocks = cus * per_cu;
  }
  void* args[] = {&p};
  (void)hipMemsetAsync((unsigned char*)d_ws + OFF_BAR, 0, OFF_CTL_END - OFF_BAR, stream);
  hipError_t e = hipLaunchCooperativeKernel((void*)k_mega, dim3(grid_blocks), dim3(256), args, 0, stream);
  if (e != hipSuccess) fprintf(stderr, "cooperative launch failed: %s (grid %d)\n", hipGetErrorString(e), grid_blocks);
#else
  k_phase<0><<<512, 256, 0, stream>>>(p);
  k_phase<1><<<512, 256, 0, stream>>>(p);
  k_phase<2><<<512, 256, 0, stream>>>(p);
  k_phase<7><<<512, 256, 0, stream>>>(p);
  k_phase<3><<<64, 256, 0, stream>>>(p);
  k_phase<6><<<512, 256, 0, stream>>>(p);
  k_phase<4><<<512, 256, 0, stream>>>(p);
  k_phase<5><<<512, 256, 0, stream>>>(p);
#endif
}
```

```cpp
#include <hip/hip_runtime.h>
#include <hip/hip_bf16.h>
#include <hip/hip_cooperative_groups.h>
#include <cstdio>
namespace cg = cooperative_groups;

#ifndef MEGA
#define MEGA 1
#endif
#define AMP_SEL (-1)
#define REP_A 1
#define REP_B 1
#define REP_C 1
#define REP_P 1
#define REP_S 1
#define REP_W 1
#define REP_F 1
#define REP_G 1

typedef unsigned short u16;
using bf16x8 = __attribute__((ext_vector_type(8))) short;
using f32x16 = __attribute__((ext_vector_type(16))) float;
using f32x4  = __attribute__((ext_vector_type(4))) float;
#define DI __device__ __forceinline__
using u32x4 = __attribute__((ext_vector_type(4))) unsigned;
using u32x2 = __attribute__((ext_vector_type(2))) unsigned;
#define MFMA16(a, b, c) __builtin_amdgcn_mfma_f32_16x16x32_bf16((a), (b), (c), 0, 0, 0)

constexpr int SEQ = 8192, M = 16384, D = 1024, NIN = 3344, N1 = 3328;
constexpr int C_DNQ = 0, C_DNK = 512, C_DNV = 1024, C_DNZ = 1536, C_SWQ = 2048, C_SWK = 2560, C_SWV = 2688, C_SWZ = 2816;
constexpr float EPS = 1e-6f;

constexpr int LDA = 1536, LDB = 1792;
constexpr int B_DNZ = 0, B_SWQ = 512, B_SWK = 1024, B_SWV = 1152, B_SWZ = 1280;
constexpr size_t OFF_XN   = 0;
constexpr size_t OFF_W1   = OFF_XN + (size_t)M * 1024 * 2;
constexpr size_t OFF_W2   = OFF_W1 + (size_t)N1 * 1024 * 2;
constexpr size_t OFF_BETA = OFF_W2 + (size_t)1024 * 1024 * 2;
constexpr size_t OFF_G    = OFF_BETA + (size_t)M * 8 * 4;
constexpr size_t OFF_ROPC = OFF_G + (size_t)M * 8 * 4;
constexpr size_t OFF_ROPS = OFF_ROPC + (size_t)SEQ * 32 * 4;
constexpr size_t OFF_PROJB= OFF_ROPS + (size_t)SEQ * 32 * 4;
constexpr size_t OFF_QN   = OFF_PROJB + (size_t)M * LDB * 2;
constexpr size_t OFF_KN   = OFF_QN + (size_t)M * 512 * 2;
constexpr size_t OFF_VV   = OFF_KN + (size_t)M * 512 * 2;
constexpr size_t OFF_PROJA= OFF_VV + (size_t)M * 512 * 2;
constexpr size_t OFF_PW   = OFF_PROJA;
constexpr size_t OFF_PU   = OFF_PW + (size_t)2048 * 8192 * 2;
constexpr size_t OFF_PK   = OFF_PU + (size_t)2048 * 8192 * 2;
constexpr size_t OFF_END  = OFF_PK + (size_t)2048 * 8192 * 2;
constexpr size_t DO_OB = (size_t)M * 512 * 2, DO_KR = (size_t)M * 512 * 4, DO_PA = DO_KR + (size_t)M * 128 * 4, DO_PE = DO_PA + (size_t)2048 * 4096 * 2, DO_PGL = DO_PE + (size_t)2048 * 64 * 4;
constexpr size_t DO_VT = DO_PGL + 8192;
constexpr int VT_LD = SEQ + 64;
static_assert(DO_VT + (size_t)256 * VT_LD * 2 <= (size_t)M * 1024 * 4, "d_out scratch overflow");
constexpr size_t OFF_BAR  = OFF_END;
constexpr size_t OFF_PROG = OFF_BAR + 16384;
constexpr size_t OFF_CTL_END = OFF_PROG + 16 * 256;
static_assert(OFF_CTL_END <= (size_t)256 * 1024 * 1024, "workspace overflow");

struct Params {
  const float *x, *norm_w, *w_in, *conv_w, *a_log, *dt_bias, *out_norm_w, *qnw, *knw, *sinks, *w_out;
  float* out;
  unsigned char* ws;
};

DI u16 f2bf(float x) { __bf16 r = (__bf16)x; return __builtin_bit_cast(u16, r); }
DI float bf2f(u16 v) { return __uint_as_float(((unsigned)v) << 16); }
typedef float f32x2_t __attribute__((ext_vector_type(2)));
typedef __bf16 bf16x2_t __attribute__((ext_vector_type(2)));
DI unsigned pack2(float a, float b) { f32x2_t v = {a, b}; bf16x2_t r = __builtin_convertvector(v, bf16x2_t); return __builtin_bit_cast(unsigned, r); }
template <int CTRL> DI float dpp_mov(float v) { return __int_as_float(__builtin_amdgcn_update_dpp(0, __float_as_int(v), CTRL, 0xF, 0xF, true)); }
DI float sum4(float v) { v += dpp_mov<0xB1>(v); v += dpp_mov<0x4E>(v); return v; }
DI float sum16(float v) { v = sum4(v); v += dpp_mov<0x141>(v); v += dpp_mov<0x140>(v); return v; }
DI float wave_sum(float v) {
  v = sum16(v);
  return (__int_as_float(__builtin_amdgcn_readlane(__float_as_int(v), 0)) + __int_as_float(__builtin_amdgcn_readlane(__float_as_int(v), 16))) +
         (__int_as_float(__builtin_amdgcn_readlane(__float_as_int(v), 32)) + __int_as_float(__builtin_amdgcn_readlane(__float_as_int(v), 48)));
}
DI float silu(float y) { return y * __frcp_rn(1.f + __expf(-y)); }
#define XB_TMO      128
#define XB_XCNT(j)  (256  + 64 * (j))
#define XB_XSUB(j)  (1280 + 64 * (j))
#define XB_XGEN(j)  (2304 + 64 * (j))
#define XB_TOP      3328
#define XB_TOPGEN   3392
#define XCD_BAR_WORDS 3456
#define XB_SPIN_CAP (1u << 20)
DI unsigned xb_ld(unsigned* p) { return __hip_atomic_load(p, __ATOMIC_RELAXED, __HIP_MEMORY_SCOPE_AGENT); }
DI unsigned xb_add(unsigned* p, unsigned v) { return __hip_atomic_fetch_add(p, v, __ATOMIC_RELAXED, __HIP_MEMORY_SCOPE_AGENT); }
DI unsigned xb_xcc_id() { return (unsigned)__builtin_amdgcn_s_getreg((3 << 11) | 20) & 0xFu; }
#define XB_SPIN(cond, bar) do { unsigned _sp = 0; while (cond) { __builtin_amdgcn_s_sleep(1); \
    if ((++_sp & 255u) == 0u) { if (xb_ld(&(bar)[XB_TMO])) break; if (_sp > XB_SPIN_CAP) { atomicAdd(&(bar)[XB_TMO], 1u); break; } } } } while (0)
struct XcdBarrier { unsigned* bar; unsigned x; volatile unsigned* st; };
DI XcdBarrier xcd_barrier_post(unsigned* bar, volatile unsigned* st) {
  XcdBarrier b; b.bar = bar; b.x = xb_xcc_id(); b.st = st;
  if (threadIdx.x == 0) (void)xb_add(&bar[XB_XCNT(b.x)], 1u);
  return b;
}
DI void xcd_barrier_complete(unsigned* bar, unsigned x, unsigned& nloc, unsigned& nx) {
  const unsigned G = gridDim.x;
  unsigned sum, cnt, mine, sp = 0u;
  for (;;) {
    sum = 0u; cnt = 0u; mine = 0u;
#pragma unroll
    for (unsigned j = 0; j < 16; ++j) { const unsigned c = xb_ld(&bar[XB_XCNT(j)]); sum += c; cnt += (c > 0u) ? 1u : 0u; mine = (j == x) ? c : mine; }
    if (sum == G) break;
    __builtin_amdgcn_s_sleep(1);
    if ((++sp & 255u) == 0u) { if (xb_ld(&bar[XB_TMO])) break; if (sp > XB_SPIN_CAP) { atomicAdd(&bar[XB_TMO], 1u); break; } }
  }
  nloc = mine > 0u ? mine : 1u; nx = cnt > 0u ? cnt : 1u;
}
DI void xcd_barrier(const XcdBarrier& b) {
  asm volatile("s_waitcnt vmcnt(0)" ::: "memory");
  __syncthreads();
  if (threadIdx.x == 0) {
    unsigned* bar = b.bar;
    __builtin_amdgcn_s_waitcnt(0);
    unsigned nloc = b.st[0], nx = b.st[1];
    if (nloc == 0u) { xcd_barrier_complete(bar, b.x, nloc, nx); b.st[0] = nloc; b.st[1] = nx; }
    const unsigned old = xb_add(&bar[XB_XSUB(b.x)], 1u);
    const unsigned gen = old / nloc;
    if (old + 1u == (gen + 1u) * nloc) {
      __builtin_amdgcn_fence(__ATOMIC_RELEASE, "agent");
      asm volatile("s_waitcnt vmcnt(0)" ::: "memory");
      const unsigned og = xb_add(&bar[XB_TOP], 1u);
      const unsigned tg = og / nx;
      if (og + 1u == (tg + 1u) * nx) xb_add(&bar[XB_TOPGEN], 1u);
      else XB_SPIN(xb_ld(&bar[XB_TOPGEN]) == tg, bar);
      __builtin_amdgcn_fence(__ATOMIC_ACQUIRE, "agent");
      xb_add(&bar[XB_XGEN(b.x)], 1u);
      asm volatile("s_waitcnt vmcnt(0)" ::: "memory");
    } else {
      XB_SPIN(xb_ld(&bar[XB_XGEN(b.x)]) == gen, bar);
      __builtin_amdgcn_fence(__ATOMIC_ACQUIRE, "agent");
      asm volatile("s_waitcnt vmcnt(0)" ::: "memory");
    }
  }
  __syncthreads();
}
DI int crow(int i, int h) { return (i & 3) + 8 * (i >> 2) + 4 * h; }

__device__ void phaseA(const Params& p, int bid, int nb, unsigned char* smem_raw) {
  float* smem = (float*)smem_raw;
  const int tid = threadIdx.x, wave = tid >> 6, lane = tid & 63;
#pragma unroll
  for (int i = 0; i < 4; ++i) {
    const int k = tid + 256 * i;
    const float4* src = (const float4*)(p.w_in + (size_t)k * NIN + 2048);
#pragma unroll
    for (int q = 0; q < 4; ++q) {
      const float4 v4 = src[q];
      smem[(4 * q + 0) * 1024 + k] = v4.x; smem[(4 * q + 1) * 1024 + k] = v4.y; smem[(4 * q + 2) * 1024 + k] = v4.z; smem[(4 * q + 3) * 1024 + k] = v4.w;
    }
  }
  __syncthreads();
  u16* xn = (u16*)(p.ws + OFF_XN);
  float* betaA = (float*)(p.ws + OFF_BETA);
  float* gA = (float*)(p.ws + OFF_G);
  float4 nwv[4];
#pragma unroll
  for (int i = 0; i < 4; ++i) nwv[i] = ((const float4*)p.norm_w)[lane + 64 * i];
  const float dtb = lane < 16 && lane >= 8 ? p.dt_bias[lane - 8] : 0.f;
  const float nal = lane < 16 && lane >= 8 ? -__expf(p.a_log[lane - 8]) : 0.f;
  float4 v[4], vn[4];
  int row = bid * 4 + wave;
  if (row < M) {
#pragma unroll
    for (int i = 0; i < 4; ++i) v[i] = ((const float4*)(p.x + (size_t)row * D))[lane + 64 * i];
  }
  for (; row < M; row += nb * 4) {
    const int rown = row + nb * 4;
    if (rown < M) {
#pragma unroll
      for (int i = 0; i < 4; ++i) vn[i] = ((const float4*)(p.x + (size_t)rown * D))[lane + 64 * i];
    }
    float ss = 0.f;
#pragma unroll
    for (int i = 0; i < 4; ++i) ss += v[i].x * v[i].x + v[i].y * v[i].y + v[i].z * v[i].z + v[i].w * v[i].w;
    ss = wave_sum(ss);
    const float rstd = rsqrtf(ss * (1.f / 1024.f) + EPS);
#pragma unroll
    for (int i = 0; i < 4; ++i) {
      v[i].x *= rstd * nwv[i].x; v[i].y *= rstd * nwv[i].y; v[i].z *= rstd * nwv[i].z; v[i].w *= rstd * nwv[i].w;
      uint2 pk; pk.x = pack2(v[i].x, v[i].y); pk.y = pack2(v[i].z, v[i].w);
      *(uint2*)(xn + (size_t)row * 1024 + (lane + 64 * i) * 4) = pk;
    }
    float r = 0.f;
#pragma unroll 2
    for (int j = 0; j < 16; ++j) {
      float a = 0.f;
#pragma unroll
      for (int i = 0; i < 4; ++i) {
        float4 w = *(const float4*)&smem[j * 1024 + (lane + 64 * i) * 4];
        a += v[i].x * w.x + v[i].y * w.y + v[i].z * w.z + v[i].w * w.w;
      }
      a = wave_sum(a);
      r = (lane == j) ? a : r;
    }
    if (lane < 8) betaA[(size_t)row * 8 + lane] = 1.f / (1.f + __expf(-r));
    else if (lane < 16) {
      float xx = r + dtb;
      float sp = fmaxf(xx, 0.f) + log1pf(__expf(-fabsf(xx)));
      gA[(size_t)row * 8 + lane - 8] = nal * sp;
    }
#pragma unroll
    for (int i = 0; i < 4; ++i) v[i] = vn[i];
  }
  u16* w1 = (u16*)(p.ws + OFF_W1);
  u16* w2 = (u16*)(p.ws + OFF_W2);
  const int gt = bid * 256 + tid, gs = nb * 256;
  {
    unsigned char* Lt = smem_raw;
    const int kq = tid >> 4, n4 = (tid & 15) * 4;
    for (int tile = bid; tile < 52 * 16 + 16 * 16; tile += nb) {
      const bool isw1 = tile < 52 * 16;
      const int tt = isw1 ? tile : tile - 52 * 16;
      const int n0 = isw1 ? (tt >> 4) * 64 : (tt >> 4) * 64, k0 = (tt & 15) * 64;
      const float* src = isw1 ? p.w_in + (n0 < 2048 ? n0 : n0 + 16) : p.w_out + n0;
      const int ldw = isw1 ? NIN : 1024;
      __syncthreads();
#pragma unroll
      for (int i = 0; i < 4; ++i) {
        const int kl = kq + 16 * i;
        const float4 v4 = *(const float4*)(src + (size_t)(k0 + kl) * ldw + n4);
        *(u16*)(Lt + (n4 + 0) * 144 + kl * 2) = f2bf(v4.x); *(u16*)(Lt + (n4 + 1) * 144 + kl * 2) = f2bf(v4.y);
        *(u16*)(Lt + (n4 + 2) * 144 + kl * 2) = f2bf(v4.z); *(u16*)(Lt + (n4 + 3) * 144 + kl * 2) = f2bf(v4.w);
      }
      __syncthreads();
      u16* dst = (isw1 ? w1 : w2) + (size_t)(n0 + (tid >> 2)) * 1024 + k0;
      *(uint4*)(dst + (tid & 3) * 8) = *(const uint4*)(Lt + (tid >> 2) * 144 + (tid & 3) * 16);
      *(uint4*)(dst + (tid & 3) * 8 + 32) = *(const uint4*)(Lt + (tid >> 2) * 144 + (tid & 3) * 16 + 64);
    }
  }
  float* rc = (float*)(p.ws + OFF_ROPC);
  float* rs = (float*)(p.ws + OFF_ROPS);
  for (int idx = gt; idx < SEQ * 32; idx += gs) {
    int pos = idx >> 5, i = idx & 31;
    float inv = exp2f(-(float)i * (13.287712379549449f / 32.f));
    float ang = (float)pos * inv;
    double a = (double)ang * 0.15915494309189535;
    float fr = (float)(a - rint(a));
    rc[idx] = __builtin_amdgcn_cosf(fr); rs[idx] = __builtin_amdgcn_sinf(fr);
  }
}

template <int MODE>
__device__ void gemm_tile(const Params& p, const u16* __restrict__ A, const u16* __restrict__ Bt, int K, int m0, int n0, unsigned char* smem) {
  const int tid = threadIdx.x, wave = tid >> 6, lane = tid & 63;
  const int wm = wave >> 1, wn = wave & 1, r = lane & 31, h = lane >> 5;
  unsigned char* As = smem;
  unsigned char* Bs = smem + 32768;
  f32x16 acc[2][2];
#pragma unroll
  for (int a = 0; a < 2; ++a)
#pragma unroll
    for (int b = 0; b < 2; ++b)
#pragma unroll
      for (int i = 0; i < 16; ++i) acc[a][b][i] = 0.f;
  uint4 s0a0, s0a1, s0a2, s0a3, s0b0, s0b1, s0b2, s0b3, s1a0, s1a1, s1a2, s1a3, s1b0, s1b1, s1b2, s1b3;
  const int KT = K / 64;
  const int lrow = tid >> 3, lc = tid & 7;
  const u16* gA = A + (size_t)(m0 + lrow) * K + lc * 8;
  const u16* gB = Bt + (size_t)(n0 + lrow) * K + lc * 8;
  const int loff = lrow * 128 + ((lc ^ ((lrow >> 1) & 7)) << 4);
#define GLOAD(kt_, S) { const u16* pa_ = gA + (kt_) * 64; const u16* pb_ = gB + (kt_) * 64; \
    S##a0 = *(const uint4*)(pa_); S##a1 = *(const uint4*)(pa_ + (size_t)32 * K); S##a2 = *(const uint4*)(pa_ + (size_t)64 * K); S##a3 = *(const uint4*)(pa_ + (size_t)96 * K); \
    S##b0 = *(const uint4*)(pb_); S##b1 = *(const uint4*)(pb_ + (size_t)32 * K); S##b2 = *(const uint4*)(pb_ + (size_t)64 * K); S##b3 = *(const uint4*)(pb_ + (size_t)96 * K); }
#define LSTORE(buf_, S) { unsigned char* la_ = As + (buf_) * 16384 + loff; unsigned char* lb_ = Bs + (buf_) * 16384 + loff; \
    *(uint4*)(la_) = S##a0; *(uint4*)(la_ + 4096) = S##a1; *(uint4*)(la_ + 8192) = S##a2; *(uint4*)(la_ + 12288) = S##a3; \
    *(uint4*)(lb_) = S##b0; *(uint4*)(lb_ + 4096) = S##b1; *(uint4*)(lb_ + 8192) = S##b2; *(uint4*)(lb_ + 12288) = S##b3; }
  const int rowa0 = wm * 64 + r, rowb0 = wn * 64 + r;
  const int swa0 = (rowa0 >> 1) & 7, swb0 = (rowb0 >> 1) & 7;
#define LDFRAG(buf_, ks_, AF, BF) { const int c_ = (ks_) * 2 + h; \
    AF[0] = *(const bf16x8*)(As + (buf_) * 16384 + rowa0 * 128 + ((c_ ^ swa0) << 4)); AF[1] = *(const bf16x8*)(As + (buf_) * 16384 + (rowa0 + 32) * 128 + ((c_ ^ swa0) << 4)); \
    BF[0] = *(const bf16x8*)(Bs + (buf_) * 16384 + rowb0 * 128 + ((c_ ^ swb0) << 4)); BF[1] = *(const bf16x8*)(Bs + (buf_) * 16384 + (rowb0 + 32) * 128 + ((c_ ^ swb0) << 4)); }
#define MMA4(AF, BF) { acc[0][0] = __builtin_amdgcn_mfma_f32_32x32x16_bf16(BF[0], AF[0], acc[0][0], 0, 0, 0); acc[0][1] = __builtin_amdgcn_mfma_f32_32x32x16_bf16(BF[1], AF[0], acc[0][1], 0, 0, 0); \
    acc[1][0] = __builtin_amdgcn_mfma_f32_32x32x16_bf16(BF[0], AF[1], acc[1][0], 0, 0, 0); acc[1][1] = __builtin_amdgcn_mfma_f32_32x32x16_bf16(BF[1], AF[1], acc[1][1], 0, 0, 0); }
  auto compute = [&](int buf) {
    bf16x8 afA[2], bfA[2], afB[2], bfB[2];
    LDFRAG(buf, 0, afA, bfA)
    LDFRAG(buf, 1, afB, bfB)
    __builtin_amdgcn_sched_barrier(0);
    __builtin_amdgcn_s_setprio(1);
    MMA4(afA, bfA)
    __builtin_amdgcn_sched_barrier(0);
    LDFRAG(buf, 2, afA, bfA)
    __builtin_amdgcn_sched_barrier(0);
    MMA4(afB, bfB)
    __builtin_amdgcn_sched_barrier(0);
    LDFRAG(buf, 3, afB, bfB)
    __builtin_amdgcn_sched_barrier(0);
    MMA4(afA, bfA)
    MMA4(afB, bfB)
    __builtin_amdgcn_s_setprio(0);
    __builtin_amdgcn_sched_barrier(0);
  };
  __syncthreads();
  GLOAD(0, s0) LSTORE(0, s0)
  GLOAD(1, s1)
  __syncthreads();
  for (int kt = 0; kt < KT; kt += 2) {
    { const int k2 = kt + 2 < KT ? kt + 2 : KT - 1; GLOAD(k2, s0) }
    compute(0);
    LSTORE(1, s1)
    __syncthreads();
    { const int k3 = kt + 3 < KT ? kt + 3 : KT - 1; GLOAD(k3, s1) }
    compute(1);
    if (kt + 2 < KT) { LSTORE(0, s0) }
    __syncthreads();
  }
#undef GLOAD
#undef LSTORE
  if (MODE == 0) {
#pragma unroll
    for (int a = 0; a < 2; ++a)
#pragma unroll
      for (int b = 0; b < 2; ++b)
#pragma unroll
        for (int g = 0; g < 4; ++g)
          *(uint2*)(smem + (wm * 64 + a * 32 + r) * 272 + (wn * 64 + b * 32 + 8 * g + 4 * h) * 2) = make_uint2(pack2(acc[a][b][4 * g], acc[a][b][4 * g + 1]), pack2(acc[a][b][4 * g + 2], acc[a][b][4 * g + 3]));
    __syncthreads();
    u16* dstb = n0 < 1536 ? (u16*)(p.ws + OFF_PROJA) + n0 : (u16*)(p.ws + OFF_PROJB) + (n0 - 1536);
    const int ld = n0 < 1536 ? LDA : LDB;
#pragma unroll
    for (int i = 0; i < 8; ++i) {
      const int id = tid + 256 * i, row = id >> 4, ch = id & 15;
      *(uint4*)(dstb + (size_t)(m0 + row) * ld + ch * 8) = *(const uint4*)(smem + row * 272 + ch * 16);
    }
    __syncthreads();
  } else {
    float* Cs = (float*)smem;
#pragma unroll
    for (int half = 0; half < 2; ++half) {
      if (wm == half) {
#pragma unroll
        for (int a = 0; a < 2; ++a)
#pragma unroll
          for (int b = 0; b < 2; ++b)
#pragma unroll
            for (int g = 0; g < 4; ++g)
              *(float4*)(Cs + (a * 32 + r) * 132 + wn * 64 + b * 32 + 8 * g + 4 * h) = make_float4(acc[a][b][4 * g], acc[a][b][4 * g + 1], acc[a][b][4 * g + 2], acc[a][b][4 * g + 3]);
      }
      __syncthreads();
#pragma unroll
      for (int i = 0; i < 8; ++i) {
        const int id = tid + 256 * i, row = id >> 5, ch = id & 31;
        const size_t go = (size_t)(m0 + half * 64 + row) * 1024 + n0 + ch * 4;
        const float4 xv = *(const float4*)(p.x + go);
        const float4 cv = *(const float4*)(Cs + row * 132 + ch * 4);
        *(float4*)(p.out + go) = make_float4(xv.x + cv.x, xv.y + cv.y, xv.z + cv.z, xv.w + cv.w);
      }
      __syncthreads();
    }
  }
}

__device__ void phaseB(const Params& p, int bid, int nb, unsigned char* smem) {
  const u16* xn = (const u16*)(p.ws + OFF_XN);
  const u16* w1 = (const u16*)(p.ws + OFF_W1);
  if ((nb & 7) == 0) {
    const int x = bid & 7, w = bid >> 3, per = nb >> 3;
    for (int j = w; j < 16 * 26; j += per) {
      const int g = j / 208, rem = j % 208;
      const int tn = rem >> 3, tm = x * 16 + g * 8 + (rem & 7);
      gemm_tile<0>(p, xn, w1, 1024, tm * 128, tn * 128, smem);
    }
  } else {
    for (int t = bid; t < 128 * 26; t += nb) gemm_tile<0>(p, xn, w1, 1024, (t / 26) * 128, (t % 26) * 128, smem);
  }
}
__device__ void phaseG(const Params& p, int bid, int nb, unsigned char* smem) {
  const u16* mix = (const u16*)(p.ws + OFF_XN);
  const u16* w2 = (const u16*)(p.ws + OFF_W2);
  if ((nb & 7) == 0) {
    const int x = bid & 7, w = bid >> 3, per = nb >> 3;
    for (int j = w; j < 16 * 8; j += per) {
      const int g = j >> 6, rem = j & 63;
      const int tn = rem >> 3, tm = x * 16 + g * 8 + (rem & 7);
      gemm_tile<1>(p, mix, w2, 1024, tm * 128, tn * 128, smem);
    }
  } else {
    for (int t = bid; t < 128 * 8; t += nb) gemm_tile<1>(p, mix, w2, 1024, (t >> 3) * 128, (t & 7) * 128, smem);
  }
}

DI void unpack8(const uint4 u, float* f) {
  f[0] = __uint_as_float(u.x << 16); f[1] = __uint_as_float(u.x & 0xffff0000u); f[2] = __uint_as_float(u.y << 16); f[3] = __uint_as_float(u.y & 0xffff0000u);
  f[4] = __uint_as_float(u.z << 16); f[5] = __uint_as_float(u.z & 0xffff0000u); f[6] = __uint_as_float(u.w << 16); f[7] = __uint_as_float(u.w & 0xffff0000u);
}
DI uint4 pack8(const float* f) { return make_uint4(pack2(f[0], f[1]), pack2(f[2], f[3]), pack2(f[4], f[5]), pack2(f[6], f[7])); }

__device__ void phaseC(const Params& p, int bid, int nb, unsigned char* smem) {
  const int tid = threadIdx.x, wave = tid >> 6, lane = tid & 63;
  const u16* projA = (const u16*)(p.ws + OFF_PROJA);
  const u16* projB = (const u16*)(p.ws + OFF_PROJB);
  u16* kr = (u16*)((unsigned char*)p.out + DO_KR);
  u16* vT = (u16*)((unsigned char*)p.out + DO_VT);
  u16* qr = (u16*)(p.ws + OFF_XN);
  const float* rc = (const float*)(p.ws + OFF_ROPC);
  const float* rs = (const float*)(p.ws + OFF_ROPS);
  int* wctr = (int*)smem;
  __syncthreads();
  if (tid == 0) *wctr = 0;
  __syncthreads();
  if (tid < 192) {
    const int sec = tid >> 6, ch0 = (tid & 63) * 8;
    u16* dst = (u16*)(p.ws + (sec == 0 ? OFF_QN : (sec == 1 ? OFF_KN : OFF_VV)));
    float w[5][8];
#pragma unroll
    for (int j = 0; j < 5; ++j) {
      const float4 w0 = *(const float4*)(p.conv_w + j * 1536 + sec * 512 + ch0), w1 = *(const float4*)(p.conv_w + j * 1536 + sec * 512 + ch0 + 4);
      w[j][0] = w0.x; w[j][1] = w0.y; w[j][2] = w0.z; w[j][3] = w0.w; w[j][4] = w1.x; w[j][5] = w1.y; w[j][6] = w1.z; w[j][7] = w1.w;
    }
    for (int run = bid; run < M / 32; run += nb) {
      const int m0 = run * 32, t0 = m0 & (SEQ - 1);
      auto ldraw = [&](int i) {
        const int t = t0 + i;
        uint4 u = make_uint4(0u, 0u, 0u, 0u);
        if (t >= 0 && t < SEQ) u = *(const uint4*)(projA + (size_t)(m0 + i) * LDA + sec * 512 + ch0);
        return u;
      };
      float r[5][8];
      { uint4 u0 = ldraw(-2), u1 = ldraw(-1), u2 = ldraw(0), u3 = ldraw(1); unpack8(u0, r[0]); unpack8(u1, r[1]); unpack8(u2, r[2]); unpack8(u3, r[3]); }
      uint4 pre0 = ldraw(2), pre1 = ldraw(3), pre2 = ldraw(4);
#pragma unroll 1
      for (int i = 0; i < 32; ++i) {
        unpack8(pre0, r[4]);
        pre0 = pre1; pre1 = pre2; pre2 = ldraw(i + 5 < 34 ? i + 5 : 33);
        float y[8]; float ss = 0.f;
#pragma unroll
        for (int c = 0; c < 8; ++c) {
          float a = r[0][c] * w[0][c] + r[1][c] * w[1][c] + r[2][c] * w[2][c] + r[3][c] * w[3][c] + r[4][c] * w[4][c];
          a = silu(a); y[c] = a; ss += a * a;
        }
        if (sec < 2) {
          ss = sum16(ss);
          const float f = rsqrtf(ss + EPS) * (sec == 0 ? 0.08838834764831845f : 1.f);
#pragma unroll
          for (int c = 0; c < 8; ++c) y[c] *= f;
        }
        if (sec == 0) {
          const int mm = m0 + i, tq = mm & (SEQ - 1), cq = tq & 63, chq = (ch0 & 127) >> 3;
          const size_t tileq = (size_t)(((mm >> 13) * 4 + (ch0 >> 7)) * 128 + (tq >> 6));
          *(uint4*)(dst + tileq * 8192 + (((cq >> 4) * 4 + (chq >> 2)) * 64 + (chq & 3) * 16 + (cq & 15)) * 8) = pack8(y);
        } else *(uint4*)(dst + (size_t)(m0 + i) * 512 + ch0) = pack8(y);
#pragma unroll
        for (int j = 0; j < 4; ++j)
#pragma unroll
          for (int c = 0; c < 8; ++c) r[j][c] = r[j + 1][c];
      }
    }
  }
  const int nitems = M / 2 + M / 8, ipw = (nitems + nb - 1) / nb;
  for (;;) {
    int it = 0;
    if (lane == 0) it = atomicAdd(wctr, 1);
    it = __shfl(it, 0);
    const int item = bid * ipw + it;
    if (it >= ipw || item >= nitems) break;
    const bool isk = item >= M / 2;
    const int j = lane & 3;
    int m, head;
    if (!isk) { m = item * 2 + (lane >> 5); head = (lane >> 2) & 7; }
    else      { m = (item - M / 2) * 8 + (lane >> 3); head = (lane >> 2) & 1; }
    const int t = m & (SEQ - 1);
    const u16* src = projB + (size_t)m * LDB + (isk ? B_SWK : B_SWQ) + head * 64 + 8 * j;
    float lo[8], hi[8];
    unpack8(*(const uint4*)src, lo); unpack8(*(const uint4*)(src + 32), hi);
    float ss = 0.f;
#pragma unroll
    for (int c = 0; c < 8; ++c) ss += lo[c] * lo[c] + hi[c] * hi[c];
    ss = sum4(ss);
    const float rstd = rsqrtf(ss * (1.f / 64.f) + EPS) * (isk ? 1.f : 0.125f);
    const float* nw = isk ? p.knw : p.qnw;
    float olo[8], ohi[8];
#pragma unroll
    for (int c = 0; c < 8; ++c) {
      const float y0 = lo[c] * rstd * nw[8 * j + c], y1 = hi[c] * rstd * nw[32 + 8 * j + c];
      const float cs = rc[t * 32 + 8 * j + c], sn = rs[t * 32 + 8 * j + c];
      olo[c] = y0 * cs - y1 * sn; ohi[c] = y1 * cs + y0 * sn;
    }
    if (isk) {
      u16* dst = kr + ((size_t)(((m >> 13) * 2 + head) * 512 + (t >> 4)) * 2) * 512 + (j * 16 + (t & 15)) * 8;
      *(uint4*)dst = pack8(olo); *(uint4*)(dst + 512) = pack8(ohi);
    } else {
      u16* dst = qr + (size_t)m * 1024 + head * 64 + 8 * j;
      *(uint4*)dst = pack8(olo); *(uint4*)(dst + 32) = pack8(ohi);
    }
  }
  for (int it = bid * 256 + tid; it < 128 * (M / 8); it += nb * 256) {
    const int c = it & 127, m0 = (it >> 7) * 8;
    const int b = m0 >> 13, t0 = m0 & (SEQ - 1);
    const u16* src = projB + (size_t)m0 * LDB + B_SWV + c;
    unsigned pk[4];
#pragma unroll
    for (int i = 0; i < 4; ++i) pk[i] = (unsigned)src[(size_t)(2 * i) * LDB] | ((unsigned)src[(size_t)(2 * i + 1) * LDB] << 16);
    u16* dst = vT + ((size_t)(((b * 2 + (c >> 6)) * 512 + (t0 >> 4)) * 4 + ((c & 63) >> 4)) * 64 + ((t0 >> 2) & 3) * 16 + (c & 15)) * 4;
    *(uint2*)dst = make_uint2(pk[0], pk[1]);
    *(uint2*)(dst + 64) = make_uint2(pk[2], pk[3]);
  }
}

__device__ void prep_tile(const Params& p, int tile, unsigned char* smem) {
  int tid_ = threadIdx.x;
  asm volatile("" : "+v"(tid_));
  const int tid = tid_, wave = __builtin_amdgcn_readfirstlane(tid >> 6), lane = tid & 63;
  const int dir = tile & 1, n = (tile >> 1) & 127, bh = tile >> 8, b = bh >> 2, hh = bh & 3;
  unsigned char* ksb = smem;
  unsigned char* qsb = smem + 17408;
  float* Ms = (float*)(smem + 34816);
  float* gc = (float*)(smem + 51200);
  float* bt = gc + 64;
  float* cw = (float*)(smem + 64000);
  float* cd = (float*)(smem + 64256);
  const u16* qn = (const u16*)(p.ws + OFF_QN);
  const u16* kn = (const u16*)(p.ws + OFF_KN);
  const u16* vv = (const u16*)(p.ws + OFF_VV);
  const float* betaA = (const float*)(p.ws + OFF_BETA);
  const float* gA = (const float*)(p.ws + OFF_G);
  u16* pw = (u16*)(p.ws + OFF_PW) + (size_t)tile * 8192;
  u16* pu = (u16*)(p.ws + OFF_PU) + (size_t)tile * 8192;
  u16* pk = (u16*)(p.ws + OFF_PK) + (size_t)tile * 8192;
  u16* pa = (u16*)((unsigned char*)p.out + DO_PA) + (size_t)tile * 4096;
  float* pe = (float*)((unsigned char*)p.out + DO_PE) + (size_t)tile * 64;
  float* pgl = (float*)((unsigned char*)p.out + DO_PGL);
  const size_t row0 = (size_t)b * SEQ + n * 64;
  __syncthreads();
#pragma unroll
  for (int i = 0; i < 4; ++i) {
    int id = tid + 256 * i, c = id >> 4, ch = id & 15;
    int tok = dir ? 63 - c : c;
    *(uint4*)(ksb + c * 272 + ch * 16) = *(const uint4*)(kn + (row0 + tok) * 512 + hh * 128 + ch * 8);
    *(uint4*)(qsb + c * 272 + ch * 16) = *(const uint4*)(qn + (size_t)(bh * 128 + n) * 8192 + (((tok >> 4) * 4 + (ch >> 2)) * 64 + (ch & 3) * 16 + (tok & 15)) * 8);
  }
  if (wave == 0) {
    int tok = dir ? 63 - lane : lane;
    float g = gA[(row0 + tok) * 8 + dir * 4 + hh];
    float bb = betaA[(row0 + tok) * 8 + dir * 4 + hh];
#pragma unroll
    for (int o = 1; o < 64; o <<= 1) { float t = __shfl_up(g, o); if (lane >= o) g += t; }
    gc[lane] = g; bt[lane] = bb;
    const float eg_ = __expf(g);
    pe[lane] = eg_;
    if (lane == 63) pgl[tile] = eg_;
    cw[lane] = bb * eg_;
    cd[lane] = __expf(__shfl(g, 63) - g);
  }
  __syncthreads();
  {
    const int row = lane & 15, quad = lane >> 4;
    bf16x8 ak[4], aq[4];
#pragma unroll
    for (int k = 0; k < 4; ++k) {
      ak[k] = *(const bf16x8*)(ksb + (16 * wave + row) * 272 + k * 64 + quad * 16);
      aq[k] = *(const bf16x8*)(qsb + (16 * wave + row) * 272 + k * 64 + quad * 16);
    }
#pragma unroll
    for (int tc = 0; tc < 4; ++tc) {
      f32x4 ckk = {0.f, 0.f, 0.f, 0.f}, cqk = {0.f, 0.f, 0.f, 0.f};
#pragma unroll
      for (int k = 0; k < 4; ++k) {
        bf16x8 bk = *(const bf16x8*)(ksb + (16 * tc + row) * 272 + k * 64 + quad * 16);
        ckk = MFMA16(ak[k], bk, ckk);
        cqk = MFMA16(aq[k], bk, cqk);
      }
      const int s = 16 * tc + row;
      const float gs = gc[s];
#pragma unroll
      for (int j = 0; j < 4; ++j) {
        const int c = 16 * wave + quad * 4 + j;
        float dec = __expf(fminf(gc[c] - gs, 0.f));
        float mval = (s < c) ? bt[c] * ckk[j] * dec : 0.f;
        float aval = (s <= c) ? cqk[j] * dec : 0.f;
        Ms[c * 64 + s] = mval;
        *(u16*)(smem + 51712 + ((((c >> 4) * 2 + (s >> 5)) * 64 + ((s >> 3) & 3) * 16 + (c & 15)) * 8 + (s & 7)) * 2) = f2bf(aval);
      }
    }
  }
  {
    const int dk = tid & 127, half = tid >> 7;
    const float gl = gc[63];
    unsigned pkd[16];
#pragma unroll
    for (int i = 0; i < 16; ++i) {
      int c0 = half * 32 + 2 * i;
      float k0 = bf2f(*(const u16*)(ksb + c0 * 272 + dk * 2)) * cd[c0];
      float k1 = bf2f(*(const u16*)(ksb + (c0 + 1) * 272 + dk * 2)) * cd[c0 + 1];
      pkd[i] = pack2(k0, k1);
    }
#pragma unroll
    for (int i = 0; i < 4; ++i) {
      const int cc = half * 4 + i;
      *(uint4*)(pk + ((((dk >> 5) * 2 + ((dk >> 4) & 1)) * 2 + (cc >> 2)) * 64 + (cc & 3) * 16 + (dk & 15)) * 8) = make_uint4(pkd[4 * i], pkd[4 * i + 1], pkd[4 * i + 2], pkd[4 * i + 3]);
    }
  }
  __syncthreads();
  {
    const uint4* src = (const uint4*)(smem + 51712);
    ((uint4*)pa)[tid] = src[tid];
    ((uint4*)pa)[tid + 256] = src[tid + 256];
  }
  float x[64];
  if (tid < 128) {
#pragma unroll
    for (int c = 0; c < 64; ++c) { int tok = dir ? 63 - c : c; x[c] = bt[c] * bf2f(vv[(row0 + tok) * 512 + hh * 128 + tid]); }
  } else {
#pragma unroll
    for (int c = 0; c < 64; ++c) x[c] = cw[c] * bf2f(*(const u16*)(ksb + c * 272 + (tid - 128) * 2));
  }
  __syncthreads();
  unsigned char* xs = smem;
  unsigned char* ys = smem + 51712;
  {
    const int row = lane & 15, quad = lane >> 4;
#pragma unroll
    for (int I = 0; I < 4; ++I) {
      asm volatile("" ::: "memory");
      if (I > 0) {
        f32x4 yacc[4];
#pragma unroll
        for (int nt = 0; nt < 4; ++nt) yacc[nt] = f32x4{0.f, 0.f, 0.f, 0.f};
#pragma unroll
        for (int ks = 0; ks < (16 * I + 31) / 32; ++ks) {
          const bool live = (ks * 32 + quad * 8) < 16 * I;
          const float4 m0 = *(const float4*)(Ms + (16 * I + row) * 64 + ks * 32 + quad * 8);
          const float4 m1 = *(const float4*)(Ms + (16 * I + row) * 64 + ks * 32 + quad * 8 + 4);
          union { bf16x8 v; unsigned u[4]; } af;
          af.u[0] = live ? pack2(m0.x, m0.y) : 0u; af.u[1] = live ? pack2(m0.z, m0.w) : 0u;
          af.u[2] = live ? pack2(m1.x, m1.y) : 0u; af.u[3] = live ? pack2(m1.z, m1.w) : 0u;
          const int qe = live ? quad : (quad & 1);
#pragma unroll
          for (int nt = 0; nt < 4; ++nt) {
            const bf16x8 bx = *(const bf16x8*)(xs + (64 * wave + 16 * nt + row) * 112 + (ks * 32 + qe * 8) * 2);
            yacc[nt] = MFMA16(af.v, bx, yacc[nt]);
          }
        }
#pragma unroll
        for (int nt = 0; nt < 4; ++nt)
          *(uint2*)(ys + (64 * wave + 16 * nt + row) * 48 + quad * 8) = make_uint2(pack2(yacc[nt][0], yacc[nt][1]), pack2(yacc[nt][2], yacc[nt][3]));
        const uint4 y0 = *(const uint4*)(ys + tid * 48), y1 = *(const uint4*)(ys + tid * 48 + 16);
        const unsigned yy[8] = {y0.x, y0.y, y0.z, y0.w, y1.x, y1.y, y1.z, y1.w};
#pragma unroll
        for (int r = 0; r < 16; ++r) x[16 * I + r] -= (r & 1) ? __uint_as_float(yy[r >> 1] & 0xffff0000u) : __uint_as_float(yy[r >> 1] << 16);
      }
      int mrow[16];
#pragma unroll
      for (int r = 1; r < 16; ++r) mrow[r] = __float_as_int(Ms[(16 * I + r) * 64 + lane]);
#pragma unroll
      for (int r = 1; r < 16; ++r) {
        float a0 = 0.f, a1 = 0.f;
#pragma unroll
        for (int sidx = 0; sidx < r; ++sidx) {
          const float m = __int_as_float(__builtin_amdgcn_readlane(mrow[r], 16 * I + sidx));
          if (sidx & 1) a1 = fmaf(m, x[16 * I + sidx], a1); else a0 = fmaf(m, x[16 * I + sidx], a0);
        }
        x[16 * I + r] -= a0 + a1;
      }
      if (I < 3) {
#pragma unroll
        for (int i = 0; i < 2; ++i)
          *(uint4*)(xs + tid * 112 + I * 32 + i * 16) = make_uint4(pack2(x[16 * I + 8 * i], x[16 * I + 8 * i + 1]), pack2(x[16 * I + 8 * i + 2], x[16 * I + 8 * i + 3]),
                                                                 pack2(x[16 * I + 8 * i + 4], x[16 * I + 8 * i + 5]), pack2(x[16 * I + 8 * i + 6], x[16 * I + 8 * i + 7]));
      }
    }
  }
  __syncthreads();
  if (tid < 128) {
#pragma unroll
    for (int g = 0; g < 16; ++g)
      *(uint2*)(pu + (((((tid >> 5) * 2 + ((tid >> 4) & 1)) * 4 + (g >> 2)) * 64 + (g & 3) * 16 + (tid & 15)) * 4)) = make_uint2(pack2(x[4 * g], x[4 * g + 1]), pack2(x[4 * g + 2], x[4 * g + 3]));
  } else {
#pragma unroll
    for (int c = 0; c < 64; ++c) *(u16*)(qsb + c * 272 + (tid - 128) * 2) = f2bf(-x[c]);
  }
  __syncthreads();
#pragma unroll
  for (int i = 0; i < 4; ++i) {
    const int d = tid + 256 * i;
    const int c = (d >> 8) * 16 + (d & 15), ch = ((d >> 6) & 3) * 4 + ((d >> 4) & 3);
    *(uint4*)(pw + d * 8) = *(const uint4*)(qsb + c * 272 + ch * 16);
  }
}

struct ScanEarly { bf16x8 aw[4]; uint2 u[2]; };
struct ScanFrags { bf16x8 aq[4], aa[2], akd[2][2]; float eg; float egl; };
__device__ void scan_chunked(const Params& p, int chain, int slab, unsigned char* smem) {
  const int tid = threadIdx.x, wave = tid >> 6, lane = tid & 63, row = lane & 15, quad = lane >> 4;
  const int dv0 = slab * 32;
  const int b = chain >> 3, hh = (chain >> 1) & 3, dir = chain & 1;
  unsigned* prog = (unsigned*)(p.ws + OFF_PROG) + chain * 64;
  const bool publisher = (dv0 == 0) && (tid == 0);
  unsigned char* Sl = smem;
  unsigned char* Vl = smem + 8704;
  const u16* qn = (const u16*)(p.ws + OFF_QN);
  const u16* pwA = (const u16*)(p.ws + OFF_PW);
  const u16* puA = (const u16*)(p.ws + OFF_PU);
  const u16* pkA = (const u16*)(p.ws + OFF_PK);
  const u16* paA = (const u16*)((unsigned char*)p.out + DO_PA);
  const float* peA = (const float*)((unsigned char*)p.out + DO_PE);
  const float* pglA = (const float*)((unsigned char*)p.out + DO_PGL);
  u16* ob = (u16*)((unsigned char*)p.out + (dir ? DO_OB : 0));
#pragma unroll 1
  for (int rep = 0; rep < REP_S; ++rep) {
  __syncthreads();
  for (int i = tid; i < 8704 / 4; i += 256) ((unsigned*)Sl)[i] = 0u;
  f32x4 Sacc[2][2];
#pragma unroll
  for (int a = 0; a < 2; ++a)
#pragma unroll
    for (int c = 0; c < 2; ++c) Sacc[a][c] = f32x4{0.f, 0.f, 0.f, 0.f};
  auto gloadE = [&](ScanEarly& e, int step) {
    const int n = dir ? 127 - step : step;
    const size_t tile = ((size_t)(b * 4 + hh) * 128 + n) * 2 + dir;
#pragma unroll
    for (int k = 0; k < 4; ++k) e.aw[k] = *(const bf16x8*)(pwA + tile * 8192 + ((wave * 4 + k) * 64 + lane) * 8);
#pragma unroll
    for (int nt = 0; nt < 2; ++nt) e.u[nt] = *(const uint2*)(puA + tile * 8192 + ((((dv0 >> 5) * 2 + nt) * 4 + wave) * 64 + lane) * 4);
  };
  auto gload = [&](ScanFrags& f, int step) {
    const int n = dir ? 127 - step : step;
    const size_t tile = ((size_t)(b * 4 + hh) * 128 + n) * 2 + dir;
    const int c = 16 * wave + row;
    const size_t qtile = (size_t)((b * 4 + hh) * 128 + n) * 8192;
    const int qlane = dir ? quad * 16 + (15 - row) : lane, qw = dir ? 3 - wave : wave;
#pragma unroll
    for (int k = 0; k < 4; ++k) f.aq[k] = *(const bf16x8*)(qn + qtile + ((qw * 4 + k) * 64 + qlane) * 8);
#pragma unroll
    for (int k = 0; k < 2; ++k) {
      f.aa[k] = *(const bf16x8*)(paA + tile * 4096 + ((wave * 2 + k) * 64 + lane) * 8);
#pragma unroll
      for (int d = 0; d < 2; ++d) f.akd[d][k] = *(const bf16x8*)(pkA + tile * 8192 + (((wave * 2 + d) * 2 + k) * 64 + lane) * 8);
    }
    f.eg = peA[tile * 64 + c];
    f.egl = pglA[tile];
  };
  auto body = [&](ScanEarly& e, ScanEarly& en2, ScanFrags& f, ScanFrags& fn, int step) {
    if (publisher) __hip_atomic_store(prog, (unsigned)(step + 1), __ATOMIC_RELAXED, __HIP_MEMORY_SCOPE_AGENT);
    if (step + 2 < 128) gloadE(en2, step + 2);
    if (step + 1 < 128) gload(fn, step + 1);
    bf16x8 bS[4][2];
#pragma unroll
    for (int k = 0; k < 4; ++k)
#pragma unroll
      for (int nt = 0; nt < 2; ++nt) bS[k][nt] = *(const bf16x8*)(Sl + (nt * 16 + row) * 272 + k * 64 + quad * 16);
    f32x4 vacc[2], oacc[2];
#pragma unroll
    for (int nt = 0; nt < 2; ++nt) {
      vacc[nt] = f32x4{__uint_as_float(e.u[nt].x << 16), __uint_as_float(e.u[nt].x & 0xffff0000u), __uint_as_float(e.u[nt].y << 16), __uint_as_float(e.u[nt].y & 0xffff0000u)};
#pragma unroll
      for (int k = 0; k < 4; ++k) vacc[nt] = MFMA16(e.aw[k], bS[k][nt], vacc[nt]);
      *(uint2*)(Vl + (nt * 16 + row) * 144 + (16 * wave + quad * 4) * 2) = make_uint2(pack2(vacc[nt][0], vacc[nt][1]), pack2(vacc[nt][2], vacc[nt][3]));
    }
    asm volatile("s_waitcnt lgkmcnt(0)\n\ts_barrier" ::: "memory");
#pragma unroll
    for (int nt = 0; nt < 2; ++nt) {
      oacc[nt] = f32x4{0.f, 0.f, 0.f, 0.f};
#pragma unroll
      for (int k = 0; k < 4; ++k) oacc[nt] = MFMA16(bS[k][nt], f.aq[k], oacc[nt]);
      oacc[nt] *= f.eg;
    }
    bf16x8 bV[2][2];
#pragma unroll
    for (int k = 0; k < 2; ++k)
#pragma unroll
      for (int nt = 0; nt < 2; ++nt) bV[k][nt] = *(const bf16x8*)(Vl + (nt * 16 + row) * 144 + k * 64 + quad * 16);
#pragma unroll
    for (int d = 0; d < 2; ++d)
#pragma unroll
      for (int nt = 0; nt < 2; ++nt) {
        Sacc[d][nt] *= f.egl;
#pragma unroll
        for (int k = 0; k < 2; ++k) Sacc[d][nt] = MFMA16(f.akd[d][k], bV[k][nt], Sacc[d][nt]);
        *(uint2*)(Sl + (nt * 16 + row) * 272 + (32 * wave + 16 * d + quad * 4) * 2) = make_uint2(pack2(Sacc[d][nt][0], Sacc[d][nt][1]), pack2(Sacc[d][nt][2], Sacc[d][nt][3]));
      }
    const int n = dir ? 127 - step : step;
#pragma unroll
    for (int nt = 0; nt < 2; ++nt) {
#pragma unroll
      for (int k = 0; k < 2; ++k) oacc[nt] = MFMA16(bV[k][nt], f.aa[k], oacc[nt]);
      const int c = 16 * wave + row;
      const int tok = dir ? 63 - c : c;
      *(uint2*)(ob + ((size_t)b * SEQ + n * 64 + tok) * 512 + hh * 128 + dv0 + nt * 16 + quad * 4) = make_uint2(pack2(oacc[nt][0], oacc[nt][1]), pack2(oacc[nt][2], oacc[nt][3]));
    }
    asm volatile("s_waitcnt lgkmcnt(0)\n\ts_barrier" ::: "memory");
  };
  ScanEarly e0, e1, e2;
  ScanFrags f0, f1;
  gloadE(e0, 0); gloadE(e1, 1);
  gload(f0, 0);
  __syncthreads();
#pragma unroll 1
  for (int step = 0; step < 126; step += 6) {
    body(e0, e2, f0, f1, step);
    body(e1, e0, f1, f0, step + 1);
    body(e2, e1, f0, f1, step + 2);
    body(e0, e2, f1, f0, step + 3);
    body(e1, e0, f0, f1, step + 4);
    body(e2, e1, f1, f0, step + 5);
  }
  body(e0, e2, f0, f1, 126);
  body(e1, e0, f1, f0, 127);
  }
}

constexpr int PF_DEPTH = 10, PF_BATCH = 4;
__device__ void scan_helper(const Params& p, int chain) {
  const int tid = threadIdx.x;
  const int b = chain >> 3, hh = (chain >> 1) & 3, dir = chain & 1;
  unsigned* prog = (unsigned*)(p.ws + OFF_PROG) + chain * 64;
  const unsigned char* pw = p.ws + OFF_PW;
  const unsigned char* pu = p.ws + OFF_PU;
  const unsigned char* pk = p.ws + OFF_PK;
  const unsigned char* pa = (const unsigned char*)p.out + DO_PA;
  const unsigned char* pe = (const unsigned char*)p.out + DO_PE;
  const unsigned char* qn = p.ws + OFF_QN;
  unsigned acc = 0u;
  int cur = 1;
#pragma unroll 1
  while (cur < 128) {
    const int done = (int)__hip_atomic_load(prog, __ATOMIC_RELAXED, __HIP_MEMORY_SCOPE_AGENT);
    if (done >= 127) break;
    if (cur < done + 1) cur = done + 1;
    const int lim = done + PF_DEPTH < 128 ? done + PF_DEPTH : 128;
    if (cur >= lim) { __builtin_amdgcn_s_sleep(4); continue; }
    unsigned v[PF_BATCH][3];
#pragma unroll
    for (int i = 0; i < PF_BATCH; ++i) {
      const int st = cur + i < lim ? cur + i : lim - 1;
      const int n = dir ? 127 - st : st;
      const size_t tile = ((size_t)(b * 4 + hh) * 128 + n) * 2 + dir;
      const unsigned char* a0 = (tid < 128) ? pw + tile * 16384 + tid * 128 : pu + tile * 16384 + (tid - 128) * 128;
      const unsigned char* a1 = (tid < 128) ? pk + tile * 16384 + tid * 128 : (tid < 192 ? pa + tile * 8192 + (tid - 128) * 128 : pe + tile * 256 + (tid & 1) * 128);
      const unsigned char* a2 = qn + (size_t)((b * 4 + hh) * 128 + n) * 16384 + (tid & 127) * 128;
      v[i][0] = *(const unsigned*)a0; v[i][1] = *(const unsigned*)a1; v[i][2] = *(const unsigned*)a2;
    }
#pragma unroll
    for (int i = 0; i < PF_BATCH; ++i) acc ^= v[i][0] ^ v[i][1] ^ v[i][2];
    cur = cur + PF_BATCH < lim ? cur + PF_BATCH : lim;
  }
  if (acc == 0x9e3779b9u && p.ws == nullptr) *(unsigned*)p.out = acc;
}

__device__ void swa_mfma(const Params& p, int bid, int nb) {
  const int wave = threadIdx.x >> 6, lane = threadIdx.x & 63, col = lane & 15, quad = lane >> 4;
  const u16* kr = (const u16*)((const unsigned char*)p.out + DO_KR);
  const u16* vT = (const u16*)((const unsigned char*)p.out + DO_VT);
  const u16* qr = (const u16*)(p.ws + OFF_XN);
  const u16* projB = (const u16*)(p.ws + OFF_PROJB);
  u16* mix = (u16*)(p.ws + OFF_XN);
  const int upw = (2048 + nb - 1) / nb;
  for (int unit = bid * upw; unit < (bid + 1) * upw && unit < 2048; ++unit) {
    const int qblk = unit & 511, kvh = (unit >> 9) & 1, b = unit >> 10;
    const int t0 = qblk * 16, qh = kvh * 4 + wave;
    const size_t mq = (size_t)b * SEQ + t0 + col;
    bf16x8 bq[2];
#pragma unroll
    for (int ks = 0; ks < 2; ++ks) {
      const u32x4 t4 = __builtin_nontemporal_load((const u32x4*)(qr + mq * 1024 + qh * 64 + ks * 32 + quad * 8));
      bq[ks] = __builtin_bit_cast(bf16x8, t4);
    }
    f32x4 sc[18];
    const int kb0 = (t0 >> 4) - 8;
    const u16* kbase = kr + (size_t)((b * 2 + kvh) * 512) * 1024 + lane * 8;
#pragma unroll
    for (int kt = 0; kt < 18; ++kt) {
      int kb = kb0 + kt; kb = kb < 0 ? 0 : (kb > 511 ? 511 : kb);
      const bf16x8 a0 = *(const bf16x8*)(kbase + (size_t)kb * 1024), a1 = *(const bf16x8*)(kbase + (size_t)kb * 1024 + 512);
      f32x4 c = {0.f, 0.f, 0.f, 0.f};
      c = MFMA16(a0, bq[0], c);
      c = MFMA16(a1, bq[1], c);
      sc[kt] = c;
    }
    const float sink = p.sinks[qh];
    float mx = sink;
#pragma unroll
    for (int kt = 0; kt < 18; ++kt)
#pragma unroll
      for (int jj = 0; jj < 4; ++jj) {
        const int key = t0 - 128 + 16 * kt + quad * 4 + jj;
        const int rel = key - (t0 + col);
        const bool valid = (rel >= -128) && (rel <= 128) && (key >= 0) && (key < SEQ);
        float v = valid ? sc[kt][jj] : -1e30f;
        sc[kt][jj] = v;
        mx = fmaxf(mx, v);
      }
    mx = fmaxf(mx, __shfl_xor(mx, 16));
    mx = fmaxf(mx, __shfl_xor(mx, 32));
    float l = 0.f;
#pragma unroll
    for (int kt = 0; kt < 18; ++kt)
#pragma unroll
      for (int jj = 0; jj < 4; ++jj) { float e = __expf(sc[kt][jj] - mx); sc[kt][jj] = e; l += e; }
    l += __shfl_xor(l, 16);
    l += __shfl_xor(l, 32);
    l += __expf(sink - mx);
    f32x4 o[4];
#pragma unroll
    for (int dt = 0; dt < 4; ++dt) o[dt] = f32x4{0.f, 0.f, 0.f, 0.f};
    bf16x8 bp[9];
#pragma unroll
    for (int kg = 0; kg < 9; ++kg) {
      union { bf16x8 v; unsigned u[4]; } t;
      t.u[0] = pack2(sc[2 * kg][0], sc[2 * kg][1]); t.u[1] = pack2(sc[2 * kg][2], sc[2 * kg][3]);
      t.u[2] = pack2(sc[2 * kg + 1][0], sc[2 * kg + 1][1]); t.u[3] = pack2(sc[2 * kg + 1][2], sc[2 * kg + 1][3]);
      bp[kg] = t.v;
    }
    const u16* vbase = vT + (size_t)((b * 2 + kvh) * 512) * 1024 + lane * 4;
#pragma unroll
    for (int hb = 0; hb < 2; ++hb) {
      uint2 av[5][4][2];
#pragma unroll
      for (int i = 0; i < 5; ++i) {
        const int kg = hb * 5 + i;
        if (kg < 9) {
          int b0 = kb0 + 2 * kg, b1 = b0 + 1;
          b0 = b0 < 0 ? 0 : (b0 > 511 ? 511 : b0); b1 = b1 < 0 ? 0 : (b1 > 511 ? 511 : b1);
#pragma unroll
          for (int dt = 0; dt < 4; ++dt) {
            av[i][dt][0] = *(const uint2*)(vbase + ((size_t)b0 * 4 + dt) * 256);
            av[i][dt][1] = *(const uint2*)(vbase + ((size_t)b1 * 4 + dt) * 256);
          }
        }
      }
      __builtin_amdgcn_sched_barrier(0);
#pragma unroll
      for (int i = 0; i < 5; ++i) {
        const int kg = hb * 5 + i;
        if (kg < 9) {
#pragma unroll
          for (int dt = 0; dt < 4; ++dt) {
            union { bf16x8 v; unsigned u[4]; } a;
            a.u[0] = av[i][dt][0].x; a.u[1] = av[i][dt][0].y; a.u[2] = av[i][dt][1].x; a.u[3] = av[i][dt][1].y;
            o[dt] = MFMA16(a.v, bp[kg], o[dt]);
          }
        }
      }
      __builtin_amdgcn_sched_barrier(0);
    }
    const float inv = __frcp_rn(l);
#pragma unroll
    for (int dt = 0; dt < 4; ++dt) {
      const int d0 = dt * 16 + quad * 4;
      const u32x2 zz = __builtin_nontemporal_load((const u32x2*)(projB + mq * LDB + B_SWZ + qh * 64 + d0));
      const uint2 z = make_uint2(zz[0], zz[1]);
      float z0 = __uint_as_float(z.x << 16), z1 = __uint_as_float(z.x & 0xffff0000u), z2 = __uint_as_float(z.y << 16), z3 = __uint_as_float(z.y & 0xffff0000u);
      __builtin_nontemporal_store(u32x2{pack2(o[dt][0] * inv * silu(z0), o[dt][1] * inv * silu(z1)), pack2(o[dt][2] * inv * silu(z2), o[dt][3] * inv * silu(z3))}, (u32x2*)(mix + mq * 1024 + 512 + qh * 64 + d0));
    }
  }
}

__device__ void phaseF(const Params& p, int bid, int nb) {
  const int tid = threadIdx.x, wave = tid >> 6, lane = tid & 63;
  const u16* proj = (const u16*)(p.ws + OFF_PROJB);
  u16* mix = (u16*)(p.ws + OFF_XN);
  const u16* of = (const u16*)p.out;
  const u16* ob = (const u16*)((const unsigned char*)p.out + DO_OB);
  float w[8];
#pragma unroll
  for (int c = 0; c < 8; ++c) w[c] = p.out_norm_w[(lane & 15) * 8 + c];
  int m = bid * 4 + wave;
  uint4 ra = make_uint4(0u, 0u, 0u, 0u), rb = ra, rz = ra;
  if (m < M) {
    ra = *(const uint4*)(of + (size_t)m * 512 + lane * 8); rb = *(const uint4*)(ob + (size_t)m * 512 + lane * 8);
    rz = *(const uint4*)(proj + (size_t)m * LDB + B_DNZ + lane * 8);
  }
  for (; m < M; m += nb * 4) {
    const int mn = m + nb * 4;
    uint4 na = ra, nb4 = rb, nz = rz;
    if (mn < M) {
      na = *(const uint4*)(of + (size_t)mn * 512 + lane * 8); nb4 = *(const uint4*)(ob + (size_t)mn * 512 + lane * 8);
      nz = *(const uint4*)(proj + (size_t)mn * LDB + B_DNZ + lane * 8);
    }
    float a[8], b[8], z[8], y[8];
    unpack8(ra, a); unpack8(rb, b); unpack8(rz, z);
    float ss = 0.f;
#pragma unroll
    for (int c = 0; c < 8; ++c) { a[c] += b[c]; ss += a[c] * a[c]; }
    ss = sum16(ss);
    const float rstd = rsqrtf(ss * (1.f / 128.f) + EPS);
#pragma unroll
    for (int c = 0; c < 8; ++c) y[c] = a[c] * rstd * w[c] * silu(z[c]);
    *(uint4*)(mix + (size_t)m * 1024 + lane * 8) = pack8(y);
    ra = na; rb = nb4; rz = nz;
  }
}

#if MEGA
__global__ void __launch_bounds__(256, 2) k_mega(Params p) {
  __shared__ __attribute__((aligned(16))) unsigned char smem[65536];
  cg::grid_group grid = cg::this_grid();
  const int bid = blockIdx.x, nb = gridDim.x;
  __shared__ uint4 xb_words;
  if (threadIdx.x == 0) xb_words = make_uint4(0u, 0u, 0u, 0u);
  __syncthreads();
  const XcdBarrier xbar = xcd_barrier_post((unsigned*)(p.ws + OFF_BAR), (volatile unsigned*)&xb_words);
  if (p.ws == nullptr) grid.sync();
#define GBAR() xcd_barrier(xbar)
#define AMP(i, ...) do { if (AMP_SEL == (i)) { const unsigned long long t0_ = __builtin_amdgcn_s_memrealtime(); __VA_ARGS__; const unsigned long long t1_ = __builtin_amdgcn_s_memrealtime(); \
    while (__builtin_amdgcn_s_memrealtime() - t1_ < (t1_ - t0_)) __builtin_amdgcn_s_sleep(8); } else { __VA_ARGS__; } } while (0)
  AMP(0, phaseA(p, bid, nb, smem));
  GBAR();
  AMP(1, phaseB(p, bid, nb, smem));
  GBAR();
  AMP(2, phaseC(p, bid, nb, smem));
  GBAR();
  AMP(3, for (int t = bid; t < 2048; t += nb) prep_tile(p, t, smem));
  GBAR();
  int role = 3, ra = 0, rb = 0;
  if (nb == 512) {
    const int x = bid & 7, j = bid >> 3, xh = x >> 1;
    if ((x & 1) == 0) { if (j < 16) { role = 0; ra = xh * 4 + (j >> 2); rb = j & 3; } else if (j < 20) { role = 1; ra = xh * 4 + (j - 16); } }
    else { role = 2; ra = j * 4 + xh; rb = 256; }
  } else {
    if (bid < 64) { role = 0; ra = (bid & 7) * 2 + (bid >> 5); rb = (bid >> 3) & 3; }
    else if (bid < 80) { role = 1; ra = ((bid - 64) & 7) * 2 + ((bid - 64) >> 3); }
    else { role = 2; ra = bid - 80; rb = nb - 80; }
  }
  if (role == 0) { __builtin_amdgcn_s_setprio(3); scan_chunked(p, ra, rb, smem); __builtin_amdgcn_s_setprio(0); }
  else if (role == 1) scan_helper(p, ra);
  else if (role == 2) swa_mfma(p, ra, rb);
  GBAR();
  AMP(4, phaseF(p, bid, nb));
  GBAR();
  AMP(5, phaseG(p, bid, nb, smem));
}
#else
template <int PH>
__global__ void __launch_bounds__(256, 2) k_phase(Params p) {
  __shared__ __attribute__((aligned(16))) unsigned char smem[65536];
  const int bid = blockIdx.x, nb = gridDim.x;
  if (PH == 0) phaseA(p, bid, nb, smem);
  if (PH == 1) phaseB(p, bid, nb, smem);
  if (PH == 2) phaseC(p, bid, nb, smem);
  if (PH == 3) scan_chunked(p, bid >> 2, bid & 3, smem);
  if (PH == 6) swa_mfma(p, bid, nb);
  if (PH == 7) for (int t = bid; t < 2048; t += nb) prep_tile(p, t, smem);
  if (PH == 4) phaseF(p, bid, nb);
  if (PH == 5) phaseG(p, bid, nb, smem);
}
#endif

extern "C" void kernel_launch(void* const* d_in, const int* in_sizes, int n_in, void* d_out, int out_size, void* d_ws, size_t ws_size, hipStream_t stream) {
  Params p{};
  p.x = (const float*)d_in[0]; p.norm_w = (const float*)d_in[1]; p.w_in = (const float*)d_in[2]; p.conv_w = (const float*)d_in[3];
  p.a_log = (const float*)d_in[4]; p.dt_bias = (const float*)d_in[5]; p.out_norm_w = (const float*)d_in[6]; p.qnw = (const float*)d_in[7];
  p.knw = (const float*)d_in[8]; p.sinks = (const float*)d_in[9]; p.w_out = (const float*)d_in[10];
  p.out = (float*)d_out; p.ws = (unsigned char*)d_ws;
  if (ws_size < OFF_CTL_END) { fprintf(stderr, "workspace too small: %zu < %zu\n", ws_size, (size_t)OFF_END); return; }
#if MEGA
  static int grid_blocks = 0;
  if (!grid_blocks) {
    int dev = 0, cus = 0, per_cu = 0;
    hipGetDevice(&dev);
    hipDeviceGetAttribute(&cus, hipDeviceAttributeMultiprocessorCount, dev);
    hipOccupancyMaxActiveBlocksPerMultiprocessor(&per_cu, k_mega, 256, 0);
    if (per_cu > 2) per_cu = 2;
    grid_blocks = cus * per_cu;
  }
  void* args[] = {&p};
  (void)hipMemsetAsync((unsigned char*)d_ws + OFF_BAR, 0, OFF_CTL_END - OFF_BAR, stream);
  hipError_t e = hipLaunchCooperativeKernel((void*)k_mega, dim3(grid_blocks), dim3(256), args, 0, stream);
  if (e != hipSuccess) fprintf(stderr, "cooperative launch failed: %s (grid %d)\n", hipGetErrorString(e), grid_blocks);
#else
  k_phase<0><<<512, 256, 0, stream>>>(p);
  k_phase<1><<<512, 256, 0, stream>>>(p);
  k_phase<2><<<512, 256, 0, stream>>>(p);
  k_phase<7><<<512, 256, 0, stream>>>(p);
  k_phase<3><<<64, 256, 0, stream>>>(p);
  k_phase<6><<<512, 256, 0, stream>>>(p);
  k_phase<4><<<512, 256, 0, stream>>>(p);
  k_phase<5><<<512, 256, 0, stream>>>(p);
#endif
}
```

```cpp
#include <hip/hip_runtime.h>
#include <hip/hip_bf16.h>
#include <hip/hip_cooperative_groups.h>
#include <cstdio>
namespace cg = cooperative_groups;

#ifndef MEGA
#define MEGA 1
#endif
#define AMP_SEL (-1)
#define REP_A 1
#define REP_B 1
#define REP_C 1
#define REP_P 1
#define REP_S 1
#define REP_W 1
#define REP_F 1
#define REP_G 1

typedef unsigned short u16;
using bf16x8 = __attribute__((ext_vector_type(8))) short;
using f32x16 = __attribute__((ext_vector_type(16))) float;
using f32x4  = __attribute__((ext_vector_type(4))) float;
#define DI __device__ __forceinline__
using u32x4 = __attribute__((ext_vector_type(4))) unsigned;
using u32x2 = __attribute__((ext_vector_type(2))) unsigned;
#define MFMA16(a, b, c) __builtin_amdgcn_mfma_f32_16x16x32_bf16((a), (b), (c), 0, 0, 0)

constexpr int SEQ = 8192, M = 16384, D = 1024, NIN = 3344, N1 = 3328;
constexpr int C_DNQ = 0, C_DNK = 512, C_DNV = 1024, C_DNZ = 1536, C_SWQ = 2048, C_SWK = 2560, C_SWV = 2688, C_SWZ = 2816;
constexpr float EPS = 1e-6f;

constexpr int LDA = 1536, LDB = 1792;
constexpr int B_DNZ = 0, B_SWQ = 512, B_SWK = 1024, B_SWV = 1152, B_SWZ = 1280;
constexpr size_t OFF_XN   = 0;
constexpr size_t OFF_W1   = OFF_XN + (size_t)M * 1024 * 2;
constexpr size_t OFF_W2   = OFF_W1 + (size_t)N1 * 1024 * 2;
constexpr size_t OFF_BETA = OFF_W2 + (size_t)1024 * 1024 * 2;
constexpr size_t OFF_G    = OFF_BETA + (size_t)M * 8 * 4;
constexpr size_t OFF_ROPC = OFF_G + (size_t)M * 8 * 4;
constexpr size_t OFF_ROPS = OFF_ROPC + (size_t)SEQ * 32 * 4;
constexpr size_t OFF_PROJB= OFF_ROPS + (size_t)SEQ * 32 * 4;
constexpr size_t OFF_QN   = OFF_PROJB + (size_t)M * LDB * 2;
constexpr size_t OFF_KN   = OFF_QN + (size_t)M * 512 * 2;
constexpr size_t OFF_VV   = OFF_KN + (size_t)M * 512 * 2;
constexpr size_t OFF_PROJA= OFF_VV + (size_t)M * 512 * 2;
constexpr size_t OFF_PW   = OFF_PROJA;
constexpr size_t OFF_PU   = OFF_PW + (size_t)2048 * 8192 * 2;
constexpr size_t OFF_PK   = OFF_PU + (size_t)2048 * 8192 * 2;
constexpr size_t OFF_END  = OFF_PK + (size_t)2048 * 8192 * 2;
constexpr size_t DO_OB = (size_t)M * 512 * 2, DO_KR = (size_t)M * 512 * 4, DO_PA = DO_KR + (size_t)M * 128 * 4, DO_PE = DO_PA + (size_t)2048 * 4096 * 2, DO_PGL = DO_PE + (size_t)2048 * 64 * 4;
constexpr size_t DO_VT = DO_PGL + 8192;
constexpr int VT_LD = SEQ + 64;
static_assert(DO_VT + (size_t)256 * VT_LD * 2 <= (size_t)M * 1024 * 4, "d_out scratch overflow");
constexpr size_t OFF_BAR  = OFF_END;
constexpr size_t OFF_PROG = OFF_BAR + 16384;
constexpr size_t OFF_CTL_END = OFF_PROG + 16 * 256;
static_assert(OFF_CTL_END <= (size_t)256 * 1024 * 1024, "workspace overflow");

struct Params {
  const float *x, *norm_w, *w_in, *conv_w, *a_log, *dt_bias, *out_norm_w, *qnw, *knw, *sinks, *w_out;
  float* out;
  unsigned char* ws;
};

DI u16 f2bf(float x) { __bf16 r = (__bf16)x; return __builtin_bit_cast(u16, r); }
DI float bf2f(u16 v) { return __uint_as_float(((unsigned)v) << 16); }
typedef float f32x2_t __attribute__((ext_vector_type(2)));
typedef __bf16 bf16x2_t __attribute__((ext_vector_type(2)));
DI unsigned pack2(float a, float b) { f32x2_t v = {a, b}; bf16x2_t r = __builtin_convertvector(v, bf16x2_t); return __builtin_bit_cast(unsigned, r); }
template <int CTRL> DI float dpp_mov(float v) { return __int_as_float(__builtin_amdgcn_update_dpp(0, __float_as_int(v), CTRL, 0xF, 0xF, true)); }
DI float sum4(float v) { v += dpp_mov<0xB1>(v); v += dpp_mov<0x4E>(v); return v; }
DI float sum16(float v) { v = sum4(v); v += dpp_mov<0x141>(v); v += dpp_mov<0x140>(v); return v; }
DI float wave_sum(float v) {
  v = sum16(v);
  return (__int_as_float(__builtin_amdgcn_readlane(__float_as_int(v), 0)) + __int_as_float(__builtin_amdgcn_readlane(__float_as_int(v), 16))) +
         (__int_as_float(__builtin_amdgcn_readlane(__float_as_int(v), 32)) + __int_as_float(__builtin_amdgcn_readlane(__float_as_int(v), 48)));
}
DI float silu(float y) { return y * __frcp_rn(1.f + __expf(-y)); }
#define XB_TMO      128
#define XB_XCNT(j)  (256  + 64 * (j))
#define XB_XSUB(j)  (1280 + 64 * (j))
#define XB_XGEN(j)  (2304 + 64 * (j))
#define XB_TOP      3328
#define XB_TOPGEN   3392
#define XCD_BAR_WORDS 3456
#define XB_SPIN_CAP (1u << 20)
DI unsigned xb_ld(unsigned* p) { return __hip_atomic_load(p, __ATOMIC_RELAXED, __HIP_MEMORY_SCOPE_AGENT); }
DI unsigned xb_add(unsigned* p, unsigned v) { return __hip_atomic_fetch_add(p, v, __ATOMIC_RELAXED, __HIP_MEMORY_SCOPE_AGENT); }
DI unsigned xb_xcc_id() { return (unsigned)__builtin_amdgcn_s_getreg((3 << 11) | 20) & 0xFu; }
#define XB_SPIN(cond, bar) do { unsigned _sp = 0; while (cond) { __builtin_amdgcn_s_sleep(1); \
    if ((++_sp & 255u) == 0u) { if (xb_ld(&(bar)[XB_TMO])) break; if (_sp > XB_SPIN_CAP) { atomicAdd(&(bar)[XB_TMO], 1u); break; } } } } while (0)
struct XcdBarrier { unsigned* bar; unsigned x; volatile unsigned* st; };
DI XcdBarrier xcd_barrier_post(unsigned* bar, volatile unsigned* st) {
  XcdBarrier b; b.bar = bar; b.x = xb_xcc_id(); b.st = st;
  if (threadIdx.x == 0) (void)xb_add(&bar[XB_XCNT(b.x)], 1u);
  return b;
}
DI void xcd_barrier_complete(unsigned* bar, unsigned x, unsigned& nloc, unsigned& nx) {
  const unsigned G = gridDim.x;
  unsigned sum, cnt, mine, sp = 0u;
  for (;;) {
    sum = 0u; cnt = 0u; mine = 0u;
#pragma unroll
    for (unsigned j = 0; j < 16; ++j) { const unsigned c = xb_ld(&bar[XB_XCNT(j)]); sum += c; cnt += (c > 0u) ? 1u : 0u; mine = (j == x) ? c : mine; }
    if (sum == G) break;
    __builtin_amdgcn_s_sleep(1);
    if ((++sp & 255u) == 0u) { if (xb_ld(&bar[XB_TMO])) break; if (sp > XB_SPIN_CAP) { atomicAdd(&bar[XB_TMO], 1u); break; } }
  }
  nloc = mine > 0u ? mine : 1u; nx = cnt > 0u ? cnt : 1u;
}
DI void xcd_barrier(const XcdBarrier& b) {
  asm volatile("s_waitcnt vmcnt(0)" ::: "memory");
  __syncthreads();
  if (threadIdx.x == 0) {
    unsigned* bar = b.bar;
    __builtin_amdgcn_s_waitcnt(0);
    unsigned nloc = b.st[0], nx = b.st[1];
    if (nloc == 0u) { xcd_barrier_complete(bar, b.x, nloc, nx); b.st[0] = nloc; b.st[1] = nx; }
    const unsigned old = xb_add(&bar[XB_XSUB(b.x)], 1u);
    const unsigned gen = old / nloc;
    if (old + 1u == (gen + 1u) * nloc) {
      __builtin_amdgcn_fence(__ATOMIC_RELEASE, "agent");
      asm volatile("s_waitcnt vmcnt(0)" ::: "memory");
      const unsigned og = xb_add(&bar[XB_TOP], 1u);
      const unsigned tg = og / nx;
      if (og + 1u == (tg + 1u) * nx) xb_add(&bar[XB_TOPGEN], 1u);
      else XB_SPIN(xb_ld(&bar[XB_TOPGEN]) == tg, bar);
      __builtin_amdgcn_fence(__ATOMIC_ACQUIRE, "agent");
      xb_add(&bar[XB_XGEN(b.x)], 1u);
      asm volatile("s_waitcnt vmcnt(0)" ::: "memory");
    } else {
      XB_SPIN(xb_ld(&bar[XB_XGEN(b.x)]) == gen, bar);
      __builtin_amdgcn_fence(__ATOMIC_ACQUIRE, "agent");
      asm volatile("s_waitcnt vmcnt(0)" ::: "memory");
    }
  }
  __syncthreads();
}
DI int crow(int i, int h) { return (i & 3) + 8 * (i >> 2) + 4 * h; }

__device__ void phaseA(const Params& p, int bid, int nb, unsigned char* smem_raw) {
  float* smem = (float*)smem_raw;
  const int tid = threadIdx.x, wave = tid >> 6, lane = tid & 63;
#pragma unroll
  for (int i = 0; i < 4; ++i) {
    const int k = tid + 256 * i;
    const float4* src = (const float4*)(p.w_in + (size_t)k * NIN + 2048);
#pragma unroll
    for (int q = 0; q < 4; ++q) {
      const float4 v4 = src[q];
      smem[(4 * q + 0) * 1024 + k] = v4.x; smem[(4 * q + 1) * 1024 + k] = v4.y; smem[(4 * q + 2) * 1024 + k] = v4.z; smem[(4 * q + 3) * 1024 + k] = v4.w;
    }
  }
  __syncthreads();
  u16* xn = (u16*)(p.ws + OFF_XN);
  float* betaA = (float*)(p.ws + OFF_BETA);
  float* gA = (float*)(p.ws + OFF_G);
  float4 nwv[4];
#pragma unroll
  for (int i = 0; i < 4; ++i) nwv[i] = ((const float4*)p.norm_w)[lane + 64 * i];
  const float dtb = lane < 16 && lane >= 8 ? p.dt_bias[lane - 8] : 0.f;
  const float nal = lane < 16 && lane >= 8 ? -__expf(p.a_log[lane - 8]) : 0.f;
  float4 v[4], vn[4];
  int row = bid * 4 + wave;
  if (row < M) {
#pragma unroll
    for (int i = 0; i < 4; ++i) v[i] = ((const float4*)(p.x + (size_t)row * D))[lane + 64 * i];
  }
  for (; row < M; row += nb * 4) {
    const int rown = row + nb * 4;
    if (rown < M) {
#pragma unroll
      for (int i = 0; i < 4; ++i) vn[i] = ((const float4*)(p.x + (size_t)rown * D))[lane + 64 * i];
    }
    float ss = 0.f;
#pragma unroll
    for (int i = 0; i < 4; ++i) ss += v[i].x * v[i].x + v[i].y * v[i].y + v[i].z * v[i].z + v[i].w * v[i].w;
    ss = wave_sum(ss);
    const float rstd = rsqrtf(ss * (1.f / 1024.f) + EPS);
#pragma unroll
    for (int i = 0; i < 4; ++i) {
      v[i].x *= rstd * nwv[i].x; v[i].y *= rstd * nwv[i].y; v[i].z *= rstd * nwv[i].z; v[i].w *= rstd * nwv[i].w;
      uint2 pk; pk.x = pack2(v[i].x, v[i].y); pk.y = pack2(v[i].z, v[i].w);
      *(uint2*)(xn + (size_t)row * 1024 + (lane + 64 * i) * 4) = pk;
    }
    float r = 0.f;
#pragma unroll 2
    for (int j = 0; j < 16; ++j) {
      float a = 0.f;
#pragma unroll
      for (int i = 0; i < 4; ++i) {
        float4 w = *(const float4*)&smem[j * 1024 + (lane + 64 * i) * 4];
        a += v[i].x * w.x + v[i].y * w.y + v[i].z * w.z + v[i].w * w.w;
      }
      a = wave_sum(a);
      r = (lane == j) ? a : r;
    }
    if (lane < 8) betaA[(size_t)row * 8 + lane] = 1.f / (1.f + __expf(-r));
    else if (lane < 16) {
      float xx = r + dtb;
      float sp = fmaxf(xx, 0.f) + log1pf(__expf(-fabsf(xx)));
      gA[(size_t)row * 8 + lane - 8] = nal * sp;
    }
#pragma unroll
    for (int i = 0; i < 4; ++i) v[i] = vn[i];
  }
  u16* w1 = (u16*)(p.ws + OFF_W1);
  u16* w2 = (u16*)(p.ws + OFF_W2);
  const int gt = bid * 256 + tid, gs = nb * 256;
  {
    unsigned char* Lt = smem_raw;
    const int kq = tid >> 4, n4 = (tid & 15) * 4;
    for (int tile = bid; tile < 52 * 16 + 16 * 16; tile += nb) {
      const bool isw1 = tile < 52 * 16;
      const int tt = isw1 ? tile : tile - 52 * 16;
      const int n0 = isw1 ? (tt >> 4) * 64 : (tt >> 4) * 64, k0 = (tt & 15) * 64;
      const float* src = isw1 ? p.w_in + (n0 < 2048 ? n0 : n0 + 16) : p.w_out + n0;
      const int ldw = isw1 ? NIN : 1024;
      __syncthreads();
#pragma unroll
      for (int i = 0; i < 4; ++i) {
        const int kl = kq + 16 * i;
        const float4 v4 = *(const float4*)(src + (size_t)(k0 + kl) * ldw + n4);
        *(u16*)(Lt + (n4 + 0) * 144 + kl * 2) = f2bf(v4.x); *(u16*)(Lt + (n4 + 1) * 144 + kl * 2) = f2bf(v4.y);
        *(u16*)(Lt + (n4 + 2) * 144 + kl * 2) = f2bf(v4.z); *(u16*)(Lt + (n4 + 3) * 144 + kl * 2) = f2bf(v4.w);
      }
      __syncthreads();
      u16* dst = (isw1 ? w1 : w2) + (size_t)(n0 + (tid >> 2)) * 1024 + k0;
      *(uint4*)(dst + (tid & 3) * 8) = *(const uint4*)(Lt + (tid >> 2) * 144 + (tid & 3) * 16);
      *(uint4*)(dst + (tid & 3) * 8 + 32) = *(const uint4*)(Lt + (tid >> 2) * 144 + (tid & 3) * 16 + 64);
    }
  }
  float* rc = (float*)(p.ws + OFF_ROPC);
  float* rs = (float*)(p.ws + OFF_ROPS);
  for (int idx = gt; idx < SEQ * 32; idx += gs) {
    int pos = idx >> 5, i = idx & 31;
    float inv = exp2f(-(float)i * (13.287712379549449f / 32.f));
    float ang = (float)pos * inv;
    double a = (double)ang * 0.15915494309189535;
    float fr = (float)(a - rint(a));
    rc[idx] = __builtin_amdgcn_cosf(fr); rs[idx] = __builtin_amdgcn_sinf(fr);
  }
}

template <int MODE>
__device__ void gemm_tile(const Params& p, const u16* __restrict__ A, const u16* __restrict__ Bt, int K, int m0, int n0, unsigned char* smem) {
  const int tid = threadIdx.x, wave = tid >> 6, lane = tid & 63;
  const int wm = wave >> 1, wn = wave & 1, r = lane & 31, h = lane >> 5;
  unsigned char* As = smem;
  unsigned char* Bs = smem + 32768;
  f32x16 acc[2][2];
#pragma unroll
  for (int a = 0; a < 2; ++a)
#pragma unroll
    for (int b = 0; b < 2; ++b)
#pragma unroll
      for (int i = 0; i < 16; ++i) acc[a][b][i] = 0.f;
  uint4 s0a0, s0a1, s0a2, s0a3, s0b0, s0b1, s0b2, s0b3, s1a0, s1a1, s1a2, s1a3, s1b0, s1b1, s1b2, s1b3;
  const int KT = K / 64;
  const int lrow = tid >> 3, lc = tid & 7;
  const u16* gA = A + (size_t)(m0 + lrow) * K + lc * 8;
  const u16* gB = Bt + (size_t)(n0 + lrow) * K + lc * 8;
  const int loff = lrow * 128 + ((lc ^ ((lrow >> 1) & 7)) << 4);
#define GLOAD(kt_, S) { const u16* pa_ = gA + (kt_) * 64; const u16* pb_ = gB + (kt_) * 64; \
    S##a0 = *(const uint4*)(pa_); S##a1 = *(const uint4*)(pa_ + (size_t)32 * K); S##a2 = *(const uint4*)(pa_ + (size_t)64 * K); S##a3 = *(const uint4*)(pa_ + (size_t)96 * K); \
    S##b0 = *(const uint4*)(pb_); S##b1 = *(const uint4*)(pb_ + (size_t)32 * K); S##b2 = *(const uint4*)(pb_ + (size_t)64 * K); S##b3 = *(const uint4*)(pb_ + (size_t)96 * K); }
#define LSTORE(buf_, S) { unsigned char* la_ = As + (buf_) * 16384 + loff; unsigned char* lb_ = Bs + (buf_) * 16384 + loff; \
    *(uint4*)(la_) = S##a0; *(uint4*)(la_ + 4096) = S##a1; *(uint4*)(la_ + 8192) = S##a2; *(uint4*)(la_ + 12288) = S##a3; \
    *(uint4*)(lb_) = S##b0; *(uint4*)(lb_ + 4096) = S##b1; *(uint4*)(lb_ + 8192) = S##b2; *(uint4*)(lb_ + 12288) = S##b3; }
  const int rowa0 = wm * 64 + r, rowb0 = wn * 64 + r;
  const int swa0 = (rowa0 >> 1) & 7, swb0 = (rowb0 >> 1) & 7;
#define LDFRAG(buf_, ks_, AF, BF) { const int c_ = (ks_) * 2 + h; \
    AF[0] = *(const bf16x8*)(As + (buf_) * 16384 + rowa0 * 128 + ((c_ ^ swa0) << 4)); AF[1] = *(const bf16x8*)(As + (buf_) * 16384 + (rowa0 + 32) * 128 + ((c_ ^ swa0) << 4)); \
    BF[0] = *(const bf16x8*)(Bs + (buf_) * 16384 + rowb0 * 128 + ((c_ ^ swb0) << 4)); BF[1] = *(const bf16x8*)(Bs + (buf_) * 16384 + (rowb0 + 32) * 128 + ((c_ ^ swb0) << 4)); }
#define MMA4(AF, BF) { acc[0][0] = __builtin_amdgcn_mfma_f32_32x32x16_bf16(BF[0], AF[0], acc[0][0], 0, 0, 0); acc[0][1] = __builtin_amdgcn_mfma_f32_32x32x16_bf16(BF[1], AF[0], acc[0][1], 0, 0, 0); \
    acc[1][0] = __builtin_amdgcn_mfma_f32_32x32x16_bf16(BF[0], AF[1], acc[1][0], 0, 0, 0); acc[1][1] = __builtin_amdgcn_mfma_f32_32x32x16_bf16(BF[1], AF[1], acc[1][1], 0, 0, 0); }
  auto compute = [&](int buf) {
    bf16x8 afA[2], bfA[2], afB[2], bfB[2];
    LDFRAG(buf, 0, afA, bfA)
    LDFRAG(buf, 1, afB, bfB)
    __builtin_amdgcn_sched_barrier(0);
    __builtin_amdgcn_s_setprio(1);
    MMA4(afA, bfA)
    __builtin_amdgcn_sched_barrier(0);
    LDFRAG(buf, 2, afA, bfA)
    __builtin_amdgcn_sched_barrier(0);
    MMA4(afB, bfB)
    __builtin_amdgcn_sched_barrier(0);
    LDFRAG(buf, 3, afB, bfB)
    __builtin_amdgcn_sched_barrier(0);
    MMA4(afA, bfA)
    MMA4(afB, bfB)
    __builtin_amdgcn_s_setprio(0);
    __builtin_amdgcn_sched_barrier(0);
  };
  __syncthreads();
  GLOAD(0, s0) LSTORE(0, s0)
  GLOAD(1, s1)
  __syncthreads();
  for (int kt = 0; kt < KT; kt += 2) {
    { const int k2 = kt + 2 < KT ? kt + 2 : KT - 1; GLOAD(k2, s0) }
    compute(0);
    LSTORE(1, s1)
    __syncthreads();
    { const int k3 = kt + 3 < KT ? kt + 3 : KT - 1; GLOAD(k3, s1) }
    compute(1);
    if (kt + 2 < KT) { LSTORE(0, s0) }
    __syncthreads();
  }
#undef GLOAD
#undef LSTORE
  if (MODE == 0) {
#pragma unroll
    for (int a = 0; a < 2; ++a)
#pragma unroll
      for (int b = 0; b < 2; ++b)
#pragma unroll
        for (int g = 0; g < 4; ++g)
          *(uint2*)(smem + (wm * 64 + a * 32 + r) * 272 + (wn * 64 + b * 32 + 8 * g + 4 * h) * 2) = make_uint2(pack2(acc[a][b][4 * g], acc[a][b][4 * g + 1]), pack2(acc[a][b][4 * g + 2], acc[a][b][4 * g + 3]));
    __syncthreads();
    u16* dstb = n0 < 1536 ? (u16*)(p.ws + OFF_PROJA) + n0 : (u16*)(p.ws + OFF_PROJB) + (n0 - 1536);
    const int ld = n0 < 1536 ? LDA : LDB;
#pragma unroll
    for (int i = 0; i < 8; ++i) {
      const int id = tid + 256 * i, row = id >> 4, ch = id & 15;
      *(uint4*)(dstb + (size_t)(m0 + row) * ld + ch * 8) = *(const uint4*)(smem + row * 272 + ch * 16);
    }
    __syncthreads();
  } else {
    float* Cs = (float*)smem;
#pragma unroll
    for (int half = 0; half < 2; ++half) {
      if (wm == half) {
#pragma unroll
        for (int a = 0; a < 2; ++a)
#pragma unroll
          for (int b = 0; b < 2; ++b)
#pragma unroll
            for (int g = 0; g < 4; ++g)
              *(float4*)(Cs + (a * 32 + r) * 132 + wn * 64 + b * 32 + 8 * g + 4 * h) = make_float4(acc[a][b][4 * g], acc[a][b][4 * g + 1], acc[a][b][4 * g + 2], acc[a][b][4 * g + 3]);
      }
      __syncthreads();
#pragma unroll
      for (int i = 0; i < 8; ++i) {
        const int id = tid + 256 * i, row = id >> 5, ch = id & 31;
        const size_t go = (size_t)(m0 + half * 64 + row) * 1024 + n0 + ch * 4;
        const float4 xv = *(const float4*)(p.x + go);
        const float4 cv = *(const float4*)(Cs + row * 132 + ch * 4);
        *(float4*)(p.out + go) = make_float4(xv.x + cv.x, xv.y + cv.y, xv.z + cv.z, xv.w + cv.w);
      }
      __syncthreads();
    }
  }
}

__device__ void phaseB(const Params& p, int bid, int nb, unsigned char* smem) {
  const u16* xn = (const u16*)(p.ws + OFF_XN);
  const u16* w1 = (const u16*)(p.ws + OFF_W1);
  if ((nb & 7) == 0) {
    const int x = bid & 7, w = bid >> 3, per = nb >> 3;
    for (int j = w; j < 16 * 26; j += per) {
      const int g = j / 208, rem = j % 208;
      const int tn = rem >> 3, tm = x * 16 + g * 8 + (rem & 7);
      gemm_tile<0>(p, xn, w1, 1024, tm * 128, tn * 128, smem);
    }
  } else {
    for (int t = bid; t < 128 * 26; t += nb) gemm_tile<0>(p, xn, w1, 1024, (t / 26) * 128, (t % 26) * 128, smem);
  }
}
__device__ void phaseG(const Params& p, int bid, int nb, unsigned char* smem) {
  const u16* mix = (const u16*)(p.ws + OFF_XN);
  const u16* w2 = (const u16*)(p.ws + OFF_W2);
  if ((nb & 7) == 0) {
    const int x = bid & 7, w = bid >> 3, per = nb >> 3;
    for (int j = w; j < 16 * 8; j += per) {
      const int g = j >> 6, rem = j & 63;
      const int tn = rem >> 3, tm = x * 16 + g * 8 + (rem & 7);
      gemm_tile<1>(p, mix, w2, 1024, tm * 128, tn * 128, smem);
    }
  } else {
    for (int t = bid; t < 128 * 8; t += nb) gemm_tile<1>(p, mix, w2, 1024, (t >> 3) * 128, (t & 7) * 128, smem);
  }
}

DI void unpack8(const uint4 u, float* f) {
  f[0] = __uint_as_float(u.x << 16); f[1] = __uint_as_float(u.x & 0xffff0000u); f[2] = __uint_as_float(u.y << 16); f[3] = __uint_as_float(u.y & 0xffff0000u);
  f[4] = __uint_as_float(u.z << 16); f[5] = __uint_as_float(u.z & 0xffff0000u); f[6] = __uint_as_float(u.w << 16); f[7] = __uint_as_float(u.w & 0xffff0000u);
}
DI uint4 pack8(const float* f) { return make_uint4(pack2(f[0], f[1]), pack2(f[2], f[3]), pack2(f[4], f[5]), pack2(f[6], f[7])); }

__device__ void phaseC(const Params& p, int bid, int nb, unsigned char* smem) {
  const int tid = threadIdx.x, wave = tid >> 6, lane = tid & 63;
  const u16* projA = (const u16*)(p.ws + OFF_PROJA);
  const u16* projB = (const u16*)(p.ws + OFF_PROJB);
  u16* kr = (u16*)((unsigned char*)p.out + DO_KR);
  u16* vT = (u16*)((unsigned char*)p.out + DO_VT);
  u16* qr = (u16*)(p.ws + OFF_XN);
  const float* rc = (const float*)(p.ws + OFF_ROPC);
  const float* rs = (const float*)(p.ws + OFF_ROPS);
  int* wctr = (int*)smem;
  __syncthreads();
  if (tid == 0) *wctr = 0;
  __syncthreads();
  if (tid < 192) {
    const int sec = tid >> 6, ch0 = (tid & 63) * 8;
    u16* dst = (u16*)(p.ws + (sec == 0 ? OFF_QN : (sec == 1 ? OFF_KN : OFF_VV)));
    float w[5][8];
#pragma unroll
    for (int j = 0; j < 5; ++j) {
      const float4 w0 = *(const float4*)(p.conv_w + j * 1536 + sec * 512 + ch0), w1 = *(const float4*)(p.conv_w + j * 1536 + sec * 512 + ch0 + 4);
      w[j][0] = w0.x; w[j][1] = w0.y; w[j][2] = w0.z; w[j][3] = w0.w; w[j][4] = w1.x; w[j][5] = w1.y; w[j][6] = w1.z; w[j][7] = w1.w;
    }
    for (int run = bid; run < M / 32; run += nb) {
      const int m0 = run * 32, t0 = m0 & (SEQ - 1);
      auto ldraw = [&](int i) {
        const int t = t0 + i;
        uint4 u = make_uint4(0u, 0u, 0u, 0u);
        if (t >= 0 && t < SEQ) u = *(const uint4*)(projA + (size_t)(m0 + i) * LDA + sec * 512 + ch0);
        return u;
      };
      float r[5][8];
      { uint4 u0 = ldraw(-2), u1 = ldraw(-1), u2 = ldraw(0), u3 = ldraw(1); unpack8(u0, r[0]); unpack8(u1, r[1]); unpack8(u2, r[2]); unpack8(u3, r[3]); }
      uint4 pre0 = ldraw(2), pre1 = ldraw(3), pre2 = ldraw(4);
#pragma unroll 1
      for (int i = 0; i < 32; ++i) {
        unpack8(pre0, r[4]);
        pre0 = pre1; pre1 = pre2; pre2 = ldraw(i + 5 < 34 ? i + 5 : 33);
        float y[8]; float ss = 0.f;
#pragma unroll
        for (int c = 0; c < 8; ++c) {
          float a = r[0][c] * w[0][c] + r[1][c] * w[1][c] + r[2][c] * w[2][c] + r[3][c] * w[3][c] + r[4][c] * w[4][c];
          a = silu(a); y[c] = a; ss += a * a;
        }
        if (sec < 2) {
          ss = sum16(ss);
          const float f = rsqrtf(ss + EPS) * (sec == 0 ? 0.08838834764831845f : 1.f);
#pragma unroll
          for (int c = 0; c < 8; ++c) y[c] *= f;
        }
        if (sec == 0) {
          const int mm = m0 + i, tq = mm & (SEQ - 1), cq = tq & 63, chq = (ch0 & 127) >> 3;
          const size_t tileq = (size_t)(((mm >> 13) * 4 + (ch0 >> 7)) * 128 + (tq >> 6));
          *(uint4*)(dst + tileq * 8192 + (((cq >> 4) * 4 + (chq >> 2)) * 64 + (chq & 3) * 16 + (cq & 15)) * 8) = pack8(y);
        } else *(uint4*)(dst + (size_t)(m0 + i) * 512 + ch0) = pack8(y);
#pragma unroll
        for (int j = 0; j < 4; ++j)
#pragma unroll
          for (int c = 0; c < 8; ++c) r[j][c] = r[j + 1][c];
      }
    }
  }
  const int nitems = M / 2 + M / 8, ipw = (nitems + nb - 1) / nb;
  for (;;) {
    int it = 0;
    if (lane == 0) it = atomicAdd(wctr, 1);
    it = __shfl(it, 0);
    const int item = bid * ipw + it;
    if (it >= ipw || item >= nitems) break;
    const bool isk = item >= M / 2;
    const int j = lane & 3;
    int m, head;
    if (!isk) { m = item * 2 + (lane >> 5); head = (lane >> 2) & 7; }
    else      { m = (item - M / 2) * 8 + (lane >> 3); head = (lane >> 2) & 1; }
    const int t = m & (SEQ - 1);
    const u16* src = projB + (size_t)m * LDB + (isk ? B_SWK : B_SWQ) + head * 64 + 8 * j;
    float lo[8], hi[8];
    unpack8(*(const uint4*)src, lo); unpack8(*(const uint4*)(src + 32), hi);
    float ss = 0.f;
#pragma unroll
    for (int c = 0; c < 8; ++c) ss += lo[c] * lo[c] + hi[c] * hi[c];
    ss = sum4(ss);
    const float rstd = rsqrtf(ss * (1.f / 64.f) + EPS) * (isk ? 1.f : 0.125f);
    const float* nw = isk ? p.knw : p.qnw;
    float olo[8], ohi[8];
#pragma unroll
    for (int c = 0; c < 8; ++c) {
      const float y0 = lo[c] * rstd * nw[8 * j + c], y1 = hi[c] * rstd * nw[32 + 8 * j + c];
      const float cs = rc[t * 32 + 8 * j + c], sn = rs[t * 32 + 8 * j + c];
      olo[c] = y0 * cs - y1 * sn; ohi[c] = y1 * cs + y0 * sn;
    }
    if (isk) {
      u16* dst = kr + ((size_t)(((m >> 13) * 2 + head) * 512 + (t >> 4)) * 2) * 512 + (j * 16 + (t & 15)) * 8;
      *(uint4*)dst = pack8(olo); *(uint4*)(dst + 512) = pack8(ohi);
    } else {
      u16* dst = qr + (size_t)m * 1024 + head * 64 + 8 * j;
      *(uint4*)dst = pack8(olo); *(uint4*)(dst + 32) = pack8(ohi);
    }
  }
  for (int it = bid * 256 + tid; it < 128 * (M / 8); it += nb * 256) {
    const int c = it & 127, m0 = (it >> 7) * 8;
    const int b = m0 >> 13, t0 = m0 & (SEQ - 1);
    const u16* src = projB + (size_t)m0 * LDB + B_SWV + c;
    unsigned pk[4];
#pragma unroll
    for (int i = 0; i < 4; ++i) pk[i] = (unsigned)src[(size_t)(2 * i) * LDB] | ((unsigned)src[(size_t)(2 * i + 1) * LDB] << 16);
    u16* dst = vT + ((size_t)(((b * 2 + (c >> 6)) * 512 + (t0 >> 4)) * 4 + ((c & 63) >> 4)) * 64 + ((t0 >> 2) & 3) * 16 + (c & 15)) * 4;
    *(uint2*)dst = make_uint2(pk[0], pk[1]);
    *(uint2*)(dst + 64) = make_uint2(pk[2], pk[3]);
  }
}

__device__ void prep_tile(const Params& p, int tile, unsigned char* smem) {
  int tid_ = threadIdx.x;
  asm volatile("" : "+v"(tid_));
  const int tid = tid_, wave = __builtin_amdgcn_readfirstlane(tid >> 6), lane = tid & 63;
  const int dir = tile & 1, n = (tile >> 1) & 127, bh = tile >> 8, b = bh >> 2, hh = bh & 3;
  unsigned char* ksb = smem;
  unsigned char* qsb = smem + 17408;
  float* Ms = (float*)(smem + 34816);
  float* gc = (float*)(smem + 51200);
  float* bt = gc + 64;
  float* cw = (float*)(smem + 64000);
  float* cd = (float*)(smem + 64256);
  const u16* qn = (const u16*)(p.ws + OFF_QN);
  const u16* kn = (const u16*)(p.ws + OFF_KN);
  const u16* vv = (const u16*)(p.ws + OFF_VV);
  const float* betaA = (const float*)(p.ws + OFF_BETA);
  const float* gA = (const float*)(p.ws + OFF_G);
  u16* pw = (u16*)(p.ws + OFF_PW) + (size_t)tile * 8192;
  u16* pu = (u16*)(p.ws + OFF_PU) + (size_t)tile * 8192;
  u16* pk = (u16*)(p.ws + OFF_PK) + (size_t)tile * 8192;
  u16* pa = (u16*)((unsigned char*)p.out + DO_PA) + (size_t)tile * 4096;
  float* pe = (float*)((unsigned char*)p.out + DO_PE) + (size_t)tile * 64;
  float* pgl = (float*)((unsigned char*)p.out + DO_PGL);
  const size_t row0 = (size_t)b * SEQ + n * 64;
  __syncthreads();
#pragma unroll
  for (int i = 0; i < 4; ++i) {
    int id = tid + 256 * i, c = id >> 4, ch = id & 15;
    int tok = dir ? 63 - c : c;
    *(uint4*)(ksb + c * 272 + ch * 16) = *(const uint4*)(kn + (row0 + tok) * 512 + hh * 128 + ch * 8);
    *(uint4*)(qsb + c * 272 + ch * 16) = *(const uint4*)(qn + (size_t)(bh * 128 + n) * 8192 + (((tok >> 4) * 4 + (ch >> 2)) * 64 + (ch & 3) * 16 + (tok & 15)) * 8);
  }
  if (wave == 0) {
    int tok = dir ? 63 - lane : lane;
    float g = gA[(row0 + tok) * 8 + dir * 4 + hh];
    float bb = betaA[(row0 + tok) * 8 + dir * 4 + hh];
#pragma unroll
    for (int o = 1; o < 64; o <<= 1) { float t = __shfl_up(g, o); if (lane >= o) g += t; }
    gc[lane] = g; bt[lane] = bb;
    const float eg_ = __expf(g);
    pe[lane] = eg_;
    if (lane == 63) pgl[tile] = eg_;
    cw[lane] = bb * eg_;
    cd[lane] = __expf(__shfl(g, 63) - g);
  }
  __syncthreads();
  {
    const int row = lane & 15, quad = lane >> 4;
    bf16x8 ak[4], aq[4];
#pragma unroll
    for (int k = 0; k < 4; ++k) {
      ak[k] = *(const bf16x8*)(ksb + (16 * wave + row) * 272 + k * 64 + quad * 16);
      aq[k] = *(const bf16x8*)(qsb + (16 * wave + row) * 272 + k * 64 + quad * 16);
    }
#pragma unroll
    for (int tc = 0; tc < 4; ++tc) {
      f32x4 ckk = {0.f, 0.f, 0.f, 0.f}, cqk = {0.f, 0.f, 0.f, 0.f};
#pragma unroll
      for (int k = 0; k < 4; ++k) {
        bf16x8 bk = *(const bf16x8*)(ksb + (16 * tc + row) * 272 + k * 64 + quad * 16);
        ckk = MFMA16(ak[k], bk, ckk);
        cqk = MFMA16(aq[k], bk, cqk);
      }
      const int s = 16 * tc + row;
      const float gs = gc[s];
#pragma unroll
      for (int j = 0; j < 4; ++j) {
        const int c = 16 * wave + quad * 4 + j;
        float dec = __expf(fminf(gc[c] - gs, 0.f));
        float mval = (s < c) ? bt[c] * ckk[j] * dec : 0.f;
        float aval = (s <= c) ? cqk[j] * dec : 0.f;
        Ms[c * 64 + s] = mval;
        *(u16*)(smem + 51712 + ((((c >> 4) * 2 + (s >> 5)) * 64 + ((s >> 3) & 3) * 16 + (c & 15)) * 8 + (s & 7)) * 2) = f2bf(aval);
      }
    }
  }
  {
    const int dk = tid & 127, half = tid >> 7;
    const float gl = gc[63];
    unsigned pkd[16];
#pragma unroll
    for (int i = 0; i < 16; ++i) {
      int c0 = half * 32 + 2 * i;
      float k0 = bf2f(*(const u16*)(ksb + c0 * 272 + dk * 2)) * cd[c0];
      float k1 = bf2f(*(const u16*)(ksb + (c0 + 1) * 272 + dk * 2)) * cd[c0 + 1];
      pkd[i] = pack2(k0, k1);
    }
#pragma unroll
    for (int i = 0; i < 4; ++i) {
      const int cc = half * 4 + i;
      *(uint4*)(pk + ((((dk >> 5) * 2 + ((dk >> 4) & 1)) * 2 + (cc >> 2)) * 64 + (cc & 3) * 16 + (dk & 15)) * 8) = make_uint4(pkd[4 * i], pkd[4 * i + 1], pkd[4 * i + 2], pkd[4 * i + 3]);
    }
  }
  __syncthreads();
  {
    const uint4* src = (const uint4*)(smem + 51712);
    ((uint4*)pa)[tid] = src[tid];
    ((uint4*)pa)[tid + 256] = src[tid + 256];
  }
  float x[64];
  if (tid < 128) {
#pragma unroll
    for (int c = 0; c < 64; ++c) { int tok = dir ? 63 - c : c; x[c] = bt[c] * bf2f(vv[(row0 + tok) * 512 + hh * 128 + tid]); }
  } else {
#pragma unroll
    for (int c = 0; c < 64; ++c) x[c] = cw[c] * bf2f(*(const u16*)(ksb + c * 272 + (tid - 128) * 2));
  }
  __syncthreads();
  unsigned char* xs = smem;
  unsigned char* ys = smem + 51712;
  {
    const int row = lane & 15, quad = lane >> 4;
#pragma unroll
    for (int I = 0; I < 4; ++I) {
      asm volatile("" ::: "memory");
      if (I > 0) {
        f32x4 yacc[4];
#pragma unroll
        for (int nt = 0; nt < 4; ++nt) yacc[nt] = f32x4{0.f, 0.f, 0.f, 0.f};
#pragma unroll
        for (int ks = 0; ks < (16 * I + 31) / 32; ++ks) {
          const bool live = (ks * 32 + quad * 8) < 16 * I;
          const float4 m0 = *(const float4*)(Ms + (16 * I + row) * 64 + ks * 32 + quad * 8);
          const float4 m1 = *(const float4*)(Ms + (16 * I + row) * 64 + ks * 32 + quad * 8 + 4);
          union { bf16x8 v; unsigned u[4]; } af;
          af.u[0] = live ? pack2(m0.x, m0.y) : 0u; af.u[1] = live ? pack2(m0.z, m0.w) : 0u;
          af.u[2] = live ? pack2(m1.x, m1.y) : 0u; af.u[3] = live ? pack2(m1.z, m1.w) : 0u;
          const int qe = live ? quad : (quad & 1);
#pragma unroll
          for (int nt = 0; nt < 4; ++nt) {
            const bf16x8 bx = *(const bf16x8*)(xs + (64 * wave + 16 * nt + row) * 112 + (ks * 32 + qe * 8) * 2);
            yacc[nt] = MFMA16(af.v, bx, yacc[nt]);
          }
        }
#pragma unroll
        for (int nt = 0; nt < 4; ++nt)
          *(uint2*)(ys + (64 * wave + 16 * nt + row) * 48 + quad * 8) = make_uint2(pack2(yacc[nt][0], yacc[nt][1]), pack2(yacc[nt][2], yacc[nt][3]));
        const uint4 y0 = *(const uint4*)(ys + tid * 48), y1 = *(const uint4*)(ys + tid * 48 + 16);
        const unsigned yy[8] = {y0.x, y0.y, y0.z, y0.w, y1.x, y1.y, y1.z, y1.w};
#pragma unroll
        for (int r = 0; r < 16; ++r) x[16 * I + r] -= (r & 1) ? __uint_as_float(yy[r >> 1] & 0xffff0000u) : __uint_as_float(yy[r >> 1] << 16);
      }
      int mrow[16];
#pragma unroll
      for (int r = 1; r < 16; ++r) mrow[r] = __float_as_int(Ms[(16 * I + r) * 64 + lane]);
#pragma unroll
      for (int r = 1; r < 16; ++r) {
        float a0 = 0.f, a1 = 0.f;
#pragma unroll
        for (int sidx = 0; sidx < r; ++sidx) {
          const float m = __int_as_float(__builtin_amdgcn_readlane(mrow[r], 16 * I + sidx));
          if (sidx & 1) a1 = fmaf(m, x[16 * I + sidx], a1); else a0 = fmaf(m, x[16 * I + sidx], a0);
        }
        x[16 * I + r] -= a0 + a1;
      }
      if (I < 3) {
#pragma unroll
        for (int i = 0; i < 2; ++i)
          *(uint4*)(xs + tid * 112 + I * 32 + i * 16) = make_uint4(pack2(x[16 * I + 8 * i], x[16 * I + 8 * i + 1]), pack2(x[16 * I + 8 * i + 2], x[16 * I + 8 * i + 3]),
                                                                 pack2(x[16 * I + 8 * i + 4], x[16 * I + 8 * i + 5]), pack2(x[16 * I + 8 * i + 6], x[16 * I + 8 * i + 7]));
      }
    }
  }
  __syncthreads();
  if (tid < 128) {
#pragma unroll
    for (int g = 0; g < 16; ++g)
      *(uint2*)(pu + (((((tid >> 5) * 2 + ((tid >> 4) & 1)) * 4 + (g >> 2)) * 64 + (g & 3) * 16 + (tid & 15)) * 4)) = make_uint2(pack2(x[4 * g], x[4 * g + 1]), pack2(x[4 * g + 2], x[4 * g + 3]));
  } else {
#pragma unroll
    for (int c = 0; c < 64; ++c) *(u16*)(qsb + c * 272 + (tid - 128) * 2) = f2bf(-x[c]);
  }
  __syncthreads();
#pragma unroll
  for (int i = 0; i < 4; ++i) {
    const int d = tid + 256 * i;
    const int c = (d >> 8) * 16 + (d & 15), ch = ((d >> 6) & 3) * 4 + ((d >> 4) & 3);
    *(uint4*)(pw + d * 8) = *(const uint4*)(qsb + c * 272 + ch * 16);
  }
}

struct ScanEarly { bf16x8 aw[4]; uint2 u[2]; };
struct ScanFrags { bf16x8 aq[4], aa[2], akd[2][2]; float eg; float egl; };
__device__ void scan_chunked(const Params& p, int chain, int slab, unsigned char* smem) {
  const int tid = threadIdx.x, wave = tid >> 6, lane = tid & 63, row = lane & 15, quad = lane >> 4;
  const int dv0 = slab * 32;
  const int b = chain >> 3, hh = (chain >> 1) & 3, dir = chain & 1;
  unsigned* prog = (unsigned*)(p.ws + OFF_PROG) + chain * 64;
  const bool publisher = (dv0 == 0) && (tid == 0);
  unsigned char* Sl = smem;
  unsigned char* Vl = smem + 8704;
  const u16* qn = (const u16*)(p.ws + OFF_QN);
  const u16* pwA = (const u16*)(p.ws + OFF_PW);
  const u16* puA = (const u16*)(p.ws + OFF_PU);
  const u16* pkA = (const u16*)(p.ws + OFF_PK);
  const u16* paA = (const u16*)((unsigned char*)p.out + DO_PA);
  const float* peA = (const float*)((unsigned char*)p.out + DO_PE);
  const float* pglA = (const float*)((unsigned char*)p.out + DO_PGL);
  u16* ob = (u16*)((unsigned char*)p.out + (dir ? DO_OB : 0));
#pragma unroll 1
  for (int rep = 0; rep < REP_S; ++rep) {
  __syncthreads();
  for (int i = tid; i < 8704 / 4; i += 256) ((unsigned*)Sl)[i] = 0u;
  f32x4 Sacc[2][2];
#pragma unroll
  for (int a = 0; a < 2; ++a)
#pragma unroll
    for (int c = 0; c < 2; ++c) Sacc[a][c] = f32x4{0.f, 0.f, 0.f, 0.f};
  auto gloadE = [&](ScanEarly& e, int step) {
    const int n = dir ? 127 - step : step;
    const size_t tile = ((size_t)(b * 4 + hh) * 128 + n) * 2 + dir;
#pragma unroll
    for (int k = 0; k < 4; ++k) e.aw[k] = *(const bf16x8*)(pwA + tile * 8192 + ((wave * 4 + k) * 64 + lane) * 8);
#pragma unroll
    for (int nt = 0; nt < 2; ++nt) e.u[nt] = *(const uint2*)(puA + tile * 8192 + ((((dv0 >> 5) * 2 + nt) * 4 + wave) * 64 + lane) * 4);
  };
  auto gload = [&](ScanFrags& f, int step) {
    const int n = dir ? 127 - step : step;
    const size_t tile = ((size_t)(b * 4 + hh) * 128 + n) * 2 + dir;
    const int c = 16 * wave + row;
    const size_t qtile = (size_t)((b * 4 + hh) * 128 + n) * 8192;
    const int qlane = dir ? quad * 16 + (15 - row) : lane, qw = dir ? 3 - wave : wave;
#pragma unroll
    for (int k = 0; k < 4; ++k) f.aq[k] = *(const bf16x8*)(qn + qtile + ((qw * 4 + k) * 64 + qlane) * 8);
#pragma unroll
    for (int k = 0; k < 2; ++k) {
      f.aa[k] = *(const bf16x8*)(paA + tile * 4096 + ((wave * 2 + k) * 64 + lane) * 8);
#pragma unroll
      for (int d = 0; d < 2; ++d) f.akd[d][k] = *(const bf16x8*)(pkA + tile * 8192 + (((wave * 2 + d) * 2 + k) * 64 + lane) * 8);
    }
    f.eg = peA[tile * 64 + c];
    f.egl = pglA[tile];
  };
  auto body = [&](ScanEarly& e, ScanEarly& en2, ScanFrags& f, ScanFrags& fn, int step) {
    if (publisher) __hip_atomic_store(prog, (unsigned)(step + 1), __ATOMIC_RELAXED, __HIP_MEMORY_SCOPE_AGENT);
    if (step + 2 < 128) gloadE(en2, step + 2);
    if (step + 1 < 128) gload(fn, step + 1);
    bf16x8 bS[4][2];
#pragma unroll
    for (int k = 0; k < 4; ++k)
#pragma unroll
      for (int nt = 0; nt < 2; ++nt) bS[k][nt] = *(const bf16x8*)(Sl + (nt * 16 + row) * 272 + k * 64 + quad * 16);
    f32x4 vacc[2], oacc[2];
#pragma unroll
    for (int nt = 0; nt < 2; ++nt) {
      vacc[nt] = f32x4{__uint_as_float(e.u[nt].x << 16), __uint_as_float(e.u[nt].x & 0xffff0000u), __uint_as_float(e.u[nt].y << 16), __uint_as_float(e.u[nt].y & 0xffff0000u)};
#pragma unroll
      for (int k = 0; k < 4; ++k) vacc[nt] = MFMA16(e.aw[k], bS[k][nt], vacc[nt]);
      *(uint2*)(Vl + (nt * 16 + row) * 144 + (16 * wave + quad * 4) * 2) = make_uint2(pack2(vacc[nt][0], vacc[nt][1]), pack2(vacc[nt][2], vacc[nt][3]));
    }
    asm volatile("s_waitcnt lgkmcnt(0)\n\ts_barrier" ::: "memory");
#pragma unroll
    for (int nt = 0; nt < 2; ++nt) {
      oacc[nt] = f32x4{0.f, 0.f, 0.f, 0.f};
#pragma unroll
      for (int k = 0; k < 4; ++k) oacc[nt] = MFMA16(bS[k][nt], f.aq[k], oacc[nt]);
      oacc[nt] *= f.eg;
    }
    bf16x8 bV[2][2];
#pragma unroll
    for (int k = 0; k < 2; ++k)
#pragma unroll
      for (int nt = 0; nt < 2; ++nt) bV[k][nt] = *(const bf16x8*)(Vl + (nt * 16 + row) * 144 + k * 64 + quad * 16);
#pragma unroll
    for (int d = 0; d < 2; ++d)
#pragma unroll
      for (int nt = 0; nt < 2; ++nt) {
        Sacc[d][nt] *= f.egl;
#pragma unroll
        for (int k = 0; k < 2; ++k) Sacc[d][nt] = MFMA16(f.akd[d][k], bV[k][nt], Sacc[d][nt]);
        *(uint2*)(Sl + (nt * 16 + row) * 272 + (32 * wave + 16 * d + quad * 4) * 2) = make_uint2(pack2(Sacc[d][nt][0], Sacc[d][nt][1]), pack2(Sacc[d][nt][2], Sacc[d][nt][3]));
      }
    const int n = dir ? 127 - step : step;
#pragma unroll
    for (int nt = 0; nt < 2; ++nt) {
#pragma unroll
      for (int k = 0; k < 2; ++k) oacc[nt] = MFMA16(bV[k][nt], f.aa[k], oacc[nt]);
      const int c = 16 * wave + row;
      const int tok = dir ? 63 - c : c;
      __builtin_nontemporal_store(u32x2{pack2(oacc[nt][0], oacc[nt][1]), pack2(oacc[nt][2], oacc[nt][3])}, (u32x2*)(ob + ((size_t)b * SEQ + n * 64 + tok) * 512 + hh * 128 + dv0 + nt * 16 + quad * 4));
    }
    asm volatile("s_waitcnt lgkmcnt(0)\n\ts_barrier" ::: "memory");
  };
  ScanEarly e0, e1, e2;
  ScanFrags f0, f1;
  gloadE(e0, 0); gloadE(e1, 1);
  gload(f0, 0);
  __syncthreads();
#pragma unroll 1
  for (int step = 0; step < 126; step += 6) {
    body(e0, e2, f0, f1, step);
    body(e1, e0, f1, f0, step + 1);
    body(e2, e1, f0, f1, step + 2);
    body(e0, e2, f1, f0, step + 3);
    body(e1, e0, f0, f1, step + 4);
    body(e2, e1, f1, f0, step + 5);
  }
  body(e0, e2, f0, f1, 126);
  body(e1, e0, f1, f0, 127);
  }
}

constexpr int PF_DEPTH = 10, PF_BATCH = 4;
__device__ void scan_helper(const Params& p, int chain) {
  const int tid = threadIdx.x;
  const int b = chain >> 3, hh = (chain >> 1) & 3, dir = chain & 1;
  unsigned* prog = (unsigned*)(p.ws + OFF_PROG) + chain * 64;
  const unsigned char* pw = p.ws + OFF_PW;
  const unsigned char* pu = p.ws + OFF_PU;
  const unsigned char* pk = p.ws + OFF_PK;
  const unsigned char* pa = (const unsigned char*)p.out + DO_PA;
  const unsigned char* pe = (const unsigned char*)p.out + DO_PE;
  const unsigned char* qn = p.ws + OFF_QN;
  unsigned acc = 0u;
  int cur = 1;
#pragma unroll 1
  while (cur < 128) {
    const int done = (int)__hip_atomic_load(prog, __ATOMIC_RELAXED, __HIP_MEMORY_SCOPE_AGENT);
    if (done >= 127) break;
    if (cur < done + 1) cur = done + 1;
    const int lim = done + PF_DEPTH < 128 ? done + PF_DEPTH : 128;
    if (cur >= lim) { __builtin_amdgcn_s_sleep(4); continue; }
    unsigned v[PF_BATCH][3];
#pragma unroll
    for (int i = 0; i < PF_BATCH; ++i) {
      const int st = cur + i < lim ? cur + i : lim - 1;
      const int n = dir ? 127 - st : st;
      const size_t tile = ((size_t)(b * 4 + hh) * 128 + n) * 2 + dir;
      const unsigned char* a0 = (tid < 128) ? pw + tile * 16384 + tid * 128 : pu + tile * 16384 + (tid - 128) * 128;
      const unsigned char* a1 = (tid < 128) ? pk + tile * 16384 + tid * 128 : (tid < 192 ? pa + tile * 8192 + (tid - 128) * 128 : pe + tile * 256 + (tid & 1) * 128);
      const unsigned char* a2 = qn + (size_t)((b * 4 + hh) * 128 + n) * 16384 + (tid & 127) * 128;
      v[i][0] = *(const unsigned*)a0; v[i][1] = *(const unsigned*)a1; v[i][2] = *(const unsigned*)a2;
    }
#pragma unroll
    for (int i = 0; i < PF_BATCH; ++i) acc ^= v[i][0] ^ v[i][1] ^ v[i][2];
    cur = cur + PF_BATCH < lim ? cur + PF_BATCH : lim;
  }
  if (acc == 0x9e3779b9u && p.ws == nullptr) *(unsigned*)p.out = acc;
}

__device__ void swa_mfma(const Params& p, int bid, int nb) {
  const int wave = threadIdx.x >> 6, lane = threadIdx.x & 63, col = lane & 15, quad = lane >> 4;
  const u16* kr = (const u16*)((const unsigned char*)p.out + DO_KR);
  const u16* vT = (const u16*)((const unsigned char*)p.out + DO_VT);
  const u16* qr = (const u16*)(p.ws + OFF_XN);
  const u16* projB = (const u16*)(p.ws + OFF_PROJB);
  u16* mix = (u16*)(p.ws + OFF_XN);
  const int upw = (2048 + nb - 1) / nb;
  for (int unit = bid * upw; unit < (bid + 1) * upw && unit < 2048; ++unit) {
    const int qblk = unit & 511, kvh = (unit >> 9) & 1, b = unit >> 10;
    const int t0 = qblk * 16, qh = kvh * 4 + wave;
    const size_t mq = (size_t)b * SEQ + t0 + col;
    bf16x8 bq[2];
#pragma unroll
    for (int ks = 0; ks < 2; ++ks) {
      const u32x4 t4 = __builtin_nontemporal_load((const u32x4*)(qr + mq * 1024 + qh * 64 + ks * 32 + quad * 8));
      bq[ks] = __builtin_bit_cast(bf16x8, t4);
    }
    f32x4 sc[18];
    const int kb0 = (t0 >> 4) - 8;
    const u16* kbase = kr + (size_t)((b * 2 + kvh) * 512) * 1024 + lane * 8;
#pragma unroll
    for (int kt = 0; kt < 18; ++kt) {
      int kb = kb0 + kt; kb = kb < 0 ? 0 : (kb > 511 ? 511 : kb);
      const bf16x8 a0 = *(const bf16x8*)(kbase + (size_t)kb * 1024), a1 = *(const bf16x8*)(kbase + (size_t)kb * 1024 + 512);
      f32x4 c = {0.f, 0.f, 0.f, 0.f};
      c = MFMA16(a0, bq[0], c);
      c = MFMA16(a1, bq[1], c);
      sc[kt] = c;
    }
    const float sink = p.sinks[qh];
    float mx = sink;
#pragma unroll
    for (int kt = 0; kt < 18; ++kt)
#pragma unroll
      for (int jj = 0; jj < 4; ++jj) {
        const int key = t0 - 128 + 16 * kt + quad * 4 + jj;
        const int rel = key - (t0 + col);
        const bool valid = (rel >= -128) && (rel <= 128) && (key >= 0) && (key < SEQ);
        float v = valid ? sc[kt][jj] : -1e30f;
        sc[kt][jj] = v;
        mx = fmaxf(mx, v);
      }
    mx = fmaxf(mx, __shfl_xor(mx, 16));
    mx = fmaxf(mx, __shfl_xor(mx, 32));
    float l = 0.f;
#pragma unroll
    for (int kt = 0; kt < 18; ++kt)
#pragma unroll
      for (int jj = 0; jj < 4; ++jj) { float e = __expf(sc[kt][jj] - mx); sc[kt][jj] = e; l += e; }
    l += __shfl_xor(l, 16);
    l += __shfl_xor(l, 32);
    l += __expf(sink - mx);
    f32x4 o[4];
#pragma unroll
    for (int dt = 0; dt < 4; ++dt) o[dt] = f32x4{0.f, 0.f, 0.f, 0.f};
    bf16x8 bp[9];
#pragma unroll
    for (int kg = 0; kg < 9; ++kg) {
      union { bf16x8 v; unsigned u[4]; } t;
      t.u[0] = pack2(sc[2 * kg][0], sc[2 * kg][1]); t.u[1] = pack2(sc[2 * kg][2], sc[2 * kg][3]);
      t.u[2] = pack2(sc[2 * kg + 1][0], sc[2 * kg + 1][1]); t.u[3] = pack2(sc[2 * kg + 1][2], sc[2 * kg + 1][3]);
      bp[kg] = t.v;
    }
    const u16* vbase = vT + (size_t)((b * 2 + kvh) * 512) * 1024 + lane * 4;
#pragma unroll
    for (int hb = 0; hb < 2; ++hb) {
      uint2 av[5][4][2];
#pragma unroll
      for (int i = 0; i < 5; ++i) {
        const int kg = hb * 5 + i;
        if (kg < 9) {
          int b0 = kb0 + 2 * kg, b1 = b0 + 1;
          b0 = b0 < 0 ? 0 : (b0 > 511 ? 511 : b0); b1 = b1 < 0 ? 0 : (b1 > 511 ? 511 : b1);
#pragma unroll
          for (int dt = 0; dt < 4; ++dt) {
            av[i][dt][0] = *(const uint2*)(vbase + ((size_t)b0 * 4 + dt) * 256);
            av[i][dt][1] = *(const uint2*)(vbase + ((size_t)b1 * 4 + dt) * 256);
          }
        }
      }
      __builtin_amdgcn_sched_barrier(0);
#pragma unroll
      for (int i = 0; i < 5; ++i) {
        const int kg = hb * 5 + i;
        if (kg < 9) {
#pragma unroll
          for (int dt = 0; dt < 4; ++dt) {
            union { bf16x8 v; unsigned u[4]; } a;
            a.u[0] = av[i][dt][0].x; a.u[1] = av[i][dt][0].y; a.u[2] = av[i][dt][1].x; a.u[3] = av[i][dt][1].y;
            o[dt] = MFMA16(a.v, bp[kg], o[dt]);
          }
        }
      }
      __builtin_amdgcn_sched_barrier(0);
    }
    const float inv = __frcp_rn(l);
#pragma unroll
    for (int dt = 0; dt < 4; ++dt) {
      const int d0 = dt * 16 + quad * 4;
      const u32x2 zz = __builtin_nontemporal_load((const u32x2*)(projB + mq * LDB + B_SWZ + qh * 64 + d0));
      const uint2 z = make_uint2(zz[0], zz[1]);
      float z0 = __uint_as_float(z.x << 16), z1 = __uint_as_float(z.x & 0xffff0000u), z2 = __uint_as_float(z.y << 16), z3 = __uint_as_float(z.y & 0xffff0000u);
      __builtin_nontemporal_store(u32x2{pack2(o[dt][0] * inv * silu(z0), o[dt][1] * inv * silu(z1)), pack2(o[dt][2] * inv * silu(z2), o[dt][3] * inv * silu(z3))}, (u32x2*)(mix + mq * 1024 + 512 + qh * 64 + d0));
    }
  }
}

__device__ void phaseF(const Params& p, int bid, int nb) {
  const int tid = threadIdx.x, wave = tid >> 6, lane = tid & 63;
  const u16* proj = (const u16*)(p.ws + OFF_PROJB);
  u16* mix = (u16*)(p.ws + OFF_XN);
  const u16* of = (const u16*)p.out;
  const u16* ob = (const u16*)((const unsigned char*)p.out + DO_OB);
  float w[8];
#pragma unroll
  for (int c = 0; c < 8; ++c) w[c] = p.out_norm_w[(lane & 15) * 8 + c];
  int m = bid * 4 + wave;
  uint4 ra = make_uint4(0u, 0u, 0u, 0u), rb = ra, rz = ra;
  if (m < M) {
    ra = *(const uint4*)(of + (size_t)m * 512 + lane * 8); rb = *(const uint4*)(ob + (size_t)m * 512 + lane * 8);
    rz = *(const uint4*)(proj + (size_t)m * LDB + B_DNZ + lane * 8);
  }
  for (; m < M; m += nb * 4) {
    const int mn = m + nb * 4;
    uint4 na = ra, nb4 = rb, nz = rz;
    if (mn < M) {
      na = *(const uint4*)(of + (size_t)mn * 512 + lane * 8); nb4 = *(const uint4*)(ob + (size_t)mn * 512 + lane * 8);
      nz = *(const uint4*)(proj + (size_t)mn * LDB + B_DNZ + lane * 8);
    }
    float a[8], b[8], z[8], y[8];
    unpack8(ra, a); unpack8(rb, b); unpack8(rz, z);
    float ss = 0.f;
#pragma unroll
    for (int c = 0; c < 8; ++c) { a[c] += b[c]; ss += a[c] * a[c]; }
    ss = sum16(ss);
    const float rstd = rsqrtf(ss * (1.f / 128.f) + EPS);
#pragma unroll
    for (int c = 0; c < 8; ++c) y[c] = a[c] * rstd * w[c] * silu(z[c]);
    *(uint4*)(mix + (size_t)m * 1024 + lane * 8) = pack8(y);
    ra = na; rb = nb4; rz = nz;
  }
}

#if MEGA
__global__ void __launch_bounds__(256, 2) k_mega(Params p) {
  __shared__ __attribute__((aligned(16))) unsigned char smem[65536];
  cg::grid_group grid = cg::this_grid();
  const int bid = blockIdx.x, nb = gridDim.x;
  __shared__ uint4 xb_words;
  if (threadIdx.x == 0) xb_words = make_uint4(0u, 0u, 0u, 0u);
  __syncthreads();
  const XcdBarrier xbar = xcd_barrier_post((unsigned*)(p.ws + OFF_BAR), (volatile unsigned*)&xb_words);
  if (p.ws == nullptr) grid.sync();
#define GBAR() xcd_barrier(xbar)
#define AMP(i, ...) do { if (AMP_SEL == (i)) { const unsigned long long t0_ = __builtin_amdgcn_s_memrealtime(); __VA_ARGS__; const unsigned long long t1_ = __builtin_amdgcn_s_memrealtime(); \
    while (__builtin_amdgcn_s_memrealtime() - t1_ < (t1_ - t0_)) __builtin_amdgcn_s_sleep(8); } else { __VA_ARGS__; } } while (0)
  AMP(0, phaseA(p, bid, nb, smem));
  GBAR();
  AMP(1, phaseB(p, bid, nb, smem));
  GBAR();
  AMP(2, phaseC(p, bid, nb, smem));
  GBAR();
  AMP(3, for (int t = bid; t < 2048; t += nb) prep_tile(p, t, smem));
  GBAR();
  int role = 3, ra = 0, rb = 0;
  if (nb == 512) {
    const int x = bid & 7, j = bid >> 3, xh = x >> 1;
    if ((x & 1) == 0) { if (j < 16) { role = 0; ra = xh * 4 + (j >> 2); rb = j & 3; } else if (j < 20) { role = 1; ra = xh * 4 + (j - 16); } }
    else { role = 2; ra = j * 4 + xh; rb = 256; }
  } else {
    if (bid < 64) { role = 0; ra = (bid & 7) * 2 + (bid >> 5); rb = (bid >> 3) & 3; }
    else if (bid < 80) { role = 1; ra = ((bid - 64) & 7) * 2 + ((bid - 64) >> 3); }
    else { role = 2; ra = bid - 80; rb = nb - 80; }
  }
  if (role == 0) { __builtin_amdgcn_s_setprio(3); scan_chunked(p, ra, rb, smem); __builtin_amdgcn_s_setprio(0); }
  else if (role == 1) scan_helper(p, ra);
  else if (role == 2) swa_mfma(p, ra, rb);
  GBAR();
  AMP(4, phaseF(p, bid, nb));
  GBAR();
  AMP(5, phaseG(p, bid, nb, smem));
}
#else
template <int PH>
__global__ void __launch_bounds__(256, 2) k_phase(Params p) {
  __shared__ __attribute__((aligned(16))) unsigned char smem[65536];
  const int bid = blockIdx.x, nb = gridDim.x;
  if (PH == 0) phaseA(p, bid, nb, smem);
  if (PH == 1) phaseB(p, bid, nb, smem);
  if (PH == 2) phaseC(p, bid, nb, smem);
  if (PH == 3) scan_chunked(p, bid >> 2, bid & 3, smem);
  if (PH == 6) swa_mfma(p, bid, nb);
  if (PH == 7) for (int t = bid; t < 2048; t += nb) prep_tile(p, t, smem);
  if (PH == 4) phaseF(p, bid, nb);
  if (PH == 5) phaseG(p, bid, nb, smem);
}
#endif

extern "C" void kernel_launch(void* const* d_in, const int* in_sizes, int n_in, void* d_out, int out_size, void* d_ws, size_t ws_size, hipStream_t stream) {
  Params p{};
  p.x = (const float*)d_in[0]; p.norm_w = (const float*)d_in[1]; p.w_in = (const float*)d_in[2]; p.conv_w = (const float*)d_in[3];
  p.a_log = (const float*)d_in[4]; p.dt_bias = (const float*)d_in[5]; p.out_norm_w = (const float*)d_in[6]; p.qnw = (const float*)d_in[7];
  p.knw = (const float*)d_in[8]; p.sinks = (const float*)d_in[9]; p.w_out = (const float*)d_in[10];
  p.out = (float*)d_out; p.ws = (unsigned char*)d_ws;
  if (ws_size < OFF_CTL_END) { fprintf(stderr, "workspace too small: %zu < %zu\n", ws_size, (size_t)OFF_END); return; }
#if MEGA
  static int grid_blocks = 0;
  if (!grid_blocks) {
    int dev = 0, cus = 0, per_cu = 0;
    hipGetDevice(&dev);
    hipDeviceGetAttribute(&cus, hipDeviceAttributeMultiprocessorCount, dev);
    hipOccupancyMaxActiveBlocksPerMultiprocessor(&per_cu, k_mega, 256, 0);
    if (per_cu > 2) per_cu = 2;
    grid_blocks = cus * per_cu;
  }
  void* args[] = {&p};
  (void)hipMemsetAsync((unsigned char*)d_ws + OFF_BAR, 0, OFF_CTL_END - OFF_BAR, stream);
  hipError_t e = hipLaunchCooperativeKernel((void*)k_mega, dim3(grid_blocks), dim3(256), args, 0, stream);
  if (e != hipSuccess) fprintf(stderr, "cooperative launch failed: %s (grid %d)\n", hipGetErrorString(e), grid_blocks);
#else
  k_phase<0><<<512, 256, 0, stream>>>(p);
  k_phase<1><<<512, 256, 0, stream>>>(p);
  k_phase<2><<<512, 256, 0, stream>>>(p);
  k_phase<7><<<512, 256, 0, stream>>>(p);
  k_phase<3><<<64, 256, 0, stream>>>(p);
  k_phase<6><<<512, 256, 0, stream>>>(p);
  k_phase<4><<<512, 256, 0, stream>>>(p);
  k_phase<5><<<512, 256, 0, stream>>>(p);
#endif
}
```
